# Optimizing an MI355X kernel written in HIP

```python
import math
import jax, jax.numpy as jnp
from jax import lax
import numpy as np

D_MODEL = 1024
BATCH = 4
SEQ = 8192
DEPTH = 2

N_MIXERS = 2
N_Q_HEADS = 8
N_KV_HEADS = 2
HEAD_DIM = D_MODEL // N_Q_HEADS
Q_PER_KV = N_Q_HEADS // N_KV_HEADS
ROT_DIM = HEAD_DIM // 4
ROPE_THETA = 500000.0
WINDOW = 128
BLOCK = 128
D_RNN = 3 * D_MODEL // 2
N_RNN_BLOCKS = 16
RNN_BLOCK_W = D_RNN // N_RNN_BLOCKS
CONV_W = 4
CONV_LEFT = 2
LRU_C = 8.0
D_FF = 4 * D_MODEL
DN_ALPHA = (2.0 * DEPTH) ** 0.25
DN_BETA = (8.0 * DEPTH) ** -0.25
LN_EPS = 1e-5
ADA_INIT = 0.5

N_ATTN_LAYERS = (DEPTH + N_MIXERS - 1) // N_MIXERS
N_RNN_LAYERS = DEPTH // N_MIXERS

kernel_name = "hybrid_swa_rglru_adaln_deepnorm_encoder"


def layer_norm(x, g, b):
    xf = x.astype(jnp.float32)
    mu = jnp.mean(xf, axis=-1, keepdims=True)
    var = jnp.mean(jnp.square(xf - mu), axis=-1, keepdims=True)
    y = (xf - mu) * lax.rsqrt(var + LN_EPS)
    return (y * g.astype(jnp.float32) + b.astype(jnp.float32)).astype(x.dtype)


def ada_modulation(c, w, b):
    mod = jax.nn.silu(c) @ w + b
    shift, scale, gate = jnp.split(mod, 3, axis=-1)
    return shift[:, None, :], scale[:, None, :], gate[:, None, :]


def partial_rope(t, cos, sin):
    half = ROT_DIM // 2
    tr = t[..., :ROT_DIM].astype(jnp.float32)
    t1, t2 = tr[..., :half], tr[..., half:]
    cs, sn = cos[None, :, None, :], sin[None, :, None, :]
    rot = jnp.concatenate([t1 * cs - t2 * sn, t2 * cs + t1 * sn], axis=-1).astype(t.dtype)
    return jnp.concatenate([rot, t[..., ROT_DIM:]], axis=-1)


def windowed_gqa(h, w_in, w_out, sinks):
    B, S, _ = h.shape
    nblk = S // BLOCK
    qkv = h @ w_in
    q, k, v = jnp.split(qkv, [N_Q_HEADS * HEAD_DIM, (N_Q_HEADS + N_KV_HEADS) * HEAD_DIM], axis=-1)
    q = q.reshape(B, S, N_Q_HEADS, HEAD_DIM)
    k = k.reshape(B, S, N_KV_HEADS, HEAD_DIM)
    v = v.reshape(B, S, N_KV_HEADS, HEAD_DIM)
    pos = jnp.arange(S, dtype=jnp.float32)
    inv_freq = ROPE_THETA ** (-jnp.arange(0, ROT_DIM, 2, dtype=jnp.float32) / ROT_DIM)
    ang = pos[:, None] * inv_freq[None, :]
    cos, sin = jnp.cos(ang), jnp.sin(ang)
    q = partial_rope(q, cos, sin)
    k = partial_rope(k, cos, sin)
    qb = q.reshape(B, nblk, BLOCK, N_KV_HEADS, Q_PER_KV, HEAD_DIM)

    def band(t):
        tp = jnp.pad(t, ((0, 0), (BLOCK, BLOCK), (0, 0), (0, 0)))
        tb = tp.reshape(B, nblk + 2, BLOCK, N_KV_HEADS, HEAD_DIM)
        return jnp.concatenate([tb[:, :-2], tb[:, 1:-1], tb[:, 2:]], axis=2)

    kb, vb = band(k), band(v)
    scores = jnp.einsum("bnqhgd,bnjhd->bnhgqj", qb, kb,
                        preferred_element_type=jnp.float32) * (HEAD_DIM ** -0.5)
    blk = jnp.arange(nblk)[:, None, None] * BLOCK
    qpos = blk + jnp.arange(BLOCK)[None, :, None]
    kpos = blk - BLOCK + jnp.arange(3 * BLOCK)[None, None, :]
    valid = (jnp.abs(qpos - kpos) <= WINDOW) & (kpos >= 0) & (kpos < S)
    scores = jnp.where(valid[None, :, None, None], scores, -jnp.inf)
    sink = sinks.astype(jnp.float32).reshape(N_KV_HEADS, Q_PER_KV)[None, None, :, :, None, None]
    m = jnp.maximum(jnp.max(scores, axis=-1, keepdims=True), sink)
    p = jnp.exp(scores - m)
    denom = jnp.sum(p, axis=-1, keepdims=True) + jnp.exp(sink - m)
    probs = (p / denom).astype(v.dtype)
    o = jnp.einsum("bnhgqj,bnjhd->bnqhgd", probs, vb)
    o = o.reshape(B, S, N_Q_HEADS * HEAD_DIM)
    return o @ w_out


def centred_depthwise_conv(x, w, b):
    S = x.shape[1]
    xp = jnp.pad(x, ((0, 0), (CONV_LEFT, CONV_W - 1 - CONV_LEFT), (0, 0)))
    out = xp[:, 0:S] * w[0] + b
    for j in range(1, CONV_W):
        out = out + xp[:, j:j + S] * w[j]
    return out


def rg_lru(x, w_a, b_a, w_x, b_x, lam, reverse):
    B, S, _ = x.shape
    xb = x.reshape(B, S, N_RNN_BLOCKS, RNN_BLOCK_W)
    r = jax.nn.sigmoid((jnp.einsum("bsni,nij->bsnj", xb, w_a).reshape(B, S, D_RNN) + b_a).astype(jnp.float32))
    i = jax.nn.sigmoid((jnp.einsum("bsni,nij->bsnj", xb, w_x).reshape(B, S, D_RNN) + b_x).astype(jnp.float32))
    log_a = -LRU_C * r * jax.nn.softplus(-lam.astype(jnp.float32))
    a = jnp.exp(log_a)
    mult = jnp.sqrt(-jnp.expm1(2.0 * log_a))
    u = mult * (i * x.astype(jnp.float32))

    def combine(left, right):
        a_l, b_l = left
        a_r, b_r = right
        return a_l * a_r, a_r * b_l + b_r

    _, hs = lax.associative_scan(combine, (a, u), axis=1, reverse=reverse)
    return hs


def recurrent_block(h, w_in, conv_w, conv_b, w_a, b_a, w_x, b_x, lam, w_out):
    z = h @ w_in
    xr, gate = jnp.split(z, 2, axis=-1)
    xr = centred_depthwise_conv(xr, conv_w, conv_b)
    y = (rg_lru(xr, w_a[0], b_a[0], w_x[0], b_x[0], lam[0], reverse=False)
         + rg_lru(xr, w_a[1], b_a[1], w_x[1], b_x[1], lam[1], reverse=True))
    y = y.astype(h.dtype) * jax.nn.gelu(gate)
    return y @ w_out


def sq_relu_mlp(h, w1, w2):
    return jnp.square(jax.nn.relu(h @ w1)) @ w2


def setup_inputs(seed: int = 0) -> dict:
    key = jax.random.key(seed)
    ks = jax.random.split(key, 24)
    nrm = lambda k, shape, s: jax.random.normal(k, shape, jnp.float32) * s
    u = jax.random.uniform(ks[17], (N_RNN_LAYERS, 2, D_RNN), jnp.float32, 0.9, 0.999)
    s_lam = u ** (1.0 / LRU_C)
    lam = jnp.log(s_lam) - jnp.log1p(-s_lam)
    return {
        "x": nrm(ks[0], (BATCH, SEQ, D_MODEL), 1.0),
        "c": nrm(ks[1], (BATCH, D_MODEL), 1.0),
        "ada_w": nrm(ks[2], (DEPTH, 2, D_MODEL, 3 * D_MODEL), ADA_INIT * D_MODEL ** -0.5),
        "ada_b": nrm(ks[3], (DEPTH, 2, 3 * D_MODEL), 0.01),
        "ln_g": 1.0 + nrm(ks[4], (DEPTH, 2, D_MODEL), 0.02),
        "ln_b": nrm(ks[5], (DEPTH, 2, D_MODEL), 0.02),
        "attn_w_in": nrm(ks[6], (N_ATTN_LAYERS, D_MODEL, (N_Q_HEADS + 2 * N_KV_HEADS) * HEAD_DIM), D_MODEL ** -0.5),
        "attn_w_out": nrm(ks[7], (N_ATTN_LAYERS, N_Q_HEADS * HEAD_DIM, D_MODEL), DN_BETA * (N_Q_HEADS * HEAD_DIM) ** -0.5),
        "attn_sinks": nrm(ks[8], (N_ATTN_LAYERS, N_Q_HEADS), 1.0),
        "rnn_w_in": nrm(ks[9], (N_RNN_LAYERS, D_MODEL, 2 * D_RNN), D_MODEL ** -0.5),
        "rnn_conv_w": nrm(ks[10], (N_RNN_LAYERS, CONV_W, D_RNN), CONV_W ** -0.5),
        "rnn_conv_b": nrm(ks[11], (N_RNN_LAYERS, D_RNN), 0.01),
        "rnn_w_a": nrm(ks[12], (N_RNN_LAYERS, 2, N_RNN_BLOCKS, RNN_BLOCK_W, RNN_BLOCK_W), RNN_BLOCK_W ** -0.5),
        "rnn_b_a": nrm(ks[13], (N_RNN_LAYERS, 2, D_RNN), 0.01),
        "rnn_w_x": nrm(ks[14], (N_RNN_LAYERS, 2, N_RNN_BLOCKS, RNN_BLOCK_W, RNN_BLOCK_W), RNN_BLOCK_W ** -0.5),
        "rnn_b_x": nrm(ks[15], (N_RNN_LAYERS, 2, D_RNN), 0.01),
        "rnn_lam": lam,
        "rnn_w_out": nrm(ks[16], (N_RNN_LAYERS, D_RNN, D_MODEL), DN_BETA * D_RNN ** -0.5),
        "mlp_w1": nrm(ks[18], (DEPTH, D_MODEL, D_FF), D_MODEL ** -0.5),
        "mlp_w2": nrm(ks[19], (DEPTH, D_FF, D_MODEL), DN_BETA * D_FF ** -0.5),
    }


def reference(x, c, ada_w, ada_b, ln_g, ln_b, attn_w_in, attn_w_out, attn_sinks,
              rnn_w_in, rnn_conv_w, rnn_conv_b, rnn_w_a, rnn_b_a, rnn_w_x, rnn_b_x, rnn_lam,
              rnn_w_out, mlp_w1, mlp_w2):
    for i in range(DEPTH):
        j = i // N_MIXERS
        shift, scale, gate = ada_modulation(c, ada_w[i, 0], ada_b[i, 0])
        h = x * (1.0 + scale) + shift
        if i % N_MIXERS == 0:
            y = windowed_gqa(h, attn_w_in[j], attn_w_out[j], attn_sinks[j])
        else:
            y = recurrent_block(h, rnn_w_in[j], rnn_conv_w[j], rnn_conv_b[j], rnn_w_a[j], rnn_b_a[j],
                                rnn_w_x[j], rnn_b_x[j], rnn_lam[j], rnn_w_out[j])
        x = layer_norm(DN_ALPHA * x + (1.0 + gate) * y, ln_g[i, 0], ln_b[i, 0])
        shift, scale, gate = ada_modulation(c, ada_w[i, 1], ada_b[i, 1])
        y = sq_relu_mlp(x * (1.0 + scale) + shift, mlp_w1[i], mlp_w2[i])
        x = layer_norm(DN_ALPHA * x + (1.0 + gate) * y, ln_g[i, 1], ln_b[i, 1])
    return x
```

```cpp
#include <hip/hip_runtime.h>
#include <hip/hip_cooperative_groups.h>
#include <cstdio>
#include <cstdint>
namespace cg = cooperative_groups;
constexpr int NWAVES = 8, NTHR = 512;
constexpr int BATCH = 4, SEQ = 8192, DM = 1024, M = BATCH * SEQ, DFF = 4096, DRNN = 1536, NQKV = 1536;
constexpr float LN_EPS = 1e-5f, DN_ALPHA = 1.4142135623730951f, LOG2E = 1.4426950408889634f;
constexpr int LDS_BYTES = 147456;
constexpr size_t MiB = 1u << 20;
constexpr size_t WS_MOD = 0;
constexpr size_t WS_BAR = 768 * 1024;
constexpr size_t WS_STAT = 256 * 1024;
constexpr size_t WS_SP8 = 512 * 1024;
constexpr size_t WS_CS = 1 * MiB;
constexpr size_t WS_WG = 2 * MiB;
constexpr size_t WS_WQKV = 4 * MiB;
constexpr size_t WS_WO = 7 * MiB;
constexpr size_t WS_WRIN = 9 * MiB;
constexpr size_t WS_WROUT = 15 * MiB;
constexpr size_t WS_W1 = 18 * MiB;
constexpr size_t WS_W2 = 34 * MiB;
constexpr size_t WS_XB = 50 * MiB;
constexpr size_t WS_HB = 178 * MiB;
constexpr size_t WS_BIG = 242 * MiB;
constexpr size_t WS_Q = WS_BIG, WS_K = WS_BIG + 64 * MiB, WS_V = WS_BIG + 80 * MiB, WS_O = WS_BIG + 96 * MiB;
constexpr size_t WS_XR = WS_BIG, WS_GG = WS_BIG + 96 * MiB;
constexpr size_t WS_AGG = WS_BIG + 192 * MiB;
constexpr size_t WS_CIN = WS_BIG + 208 * MiB;
constexpr size_t WS_END = WS_BIG + 256 * MiB;

namespace pg8 {
#define PG8_LAS __attribute__((address_space(3)))
typedef unsigned short bf16_t;
typedef short bf16x8 __attribute__((ext_vector_type(8)));
typedef float f32x4 __attribute__((ext_vector_type(4)));
typedef unsigned u32x4 __attribute__((ext_vector_type(4)));
constexpr int BM = 256, BK = 64, HALF = 128, HTB = HALF * BK * 2  , STAGE_BYTES = 8 * HTB, NXCD = 8, WGM = 8;

__host__ __device__ __forceinline__ int lds_byte(int r, int c) { const int st = (r >> 4) * 2 + (c >> 5), rr = r & 15, cc = c & 31, ob = rr * 64 + cc * 2; return st * 1024 + (ob ^ (((ob >> 9) & 1) << 5)); }
__host__ __device__ __forceinline__ void stage_rc(int b, int& R, int& C) { const int st = b / 1024, sb = b % 1024, swz = sb ^ (((sb >> 9) & 1) << 5); R = (st >> 1) * 16 + swz / 64; C = (st & 1) * 32 + (swz % 64) / 2; }
__host__ __device__ __forceinline__ int perm32(int rho) { const int n = rho >> 4, i = rho & 15; return 8 * (i >> 2) + 4 * n + (i & 3); }

struct Unit { int pm, pn; };
struct Gemm { const bf16_t* A; const bf16_t* Bt; int M, N, K; };

struct StaticOrder {
    int nM, nN, nwg, G, c;
    __host__ __device__ void init(int M, int N, int G_, int c_) { nM = M / BM; nN = N / BM; nwg = nM * nN; G = G_; c = c_; }
    __host__ __device__ bool next(int i, Unit& u) const {
        const long L = (long)i * G + c; if (L >= nwg) return false;
        int wgid = (int)L; { const int q = nwg / NXCD, r = nwg % NXCD, xcd = wgid % NXCD, off = wgid / NXCD; wgid = (xcd < r ? xcd * (q + 1) : r * (q + 1) + (xcd - r) * q) + off; }
        const int nig = WGM * nN, gid = wgid / nig, fm = gid * WGM, gsz = (nM - fm) < WGM ? (nM - fm) : WGM;
        u.pm = fm + ((wgid % nig) % gsz); u.pn = (wgid % nig) / gsz; return true;
    }
    __device__ __forceinline__ void a_ready(const Unit&) const {}
    __device__ __forceinline__ void done(const Unit&) const {}
};

__device__ __forceinline__ unsigned cvt_pk_bf16(float lo, float hi) { unsigned r; asm volatile("v_cvt_pk_bf16_f32 %0, %1, %2" : "=v"(r) : "v"(lo), "v"(hi)); return r; }
__device__ __forceinline__ u32x4 pack8(const f32x4 v0, const f32x4 v1) { u32x4 w; w.x = cvt_pk_bf16(v0[0], v0[1]); w.y = cvt_pk_bf16(v0[2], v0[3]); w.z = cvt_pk_bf16(v1[0], v1[1]); w.w = cvt_pk_bf16(v1[2], v1[3]); return w; }
struct EpiQKV {
    static constexpr bool PERM = true, AFTER_DRAIN = false;
    bf16_t* Q; bf16_t* K; bf16_t* V; const float* cs; float qscale;
    __device__ __forceinline__ void operator()(const f32x4 (&acc)[2][2][4][2], const Unit& u, int wr, int wc, int fr, int fq) const {
        const int row0 = u.pm * BM + wr * 64 + fr;
        bf16_t* base; int ld, colt; float sc = 1.f; bool rope = true;
        if (u.pn < 4) { base = Q; ld = 1024; colt = u.pn * BM; sc = qscale; }
        else if (u.pn == 4) { base = K; ld = 256; colt = 0; }
        else { base = V; ld = 256; colt = 0; rope = false; }
        const int col0 = colt + wc * 32 + 8 * fq;
        const bool dorope = rope && (wc == 0);
#pragma unroll
        for (int ai = 0; ai < 2; ++ai)
#pragma unroll
            for (int m = 0; m < 4; ++m) {
                const int row = row0 + ai * HALF + m * 16; const int pos = row & 8191;
                f32x4 c0 = {1.f, 1.f, 1.f, 1.f}, c1 = c0, s0 = {0.f, 0.f, 0.f, 0.f}, s1 = s0;
                if (dorope) { const float* t = cs + (size_t)pos * 32 + 8 * (fq & 1); c0 = *(const f32x4*)t; c1 = *(const f32x4*)(t + 4); s0 = *(const f32x4*)(t + 16); s1 = *(const f32x4*)(t + 20);
                    if (fq < 2) { s0 = -s0; s1 = -s1; } }
#pragma unroll
                for (int bj = 0; bj < 2; ++bj) {
                    f32x4 v0 = acc[ai][bj][m][0], v1 = acc[ai][bj][m][1];
                    if (dorope) { f32x4 p0, p1;
#pragma unroll
                        for (int j = 0; j < 4; ++j) { p0[j] = __shfl_xor(v0[j], 32); p1[j] = __shfl_xor(v1[j], 32); }
                        v0 = v0 * c0 + p0 * s0; v1 = v1 * c1 + p1 * s1; }
                    v0 = v0 * sc; v1 = v1 * sc;
                    *(u32x4*)(base + (size_t)row * ld + col0 + bj * HALF) = pack8(v0, v1);
                }
            }
    }
};
template <bool XF32> struct EpiRes {
    static constexpr bool PERM = true, AFTER_DRAIN = false;
    unsigned char* ws; const float* xin; const float* lng_all; const float* lnb_all; int k;
    __device__ __forceinline__ void operator()(const f32x4 (&acc)[2][2][4][2], const Unit& u, int wr, int wc, int fr, int fq) const {
        const int row0 = u.pm * BM + wr * 64 + fr, col0 = u.pn * BM + wc * 32 + 8 * fq;
        const int b = (u.pm * BM) >> 13;
        const void* xres = XF32 ? (const void*)xin : (const void*)(ws + WS_XB); bf16_t* out = (bf16_t*)(ws + WS_XB); constexpr float alpha = DN_ALPHA;
        const float* gate = (const float*)(ws + WS_MOD) + k * 12288 + 2048; const float* stat = (const float*)(ws + WS_STAT);
        const float* lng = lng_all + (k - 1) * 1024; const float* lnb = lnb_all + (k - 1) * 1024;
#pragma unroll
        for (int bj = 0; bj < 2; ++bj) {
            const f32x4 g0 = *(const f32x4*)(gate + b * 3072 + col0 + bj * HALF) + 1.0f, g1 = *(const f32x4*)(gate + b * 3072 + col0 + bj * HALF + 4) + 1.0f;
            f32x4 G0, G1, B0, B1;
            if (!XF32) { G0 = *(const f32x4*)(lng + col0 + bj * HALF); G1 = *(const f32x4*)(lng + col0 + bj * HALF + 4); B0 = *(const f32x4*)(lnb + col0 + bj * HALF); B1 = *(const f32x4*)(lnb + col0 + bj * HALF + 4); }
#pragma unroll
            for (int ai = 0; ai < 2; ++ai)
#pragma unroll
                for (int m = 0; m < 4; ++m) { const size_t off = (size_t)(row0 + ai * HALF + m * 16) * 1024 + col0 + bj * HALF;
                    f32x4 x0, x1;
                    if (XF32) { x0 = *(const f32x4*)((const float*)xres + off); x1 = *(const f32x4*)((const float*)xres + off + 4); }
                    else { const u32x4 w = *(const u32x4*)((const bf16_t*)xres + off);
                        x0 = (f32x4){__uint_as_float(w.x << 16), __uint_as_float(w.x & 0xffff0000u), __uint_as_float(w.y << 16), __uint_as_float(w.y & 0xffff0000u)};
                        x1 = (f32x4){__uint_as_float(w.z << 16), __uint_as_float(w.z & 0xffff0000u), __uint_as_float(w.w << 16), __uint_as_float(w.w & 0xffff0000u)};
                        typedef float f32x2e __attribute__((ext_vector_type(2))); const f32x2e sr = *(const f32x2e*)(stat + 2 * (row0 + ai * HALF + m * 16));
                        x0 = (x0 - sr.x) * sr.y * G0 + B0; x1 = (x1 - sr.x) * sr.y * G1 + B1; }
                    *(u32x4*)(out + off) = pack8(x0 * alpha + g0 * acc[ai][bj][m][0], x1 * alpha + g1 * acc[ai][bj][m][1]);
                    if (m & 1) asm volatile("" ::: "memory"); }
        }
    }
};
__device__ __forceinline__ float gelu_tanh(float x) { const float t = x * x * 0.044715f + 1.0f; const float e = __builtin_amdgcn_exp2f(-2.302208198f * (x * t)); return x * __builtin_amdgcn_rcpf(1.0f + e); }
template <int MODE> struct EpiAct {
    static constexpr bool PERM = true, AFTER_DRAIN = false;
    bf16_t* O; bf16_t* O2; int ldc;
    __device__ __forceinline__ void operator()(const f32x4 (&acc)[2][2][4][2], const Unit& u, int wr, int wc, int fr, int fq) const {
        const int row0 = u.pm * BM + wr * 64 + fr; int colt = u.pn * BM; bf16_t* base = O; bool act = (MODE == 0);
        if (MODE == 1 && u.pn >= 6) { base = O2; colt -= 1536; act = true; }
        const int col0 = colt + wc * 32 + 8 * fq;
#pragma unroll
        for (int ai = 0; ai < 2; ++ai)
#pragma unroll
            for (int m = 0; m < 4; ++m) { bf16_t* rowp = base + (size_t)(row0 + ai * HALF + m * 16) * ldc + col0;
#pragma unroll
                for (int bj = 0; bj < 2; ++bj) { f32x4 v0 = acc[ai][bj][m][0], v1 = acc[ai][bj][m][1];
                    if (act) {
#pragma unroll
                        for (int j = 0; j < 4; ++j) {
                            if (MODE == 0) { const float a = fmaxf(v0[j], 0.f), b = fmaxf(v1[j], 0.f); v0[j] = a * a; v1[j] = b * b; }
                            else { v0[j] = gelu_tanh(v0[j]); v1[j] = gelu_tanh(v1[j]); } } }
                    *(u32x4*)(rowp + bj * HALF) = pack8(v0, v1); } }
    }
};
template <class Epi, class Sched, bool ALIGN_EPI = false, bool SP2 = false>
__device__ __forceinline__ void gemm_phase(PG8_LAS unsigned char* lds, const Gemm g, const Sched& S, const Epi& E) {
    int tid_ = threadIdx.x; asm volatile("" : "+v"(tid_));
    const int tid = tid_, wid = __builtin_amdgcn_readfirstlane(tid >> 6), lane = tid & 63, wr = wid >> 2, wc = wid & 3, fr = lane & 15, fq = lane >> 4;
    const int K = g.K, nt = K / BK;
    unsigned voffA[2], voffB[2];
#pragma unroll
    for (int i = 0; i < 2; ++i) { int R, C; stage_rc(tid * 16 + i * 8192, R, C); const int Rb = Epi::PERM ? ((R & ~31) + perm32(R & 31)) : R;
        voffA[i] = (unsigned)(R * K + C) * 2u; voffB[i] = (unsigned)(Rb * K + C) * 2u; }
    const size_t kstep = (size_t)(BK * 2);
    const size_t hstep = (size_t)HALF * K * 2;
    const size_t tstep = 2 * hstep;
    const unsigned ldsw = (unsigned)wid * 1024u;
    const int aoff = lds_byte(wr * 64 + fr, fq * 8), boff = lds_byte(wc * 32 + fr, fq * 8);
#define PG8_SA(b, h) (((b) * 2 + (h)) * HTB)
#define PG8_SB(b, h) ((4 + (b) * 2 + (h)) * HTB)
#define PG8_STAGE(bufoff, gbase, voff) do { _Pragma("unroll") for (int _i = 0; _i < 2; ++_i) \
        __builtin_amdgcn_global_load_lds((const unsigned*)((const char*)(gbase) + (voff)[_i]), (PG8_LAS unsigned*)(lds + (bufoff) + ldsw + _i * 8192), 16, 0, 0); } while (0)
#define PG8_LDA(dst, b, h) do { _Pragma("unroll") for (int m = 0; m < 4; ++m) _Pragma("unroll") for (int k = 0; k < 2; ++k) dst[m][k] = *(const PG8_LAS bf16x8*)(lds + PG8_SA(b, h) + aoff + m * 2048 + k * 1024); } while (0)
#define PG8_LDB(dst, b, h) do { _Pragma("unroll") for (int n = 0; n < 2; ++n) _Pragma("unroll") for (int k = 0; k < 2; ++k) dst[n][k] = *(const PG8_LAS bf16x8*)(lds + PG8_SB(b, h) + boff + n * 2048 + k * 1024); } while (0)
#define PG8_MMA(ai, bj, At, Bt) do { __builtin_amdgcn_s_setprio(1); _Pragma("unroll") for (int m = 0; m < 4; ++m) _Pragma("unroll") for (int n = 0; n < 2; ++n) _Pragma("unroll") for (int k = 0; k < 2; ++k) \
        acc[ai][bj][m][n] = __builtin_amdgcn_mfma_f32_16x16x32_bf16(Bt[n][k], At[m][k], acc[ai][bj][m][n], 0, 0, 0); __builtin_amdgcn_s_setprio(0); } while (0)
#define PG8_WAIT_V(n) asm volatile("s_waitcnt vmcnt(" #n ")" ::: "memory")
#define PG8_WAIT_L(n) asm volatile("s_waitcnt lgkmcnt(" #n ")" ::: "memory")
#define PG8_BAR __builtin_amdgcn_s_barrier()
#define PG8_SCHED __builtin_amdgcn_sched_barrier(0)
    Unit cur, nxt; int ui = 0;
    if (!S.next(0, cur)) return;
    f32x4 acc[2][2][4][2];
#pragma unroll
    for (int a = 0; a < 2; ++a)
#pragma unroll
        for (int b = 0; b < 2; ++b)
#pragma unroll
            for (int m = 0; m < 4; ++m)
#pragma unroll
                for (int n = 0; n < 2; ++n) acc[a][b][m][n] = (f32x4){0.f, 0.f, 0.f, 0.f};
    bf16x8 At[4][2], B0[2][2], B1[2][2];
    const char* cA = (const char*)g.A + (size_t)cur.pm * tstep; const char* cB = (const char*)g.Bt + (size_t)cur.pn * tstep;
    S.a_ready(cur);
    if constexpr (SP2) {
        PG8_STAGE(PG8_SB(0, 0), cB, voffB); PG8_STAGE(PG8_SB(0, 1), cB + hstep, voffB); PG8_STAGE(PG8_SA(0, 0), cA, voffA); PG8_STAGE(PG8_SA(0, 1), cA + hstep, voffA);
        if (wr == 1) PG8_BAR;
        PG8_WAIT_V(2); PG8_BAR;
        PG8_STAGE(PG8_SB(1, 0), cB + kstep, voffB); PG8_STAGE(PG8_SA(1, 0), cA + kstep, voffA); PG8_STAGE(PG8_SB(1, 1), cB + hstep + kstep, voffB);
        PG8_WAIT_V(6); PG8_BAR;
    } else {
        PG8_STAGE(PG8_SB(0, 0), cB, voffB); PG8_STAGE(PG8_SA(0, 0), cA, voffA); PG8_STAGE(PG8_SB(0, 1), cB + hstep, voffB); PG8_STAGE(PG8_SA(0, 1), cA + hstep, voffA);
        if (wr == 1) PG8_BAR;
        PG8_WAIT_V(4); PG8_BAR;
        PG8_STAGE(PG8_SB(1, 0), cB + kstep, voffB); PG8_STAGE(PG8_SA(1, 0), cA + kstep, voffA); PG8_STAGE(PG8_SB(1, 1), cB + hstep + kstep, voffB);
        PG8_WAIT_V(6); PG8_BAR;
    }
    for (;;) {
        const bool has_next = S.next(ui + 1, nxt);
        const char* nA = has_next ? (const char*)g.A + (size_t)nxt.pm * tstep : cA; const char* nB = has_next ? (const char*)g.Bt + (size_t)nxt.pn * tstep : cB;
        for (int t = 0; t < nt; t += 2) {
            const bool last = (t == nt - 2);
            const char* a1 = cA + (size_t)(t + 1) * kstep;
            const char* a2 = last ? nA : cA + (size_t)(t + 2) * kstep; const char* b2 = last ? nB : cB + (size_t)(t + 2) * kstep;
            const char* a3 = a2 + kstep; const char* b3 = b2 + kstep;
            if (last && has_next) S.a_ready(nxt);
            if constexpr (SP2) {
            PG8_LDB(B0, 0, 0); PG8_LDB(B1, 0, 1); PG8_SCHED; PG8_LDA(At, 0, 0); PG8_STAGE(PG8_SA(1, 1), a1 + hstep, voffA);
            PG8_WAIT_V(8); PG8_WAIT_L(0); PG8_BAR; PG8_MMA(0, 0, At, B0); PG8_MMA(0, 1, At, B1); PG8_BAR; PG8_SCHED;
            PG8_LDA(At, 0, 1); PG8_STAGE(PG8_SB(0, 0), b2, voffB); PG8_STAGE(PG8_SB(0, 1), b2 + hstep, voffB); PG8_STAGE(PG8_SA(0, 0), a2, voffA);
            PG8_WAIT_V(8); PG8_WAIT_L(0); PG8_BAR; PG8_MMA(1, 0, At, B0); PG8_MMA(1, 1, At, B1); PG8_BAR; PG8_SCHED;
            PG8_LDB(B0, 1, 0); PG8_LDB(B1, 1, 1); PG8_SCHED; PG8_LDA(At, 1, 0); PG8_STAGE(PG8_SA(0, 1), a2 + hstep, voffA);
            PG8_WAIT_V(8); PG8_WAIT_L(0); PG8_BAR; PG8_MMA(0, 0, At, B0); PG8_MMA(0, 1, At, B1); PG8_BAR; PG8_SCHED;
            PG8_LDA(At, 1, 1); PG8_STAGE(PG8_SB(1, 0), b3, voffB); PG8_STAGE(PG8_SB(1, 1), b3 + hstep, voffB); PG8_STAGE(PG8_SA(1, 0), a3, voffA);
            PG8_WAIT_V(8); PG8_WAIT_L(0); PG8_BAR; PG8_MMA(1, 0, At, B0); PG8_MMA(1, 1, At, B1); PG8_BAR; PG8_SCHED;
            } else {
            PG8_LDB(B0, 0, 0); PG8_SCHED; PG8_LDA(At, 0, 0); PG8_STAGE(PG8_SA(1, 1), a1 + hstep, voffA);
            PG8_WAIT_L(8); PG8_BAR; PG8_WAIT_L(0); PG8_MMA(0, 0, At, B0); PG8_BAR; PG8_SCHED;
            PG8_LDB(B1, 0, 1); PG8_STAGE(PG8_SB(0, 0), b2, voffB);
            PG8_BAR; PG8_WAIT_L(0); PG8_MMA(0, 1, At, B1); PG8_BAR;
            PG8_LDA(At, 0, 1); PG8_STAGE(PG8_SA(0, 0), a2, voffA);
            PG8_BAR; PG8_WAIT_L(0); PG8_MMA(1, 0, At, B0); PG8_BAR; PG8_SCHED;
            PG8_STAGE(PG8_SB(0, 1), b2 + hstep, voffB);
            PG8_WAIT_V(6); PG8_BAR; PG8_MMA(1, 1, At, B1); PG8_BAR;
            PG8_LDB(B0, 1, 0); PG8_SCHED; PG8_LDA(At, 1, 0); PG8_STAGE(PG8_SA(0, 1), a2 + hstep, voffA);
            PG8_WAIT_L(8); PG8_BAR; PG8_WAIT_L(0); PG8_MMA(0, 0, At, B0); PG8_BAR; PG8_SCHED;
            PG8_LDB(B1, 1, 1); PG8_STAGE(PG8_SB(1, 0), b3, voffB);
            PG8_BAR; PG8_WAIT_L(0); PG8_MMA(0, 1, At, B1); PG8_BAR;
            PG8_LDA(At, 1, 1); PG8_STAGE(PG8_SA(1, 0), a3, voffA);
            PG8_BAR; PG8_WAIT_L(0); PG8_MMA(1, 0, At, B0); PG8_BAR; PG8_SCHED;
            PG8_STAGE(PG8_SB(1, 1), b3 + hstep, voffB);
            PG8_WAIT_V(6); PG8_BAR; PG8_MMA(1, 1, At, B1); PG8_BAR;
            }
        }
        if constexpr (ALIGN_EPI) { if (wr == 0) PG8_BAR; }
        if constexpr (!Epi::AFTER_DRAIN) { E(acc, cur, wr, wc, fr, fq); S.done(cur); }
        if (!has_next) break;
#pragma unroll
        for (int a = 0; a < 2; ++a)
#pragma unroll
            for (int b = 0; b < 2; ++b)
#pragma unroll
                for (int m = 0; m < 4; ++m)
#pragma unroll
                    for (int n = 0; n < 2; ++n) acc[a][b][m][n] = (f32x4){0.f, 0.f, 0.f, 0.f};
        cur = nxt; cA = nA; cB = nB; ++ui;
        if constexpr (ALIGN_EPI) { if (wr == 1) PG8_BAR; }
    }
    PG8_WAIT_V(0);
    if constexpr (!ALIGN_EPI) { if (wr == 0) PG8_BAR; }
    PG8_BAR;
    if constexpr (Epi::AFTER_DRAIN) { E.fused(acc, cur, wr, wc, fr, fq, lds, wid, lane); S.done(cur); }
#undef PG8_SA
#undef PG8_SB
#undef PG8_STAGE
#undef PG8_LDA
#undef PG8_LDB
#undef PG8_MMA
#undef PG8_WAIT_V
#undef PG8_WAIT_L
#undef PG8_BAR
#undef PG8_SCHED
}
}

#define LAS __attribute__((address_space(3)))
typedef unsigned short bf16;
typedef unsigned v4u __attribute__((ext_vector_type(4)));
typedef unsigned v2u __attribute__((ext_vector_type(2)));
typedef float f32x4 __attribute__((ext_vector_type(4)));
typedef float f32x2 __attribute__((ext_vector_type(2)));
typedef float f32x16 __attribute__((ext_vector_type(16)));
typedef short bf16x8 __attribute__((ext_vector_type(8)));
typedef short s16x4 __attribute__((ext_vector_type(4)));
typedef __bf16 bf16x2_t __attribute__((ext_vector_type(2)));
__device__ __forceinline__ unsigned pk2(float lo, float hi) { f32x2 v = {lo, hi}; bf16x2_t b = __builtin_convertvector(v, bf16x2_t); return __builtin_bit_cast(unsigned, b); }
__device__ __forceinline__ float bf2f(unsigned short h) { return __uint_as_float((unsigned)h << 16); }
__device__ __forceinline__ float wave_sum(float v) {
#pragma unroll
    for (int o = 1; o < 64; o <<= 1) v += __shfl_xor(v, o);
    return v;
}
__device__ __forceinline__ float sigmoidf_(float x) { return __builtin_amdgcn_rcpf(1.0f + __builtin_amdgcn_exp2f(-1.4426950408889634f * x)); }

struct Args { const float* in[20]; float* out; unsigned char* ws; };


#define GAS __attribute__((address_space(1)))
#define XB_TMO      128
#define XB_XCNT(j)  (256  + 64 * (j))
#define XB_XSUB(j)  (1280 + 64 * (j))
#define XB_XGEN(j)  (2304 + 64 * (j))
#define XB_TOP      3328
#define XB_TOPGEN   3392
#define XCD_BAR_WORDS 3456
#define XB_SPIN_CAP (1u << 18)

__device__ __forceinline__ unsigned xb_ld(unsigned* p)              { return __hip_atomic_load(p, __ATOMIC_RELAXED, __HIP_MEMORY_SCOPE_AGENT); }
__device__ __forceinline__ unsigned xb_add(unsigned* p, unsigned v) { return __hip_atomic_fetch_add(p, v, __ATOMIC_RELAXED, __HIP_MEMORY_SCOPE_AGENT); }
__device__ __forceinline__ unsigned xb_xcc_id() { return (unsigned)__builtin_amdgcn_s_getreg((3 << 11) | 20) & 0xFu; }
#define XB_SPIN(cond, bar) do { unsigned _sp = 0; while (cond) { __builtin_amdgcn_s_sleep(1); \
    if ((++_sp & 255u) == 0u) { if (xb_ld(&(bar)[XB_TMO])) break; if (_sp > XB_SPIN_CAP) { atomicAdd(&(bar)[XB_TMO], 1u); break; } } } } while (0)

struct XcdBarrier {
    unsigned* bar; unsigned x;
    volatile LAS unsigned* st;
};

__device__ __forceinline__ XcdBarrier xcd_barrier_post(unsigned* bar, volatile LAS unsigned* st) {
    XcdBarrier b; b.bar = bar; b.x = xb_xcc_id(); b.st = st;
    if (threadIdx.x == 0) (void)xb_add(&bar[XB_XCNT(b.x)], 1u);
    return b;
}
__device__ __forceinline__ void xcd_barrier_complete(unsigned* bar, unsigned x, unsigned& nloc, unsigned& nx) {
    const unsigned G = gridDim.x * gridDim.y * gridDim.z;
    unsigned sum, cnt, mine, sp = 0u;
    for (;;) {
        sum = 0u; cnt = 0u; mine = 0u;
#pragma unroll
        for (unsigned j = 0; j < 16; ++j) { const unsigned c = xb_ld(&bar[XB_XCNT(j)]); sum += c; cnt += (c > 0u) ? 1u : 0u; mine = (j == x) ? c : mine; }
        if (sum == G) break;
        __builtin_amdgcn_s_sleep(1);
        if ((++sp & 255u) == 0u) { if (xb_ld(&bar[XB_TMO])) break; if (sp > XB_SPIN_CAP) { atomicAdd(&bar[XB_TMO], 1u); break; } }
    }
    nloc = mine > 0u ? mine : 1u; nx = cnt > 0u ? cnt : 1u;
}

__device__ __forceinline__ void xcd_barrier(const XcdBarrier& b) {
    asm volatile("s_waitcnt vmcnt(0)" ::: "memory");
    __syncthreads();
    if (threadIdx.x == 0) {
        unsigned* bar = b.bar;
        __builtin_amdgcn_s_waitcnt(0);
        unsigned nloc = b.st[0], nx = b.st[1];
        if (nloc == 0u) { xcd_barrier_complete(bar, b.x, nloc, nx); b.st[0] = nloc; b.st[1] = nx; }
        const unsigned old = xb_add(&bar[XB_XSUB(b.x)], 1u);
        const unsigned gen = old / nloc;
        if (old + 1u == (gen + 1u) * nloc) {
            __builtin_amdgcn_fence(__ATOMIC_RELEASE, "agent");
            asm volatile("s_waitcnt vmcnt(0)" ::: "memory");
            const unsigned og = xb_add(&bar[XB_TOP], 1u);
            const unsigned tg = og / nx;
            if (og + 1u == (tg + 1u) * nx) xb_add(&bar[XB_TOPGEN], 1u);
            else XB_SPIN(xb_ld(&bar[XB_TOPGEN]) == tg, bar);
            __builtin_amdgcn_fence(__ATOMIC_ACQUIRE, "agent");
            xb_add(&bar[XB_XGEN(b.x)], 1u);
            asm volatile("s_waitcnt vmcnt(0)" ::: "memory");
        } else {
            XB_SPIN(xb_ld(&bar[XB_XGEN(b.x)]) == gen, bar);
            __builtin_amdgcn_fence(__ATOMIC_ACQUIRE, "agent");
            asm volatile("s_waitcnt vmcnt(0)" ::: "memory");
        }
    }
    __syncthreads();
}

__device__ __forceinline__ void p0_transpose_item(const float* W, int K, int N, bf16* WT, LAS float* scr, int item, int lane) {
    const int nblk = N / 32, kb = item / nblk, nb = item % nblk, k0 = 64 * kb, n0 = 32 * nb;
    float wv_[32];
#pragma unroll
    for (int i = 0; i < 32; ++i) wv_[i] = W[(size_t)(k0 + 2 * i + (lane >> 5)) * N + n0 + (lane & 31)];
#pragma unroll
    for (int i = 0; i < 32; ++i) scr[(2 * i + (lane >> 5)) * 33 + (lane & 31)] = wv_[i];
    asm volatile("s_waitcnt lgkmcnt(0)" ::: "memory");
    const int c = lane & 7;
#pragma unroll
    for (int j = 0; j < 4; ++j) { const int n = (lane >> 3) + 8 * j; const LAS float* s = scr + (8 * c) * 33 + n;
        v4u o; o.x = pk2(s[0 * 33], s[1 * 33]); o.y = pk2(s[2 * 33], s[3 * 33]); o.z = pk2(s[4 * 33], s[5 * 33]); o.w = pk2(s[6 * 33], s[7 * 33]);
        *(v4u*)(WT + (size_t)(n0 + n) * K + k0 + 8 * c) = o; }
    asm volatile("s_waitcnt lgkmcnt(0)" ::: "memory");
}

__device__ __forceinline__ void p0_prologue(const Args& a, LAS unsigned char* lds, int tid, int lane, int wave, int G, int bid) {
    unsigned char* ws = a.ws;
    {
        LAS float* sc = (LAS float*)lds;
        LAS float* red = (LAS float*)(lds + 16384);
        const float* c = a.in[1];
        for (int i = tid; i < 4096; i += NTHR) { const float v = c[i]; sc[i] = v / (1.0f + __expf(-v)); }
        __syncthreads();
        for (int item = bid; item < 192; item += G) {
            const int s = item / 48, n0 = (item % 48) * 64;
            const float* w = a.in[2] + (size_t)s * 1024 * 3072 + n0 + lane;
            float acc0 = 0.f, acc1 = 0.f, acc2 = 0.f, acc3 = 0.f;
            const int kbeg = wave * 128;
#pragma unroll 16
            for (int k = 0; k < 128; ++k) { const float wv = w[(size_t)(kbeg + k) * 3072];
                acc0 += wv * sc[kbeg + k]; acc1 += wv * sc[1024 + kbeg + k]; acc2 += wv * sc[2048 + kbeg + k]; acc3 += wv * sc[3072 + kbeg + k]; }
            red[(wave * 4 + 0) * 64 + lane] = acc0; red[(wave * 4 + 1) * 64 + lane] = acc1; red[(wave * 4 + 2) * 64 + lane] = acc2; red[(wave * 4 + 3) * 64 + lane] = acc3;
            __syncthreads();
            if (tid < 256) { const int b = tid >> 6, l = tid & 63; float t = a.in[3][s * 3072 + n0 + l];
#pragma unroll
                for (int wv = 0; wv < 8; ++wv) t += red[(wv * 4 + b) * 64 + l];
                ((float*)(ws + WS_MOD))[(s * 4 + b) * 3072 + n0 + l] = t; }
            __syncthreads();
        }
    }
    __syncthreads();
    {
        const float invf[16] = {1.000000000e+00f, 4.403665960e-01f, 1.939227432e-01f, 8.539710194e-02f, 3.760603070e-02f, 1.656043902e-02f, 7.292664610e-03f, 3.211445874e-03f,
                                1.414213562e-03f, 6.227723788e-04f, 2.742481884e-04f, 1.207697351e-04f, 5.318296098e-05f, 2.341999971e-05f, 1.031338616e-05f, 4.541670478e-06f};
        float* cs = (float*)(ws + WS_CS);
        for (int idx = bid * NTHR + tid; idx < 8192 * 16; idx += G * NTHR) {
            const int pos = idx >> 4, i = idx & 15;
            float f = invf[0];
#pragma unroll
            for (int q = 1; q < 16; ++q) f = (i == q) ? invf[q] : f;
            const float ang = (float)pos * f;
            double t = (double)ang * 0.15915494309189535; t -= __builtin_rint(t);
            const float r = (float)t;
            cs[pos * 32 + i] = __builtin_amdgcn_cosf(r); cs[pos * 32 + 16 + i] = __builtin_amdgcn_sinf(r);
        }
    }
    { float* sp8 = (float*)(ws + WS_SP8); for (int idx = bid * NTHR + tid; idx < 2 * DRNN; idx += G * NTHR) sp8[idx] = 8.0f * log1pf(__expf(-a.in[16][idx])); }
    {
        bf16* wg = (bf16*)(ws + WS_WG);
        for (int idx = bid * NTHR + tid; idx < 2 * 16 * 2 * 96 * 96; idx += G * NTHR) {
            const int i = idx % 96, j = (idx / 96) % 96, gate = (idx / 9216) & 1, n = (idx / 18432) & 15, dir = idx / 294912;
            const float* src = gate ? a.in[14] : a.in[12];
            const float v = src[((size_t)(dir * 16 + n) * 96 + i) * 96 + j];
            wg[idx] = (bf16)(pk2(v, 0.f) & 0xffffu);
        }
    }
    {
        LAS float* scr = (LAS float*)(lds + wave * 16384);
        const int gw = bid * NWAVES + wave, NGW = G * NWAVES;
        constexpr int I_QKV = 16 * 48, I_O = 16 * 32, I_RIN = 16 * 96, I_ROUT = 24 * 32, I_1 = 16 * 128, I_2 = 64 * 32;
        constexpr int NITEMS = I_QKV + I_O + I_RIN + I_ROUT + 2 * I_1 + 2 * I_2;
        for (int it = gw; it < NITEMS; it += NGW) {
            int r = it;
            if (r < I_QKV) { p0_transpose_item(a.in[6], 1024, 1536, (bf16*)(ws + WS_WQKV), scr, r, lane); continue; } r -= I_QKV;
            if (r < I_O) { p0_transpose_item(a.in[7], 1024, 1024, (bf16*)(ws + WS_WO), scr, r, lane); continue; } r -= I_O;
            if (r < I_RIN) { p0_transpose_item(a.in[9], 1024, 3072, (bf16*)(ws + WS_WRIN), scr, r, lane); continue; } r -= I_RIN;
            if (r < I_ROUT) { p0_transpose_item(a.in[17], 1536, 1024, (bf16*)(ws + WS_WROUT), scr, r, lane); continue; } r -= I_ROUT;
            if (r < I_1) { p0_transpose_item(a.in[18], 1024, 4096, (bf16*)(ws + WS_W1), scr, r, lane); continue; } r -= I_1;
            if (r < I_1) { p0_transpose_item(a.in[18] + (size_t)1024 * 4096, 1024, 4096, (bf16*)(ws + WS_W1) + (size_t)4096 * 1024, scr, r, lane); continue; } r -= I_1;
            if (r < I_2) { p0_transpose_item(a.in[19], 4096, 1024, (bf16*)(ws + WS_W2), scr, r, lane); continue; } r -= I_2;
            p0_transpose_item(a.in[19] + (size_t)4096 * 1024, 4096, 1024, (bf16*)(ws + WS_W2) + (size_t)1024 * 4096, scr, r, lane);
        }
    }
}

template <bool DO_LN, bool IN_F32, bool OUT_F32> __device__ __forceinline__ void ln_mod_phase(const void* xin, void* xout, bf16* hout, const float* lng, const float* lnb, const float* mod, float* stat, int lane, int wave, int G, int bid) {
    const int gw = bid * NWAVES + wave, NGW = G * NWAVES;
    for (int row = gw; row < M; row += NGW) {
        f32x4 v[4];
#pragma unroll
        for (int j = 0; j < 2; ++j) { const size_t e = (size_t)row * DM + 512 * j + 8 * lane;
            if (IN_F32) { v[2 * j] = *(const f32x4*)((const float*)xin + e); v[2 * j + 1] = *(const f32x4*)((const float*)xin + e + 4); }
            else { const v4u w = *(const v4u*)((const bf16*)xin + e);
                v[2 * j] = (f32x4){__uint_as_float(w.x << 16), __uint_as_float(w.x & 0xffff0000u), __uint_as_float(w.y << 16), __uint_as_float(w.y & 0xffff0000u)};
                v[2 * j + 1] = (f32x4){__uint_as_float(w.z << 16), __uint_as_float(w.z & 0xffff0000u), __uint_as_float(w.w << 16), __uint_as_float(w.w & 0xffff0000u)}; } }
        if (DO_LN) {
            float s = 0.f;
#pragma unroll
            for (int j = 0; j < 4; ++j) s += (v[j].x + v[j].y) + (v[j].z + v[j].w);
            const float mean = wave_sum(s) * (1.f / DM); float s2 = 0.f;
#pragma unroll
            for (int j = 0; j < 4; ++j) { v[j] = v[j] - mean; s2 += (v[j].x * v[j].x + v[j].y * v[j].y) + (v[j].z * v[j].z + v[j].w * v[j].w); }
            const float rstd = __builtin_amdgcn_rsqf(wave_sum(s2) * (1.f / DM) + LN_EPS);
            if (stat && lane == 0) { stat[2 * row] = mean; stat[2 * row + 1] = rstd; }
#pragma unroll
            for (int j = 0; j < 4; ++j) { const int c = 512 * (j >> 1) + 8 * lane + 4 * (j & 1); const f32x4 g = *(const f32x4*)(lng + c), bb = *(const f32x4*)(lnb + c); v[j] = v[j] * rstd * g + bb; }
        }
        if (xout) {
#pragma unroll
            for (int j = 0; j < 2; ++j) { const size_t e = (size_t)row * DM + 512 * j + 8 * lane;
                if (OUT_F32) { *(f32x4*)((float*)xout + e) = v[2 * j]; *(f32x4*)((float*)xout + e + 4) = v[2 * j + 1]; }
                else { v4u w; w.x = pk2(v[2 * j].x, v[2 * j].y); w.y = pk2(v[2 * j].z, v[2 * j].w); w.z = pk2(v[2 * j + 1].x, v[2 * j + 1].y); w.w = pk2(v[2 * j + 1].z, v[2 * j + 1].w); *(v4u*)((bf16*)xout + e) = w; } } }
        if (hout) { const int b = row >> 13; const float* sh = mod + b * 3072; const float* scl = mod + b * 3072 + 1024;
#pragma unroll
            for (int j = 0; j < 2; ++j) { const int c = 512 * j + 8 * lane;
                const f32x4 h0 = v[2 * j] * (*(const f32x4*)(scl + c) + 1.0f) + *(const f32x4*)(sh + c), h1 = v[2 * j + 1] * (*(const f32x4*)(scl + c + 4) + 1.0f) + *(const f32x4*)(sh + c + 4);
                v4u w; w.x = pk2(h0.x, h0.y); w.y = pk2(h0.z, h0.w); w.z = pk2(h1.x, h1.y); w.w = pk2(h1.z, h1.w); *(v4u*)(hout + (size_t)row * DM + c) = w; } }
    }
}

__device__ __forceinline__ unsigned off_b(unsigned row, unsigned ch) { return 256u * row + 16u * (ch ^ (((row & 3) << 2) | ((row >> 2) & 3))); }
__device__ __forceinline__ s16x4 vtr(const LAS unsigned char* p) { typedef short v4i16_t __attribute__((ext_vector_type(4))); return __builtin_bit_cast(s16x4, __builtin_amdgcn_ds_read_tr16_b64_v4i16((LAS v4i16_t*)p)); }
__device__ __forceinline__ void attn_phase(LAS unsigned char* lds, const bf16* Q, const bf16* K, const bf16* V, bf16* O, const float* sinks, int tid, int lane, int wave, int G, int bid) {
    const int r32 = lane & 31, h = lane >> 5;
    const int blk = (lane >> 4) & 1, q4 = (lane & 15) >> 2, p4 = lane & 3;
    unsigned kofs[8], vofs[4][2];
    { const unsigned swzk = ((r32 & 3) << 2) | ((r32 >> 2) & 3);
#pragma unroll
      for (int s_ = 0; s_ < 8; ++s_) kofs[s_] = 256u * r32 + 16u * ((2u * s_ + h) ^ swzk);
#pragma unroll
      for (int c = 0; c < 4; ++c)
#pragma unroll
          for (int t_ = 0; t_ < 2; ++t_) { const unsigned xr = ((unsigned)q4 << 2) | ((h + 2u * t_) & 3u); vofs[c][t_] = 256u * (4u * h + q4) + 16u * ((4u * c + 2u * blk + (p4 >> 1)) ^ xr) + 8u * (p4 & 1); } }
    for (int unit = bid; unit < 1024; unit += G) {
        const int u = unit & 127, kvh = (unit >> 7) & 1, b = unit >> 8;
        const int head = kvh * 4 + (wave >> 1); const int qpos = 64 * u + 32 * (wave & 1) + r32;
        const size_t tokbase = (size_t)b * SEQ;
        bf16x8 qf[8];
        { const bf16* qp = Q + (tokbase + qpos) * 1024 + head * 128 + 8 * h;
#pragma unroll
          for (int s = 0; s < 8; ++s) qf[s] = *(const bf16x8*)(qp + 16 * s); }
        float mrun = sinks[head] * LOG2E; float lrun = (h == 0) ? 1.f : 0.f;
        f32x16 o[4];
#pragma unroll
        for (int c = 0; c < 4; ++c)
#pragma unroll
            for (int i = 0; i < 16; ++i) o[c][i] = 0.f;
        const int c_lo = (u < 2) ? 2 - u : 0, c_hi = (u > 125) ? 129 - u : 4;
        const int lrow0 = tid >> 4, lch = tid & 15;
        v4u kreg[2], vreg[2];
        __syncthreads();
        { const int kc = u - 2 + c_lo;
#pragma unroll
          for (int i = 0; i < 2; ++i) { const size_t g = (tokbase + 64 * kc + lrow0 + 32 * i) * 256 + kvh * 128 + lch * 8; kreg[i] = *(const v4u*)(K + g); vreg[i] = *(const v4u*)(V + g); }
#pragma unroll
          for (int i = 0; i < 2; ++i) { const unsigned ob = off_b(lrow0 + 32 * i, lch); *(LAS v4u*)(lds + ob) = kreg[i]; *(LAS v4u*)(lds + 32768 + ob) = vreg[i]; } }
        __syncthreads();
        for (int ci = c_lo; ci <= c_hi; ++ci) {
            const int buf = (ci - c_lo) & 1; const int kc = u - 2 + ci;
            const bool more = ci < c_hi;
            if (more) {
#pragma unroll
                for (int i = 0; i < 2; ++i) { const size_t g = (tokbase + 64 * (kc + 1) + lrow0 + 32 * i) * 256 + kvh * 128 + lch * 8; kreg[i] = *(const v4u*)(K + g); vreg[i] = *(const v4u*)(V + g); } }
            const LAS unsigned char* Kb = lds + buf * 16384; const LAS unsigned char* Vb = lds + 32768 + buf * 16384;
            f32x16 sa[2];
#pragma unroll
            for (int kt = 0; kt < 2; ++kt) {
#pragma unroll
                for (int i = 0; i < 16; ++i) sa[kt][i] = 0.f;
#pragma unroll
                for (int s = 0; s < 8; ++s) { const bf16x8 kf = *(const LAS bf16x8*)(Kb + kofs[s] + 8192 * kt); sa[kt] = __builtin_amdgcn_mfma_f32_32x32x16_bf16(kf, qf[s], sa[kt], 0, 0, 0); }
            }
            float mx = -INFINITY;
            if (ci == 0 || ci == 4) {
#pragma unroll
                for (int kt = 0; kt < 2; ++kt)
#pragma unroll
                    for (int i = 0; i < 16; ++i) { const int kp = 64 * kc + 32 * kt + (i & 3) + 8 * (i >> 2) + 4 * h; const int d = qpos - kp; if (d > 128 || d < -128) sa[kt][i] = -INFINITY; }
            }
            { f32x4 m4 = (f32x4){sa[0][0], sa[0][1], sa[0][2], sa[0][3]};
#pragma unroll
              for (int kt = 0; kt < 2; ++kt)
#pragma unroll
                  for (int g = 0; g < 4; ++g) m4 = __builtin_elementwise_max(m4, (f32x4){sa[kt][4 * g], sa[kt][4 * g + 1], sa[kt][4 * g + 2], sa[kt][4 * g + 3]});
              mx = fmaxf(fmaxf(m4.x, m4.y), fmaxf(m4.z, m4.w)); }
            mx = fmaxf(mx, __shfl_xor(mx, 32));
            const float mnew = fmaxf(mrun, mx); const float alpha = __builtin_amdgcn_exp2f(mrun - mnew); mrun = mnew;
            float ls = 0.f;
#pragma unroll
            for (int kt = 0; kt < 2; ++kt) {
                sa[kt] = sa[kt] - mnew;
#pragma unroll
                for (int i = 0; i < 16; ++i) sa[kt][i] = __builtin_amdgcn_exp2f(sa[kt][i]);
                f32x4 q4s = (f32x4){sa[kt][0], sa[kt][1], sa[kt][2], sa[kt][3]} + (f32x4){sa[kt][4], sa[kt][5], sa[kt][6], sa[kt][7]} + (f32x4){sa[kt][8], sa[kt][9], sa[kt][10], sa[kt][11]} + (f32x4){sa[kt][12], sa[kt][13], sa[kt][14], sa[kt][15]};
                ls += (q4s.x + q4s.y) + (q4s.z + q4s.w);
            }
            lrun = lrun * alpha + ls;
            if (__any(alpha != 1.0f)) {
#pragma unroll
                for (int c = 0; c < 4; ++c) o[c] = o[c] * alpha;
            }
#pragma unroll
            for (int kt = 0; kt < 2; ++kt)
#pragma unroll
                for (int s2 = 0; s2 < 2; ++s2) {
                    v4u pw; pw.x = pk2(sa[kt][8 * s2 + 0], sa[kt][8 * s2 + 1]); pw.y = pk2(sa[kt][8 * s2 + 2], sa[kt][8 * s2 + 3]); pw.z = pk2(sa[kt][8 * s2 + 4], sa[kt][8 * s2 + 5]); pw.w = pk2(sa[kt][8 * s2 + 6], sa[kt][8 * s2 + 7]);
                    const bf16x8 pf = __builtin_bit_cast(bf16x8, pw);
#pragma unroll
                    for (int c = 0; c < 4; ++c) {
                        const s16x4 lo = vtr(Vb + vofs[c][0] + (8192 * kt + 4096 * s2));
                        const s16x4 hi = vtr(Vb + vofs[c][1] + (8192 * kt + 4096 * s2 + 2048));
                        const bf16x8 vf = __builtin_shufflevector(lo, hi, 0, 1, 2, 3, 4, 5, 6, 7);
                        o[c] = __builtin_amdgcn_mfma_f32_32x32x16_bf16(vf, pf, o[c], 0, 0, 0);
                    }
                }
            if (more) {
#pragma unroll
                for (int i = 0; i < 2; ++i) { const unsigned ob = off_b(lrow0 + 32 * i, lch); *(LAS v4u*)(lds + (buf ^ 1) * 16384 + ob) = kreg[i]; *(LAS v4u*)(lds + 32768 + (buf ^ 1) * 16384 + ob) = vreg[i]; } }
            __syncthreads();
        }
        lrun += __shfl_xor(lrun, 32);
        const float rl = 1.0f / lrun;
        bf16* op = O + (tokbase + qpos) * 1024 + head * 128 + 4 * h;
#pragma unroll
        for (int c = 0; c < 4; ++c)
#pragma unroll
            for (int g = 0; g < 4; ++g) { v2u w; w.x = pk2(o[c][4 * g] * rl, o[c][4 * g + 1] * rl); w.y = pk2(o[c][4 * g + 2] * rl, o[c][4 * g + 3] * rl); *(v2u*)(op + 32 * c + 8 * g) = w; }
    }
}

constexpr int RL_XCB = 0, RL_XCT = 13312, RL_XRS = 27136, RL_T = 40000, RL_YO = 46144, RL_YOSZ = 26624, RL_PAR = 99392;
template <bool FINAL> __device__ __forceinline__ void rnn_phase(LAS unsigned char* lds, const bf16* XR, bf16* GG, const float* conv_w, const float* conv_b, const bf16* Wg,
        const float* b_a, const float* b_x, const float* sp8t, f32x2* agg, const float* cin, int tid, int lane, int wave, int G, int bid) {
    LAS unsigned short* XCB = (LAS unsigned short*)(lds + RL_XCB); LAS unsigned short* XCT = (LAS unsigned short*)(lds + RL_XCT); LAS unsigned short* XRS = (LAS unsigned short*)(lds + RL_XRS);
    LAS f32x2* T = (LAS f32x2*)(lds + RL_T); LAS float* YO = (LAS float*)(lds + RL_YO); LAS float* PAR = (LAS float*)(lds + RL_PAR);
    const int n = bid & 15, slot = bid >> 4, nslots = (G + 15 - n) >> 4;
    const int xr_r0 = tid / 12, xr_c0 = tid % 12, xr_r1 = (tid + 512) / 12, xr_c1 = (tid + 512) % 12; const bool xr_v1 = (tid + 512) < 67 * 12;
    const int cc = tid % 96, ctq = tid / 96; const int ccg = 96 * n + cc;
    float cw0 = 0.f, cw1 = 0.f, cw2 = 0.f, cw3 = 0.f, cbb = 0.f;
    if (tid < 384) { cw0 = conv_w[ccg]; cw1 = conv_w[DRNN + ccg]; cw2 = conv_w[2 * DRNN + ccg]; cw3 = conv_w[3 * DRNN + ccg]; cbb = conv_b[ccg]; }
    const int rtp = wave & 1, dir = wave >> 2, cth = (wave >> 1) & 1, l15 = lane & 15, l4 = lane >> 4; const bool fwd = (dir == 0);
    const bf16* wlane = Wg + ((size_t)((dir * 16 + n) * 2) * 96 + l15) * 96 + 8 * l4;
    __syncthreads();
    for (int i = tid; i < 576; i += NTHR) { const int d_ = i / 288, w_ = (i / 96) % 3, c_ = i % 96; const float* src = (w_ == 0) ? b_a : (w_ == 1) ? b_x : sp8t; PAR[i] = src[d_ * DRNN + 96 * n + c_]; }
    v4u xq0 = {0u, 0u, 0u, 0u}, xq1 = {0u, 0u, 0u, 0u};
#define RNN_LOAD_XR(pair) do { const int b_ = (pair) >> 7, ch_ = (pair) & 127; const size_t tb_ = (size_t)b_ * SEQ; const int tk0 = 64 * ch_ - 2 + xr_r0, tk1 = 64 * ch_ - 2 + xr_r1; \
        xq0 = (v4u){0u, 0u, 0u, 0u}; xq1 = xq0; \
        if (tk0 >= 0 && tk0 < SEQ) xq0 = *(const v4u*)(XR + (tb_ + tk0) * DRNN + 96 * n + 8 * xr_c0); \
        if (xr_v1 && tk1 >= 0 && tk1 < SEQ) xq1 = *(const v4u*)(XR + (tb_ + tk1) * DRNN + 96 * n + 8 * xr_c1); } while (0)
    bf16x8 wa[3][3], wx[3][3];
#pragma unroll
    for (int i = 0; i < 3; ++i)
#pragma unroll
        for (int ks = 0; ks < 3; ++ks) { wa[i][ks] = *(const bf16x8*)(wlane + (size_t)(16 * (3 * cth + i)) * 96 + 32 * ks); wx[i][ks] = *(const bf16x8*)(wlane + (size_t)(96 + 16 * (3 * cth + i)) * 96 + 32 * ks); }
    int pair = slot;
    if (pair < 512) RNN_LOAD_XR(pair);
    for (; pair < 512; pair += nslots) {
        const int b = pair >> 7, chunk = pair & 127; const size_t tokbase = (size_t)b * SEQ; const int t0 = 64 * chunk;
        *(LAS v4u*)(XRS + xr_r0 * 96 + xr_c0 * 8) = xq0; if (xr_v1) *(LAS v4u*)(XRS + xr_r1 * 96 + xr_c1 * 8) = xq1;
        __syncthreads();
        if (pair + nslots < 512) RNN_LOAD_XR(pair + nslots);
        v4u gq0 = {0u, 0u, 0u, 0u}, gq1 = gq0; float cinr[3] = {0.f, 0.f, 0.f};
        if (FINAL) {
            gq0 = *(const v4u*)(GG + (tokbase + t0 + tid / 12) * DRNN + 96 * n + 8 * (tid % 12));
            if (tid < 256) gq1 = *(const v4u*)(GG + (tokbase + t0 + (tid + 512) / 12) * DRNN + 96 * n + 8 * ((tid + 512) % 12));
#pragma unroll
            for (int i = 0; i < 3; ++i) cinr[i] = cin[((size_t)(b * 128 + chunk) * 2 + dir) * DRNN + 96 * n + 16 * (3 * cth + i) + l15];
        }
        if (tid < 384) {
            float x0 = bf2f(XRS[(16 * ctq + 0) * 96 + cc]), x1 = bf2f(XRS[(16 * ctq + 1) * 96 + cc]), x2 = bf2f(XRS[(16 * ctq + 2) * 96 + cc]);
#pragma unroll
            for (int k = 0; k < 16; ++k) { const int t = 16 * ctq + k; const float x3 = bf2f(XRS[(t + 3) * 96 + cc]);
                const float v = cbb + x0 * cw0 + x1 * cw1 + x2 * cw2 + x3 * cw3;
                const unsigned short vb = (unsigned short)(pk2(v, 0.f) & 0xffffu);
                XCB[t * 104 + cc] = vb; XCT[cc * 72 + t] = vb;
                x0 = x1; x1 = x2; x2 = x3; } }
        __syncthreads();
        float ar[6][4], ur[6][4], Ae[6], He[6];
#pragma unroll
        for (int tt = 0; tt < 2; ++tt) {
            const int rt = 2 * rtp + tt;
            bf16x8 xa[3];
#pragma unroll
            for (int ks = 0; ks < 3; ++ks) xa[ks] = *(const LAS bf16x8*)(XCB + (16 * rt + l15) * 104 + 32 * ks + 8 * l4);
#pragma unroll
            for (int i = 0; i < 3; ++i) {
                const int it = tt * 3 + i;
                f32x4 ga = {0.f, 0.f, 0.f, 0.f}, gx = {0.f, 0.f, 0.f, 0.f};
#pragma unroll
                for (int ks = 0; ks < 3; ++ks) {
                    ga = __builtin_amdgcn_mfma_f32_16x16x32_bf16(xa[ks], wa[i][ks], ga, 0, 0, 0);
                    gx = __builtin_amdgcn_mfma_f32_16x16x32_bf16(xa[ks], wx[i][ks], gx, 0, 0, 0);
                }
                const int c = 16 * (3 * cth + i) + l15;
                const float ba = PAR[dir * 288 + c], bx = PAR[dir * 288 + 96 + c], lm = PAR[dir * 288 + 192 + c];
                const v2u xcw = *(const LAS v2u*)(XCT + c * 72 + 16 * rt + 4 * l4);
                const float xc[4] = {__uint_as_float(xcw.x << 16), __uint_as_float(xcw.x & 0xffff0000u), __uint_as_float(xcw.y << 16), __uint_as_float(xcw.y & 0xffff0000u)};
#pragma unroll
                for (int p2 = 0; p2 < 2; ++p2) {
                    const f32x2 za = (f32x2){ga[2 * p2], ga[2 * p2 + 1]} + ba, zx = (f32x2){gx[2 * p2], gx[2 * p2 + 1]} + bx;
                    const f32x2 ta = za * (-1.4426950408889634f), tx = zx * (-1.4426950408889634f);
                    const f32x2 da = (f32x2){__builtin_amdgcn_exp2f(ta.x), __builtin_amdgcn_exp2f(ta.y)} + 1.0f, dx = (f32x2){__builtin_amdgcn_exp2f(tx.x), __builtin_amdgcn_exp2f(tx.y)} + 1.0f;
                    const f32x2 ra = {__builtin_amdgcn_rcpf(da.x), __builtin_amdgcn_rcpf(da.y)}, ii = {__builtin_amdgcn_rcpf(dx.x), __builtin_amdgcn_rcpf(dx.y)};
                    const f32x2 la = ra * (-lm);
                    const f32x2 tl = la * 1.4426950408889634f;
                    const f32x2 x = la + la;
                    f32x2 pz = x * (1.0f / 24.0f) + (1.0f / 6.0f); pz = pz * x + 0.5f; pz = pz * x + 1.0f;
                    const f32x2 m2 = x * pz;
                    const f32x2 w2 = ii * (f32x2){xc[2 * p2], xc[2 * p2 + 1]};
                    const f32x2 uu = (f32x2){__builtin_amdgcn_sqrtf(-m2.x), __builtin_amdgcn_sqrtf(-m2.y)} * w2;
                    ar[it][2 * p2] = __builtin_amdgcn_exp2f(tl.x); ar[it][2 * p2 + 1] = __builtin_amdgcn_exp2f(tl.y);
                    ur[it][2 * p2] = uu.x; ur[it][2 * p2 + 1] = uu.y;
                }
                float A = 1.f, H = 0.f;
#pragma unroll
                for (int k = 0; k < 4; ++k) { const int r = fwd ? k : 3 - k; H = ar[it][r] * H + ur[it][r]; A *= ar[it][r]; }
                const int p = fwd ? l4 : 3 - l4;
#pragma unroll
                for (int d = 1; d <= 2; d <<= 1) {
                    const int src = fwd ? lane - 16 * d : lane + 16 * d;
                    const float Ap = __shfl(A, src & 63), Hp = __shfl(H, src & 63);
                    if (p >= d) { H = A * Hp + H; A = Ap * A; }
                }
                { const int src = fwd ? lane - 16 : lane + 16;
                  const float Ap = __shfl(A, src & 63), Hp = __shfl(H, src & 63);
                  Ae[it] = (p >= 1) ? Ap : 1.f; He[it] = (p >= 1) ? Hp : 0.f; }
                if (p == 3) T[(dir * 4 + rt) * 96 + c] = (f32x2){A, H};
            }
        }
        __syncthreads();
        if (!FINAL) {
            if (rtp == 0 && l4 == 0) {
#pragma unroll
                for (int i = 0; i < 3; ++i) { const int c = 16 * (3 * cth + i) + l15; float A = 1.f, H = 0.f;
#pragma unroll
                    for (int k = 0; k < 4; ++k) { const f32x2 tv = T[(dir * 4 + (fwd ? k : 3 - k)) * 96 + c]; H = tv.x * H + tv.y; A *= tv.x; }
                    agg[((size_t)(b * 128 + chunk) * 2 + dir) * DRNN + 96 * n + c] = (f32x2){A, H}; }
            }
        } else {
            LAS float* YOd = YO + dir * (RL_YOSZ / 4);
#pragma unroll
            for (int tt = 0; tt < 2; ++tt) {
                const int rt = 2 * rtp + tt;
#pragma unroll
                for (int i = 0; i < 3; ++i) { const int it = tt * 3 + i; const int c = 16 * (3 * cth + i) + l15;
                    float Hc = cinr[i];
#pragma unroll
                    for (int k = 0; k < 3; ++k) { const int tq = fwd ? k : 3 - k; const bool before = fwd ? (tq < rt) : (tq > rt); const f32x2 tv = T[(dir * 4 + tq) * 96 + c]; if (before) Hc = tv.x * Hc + tv.y; }
                    float h = Ae[it] * Hc + He[it];
#pragma unroll
                    for (int k = 0; k < 4; ++k) { const int r = fwd ? k : 3 - k; h = ar[it][r] * h + ur[it][r]; YOd[(16 * rt + 4 * l4 + r) * 104 + c] = h; }
                }
            }
            __syncthreads();
#pragma unroll
            for (int it2 = 0; it2 < 2; ++it2) { const int idx = tid + 512 * it2; if (it2 == 1 && tid >= 256) break; const int t = idx / 12, ch = idx % 12;
                const v4u gv = it2 ? gq1 : gq0;
                const f32x4 f0 = *(const LAS f32x4*)(YO + t * 104 + 8 * ch), f1 = *(const LAS f32x4*)(YO + t * 104 + 8 * ch + 4);
                const f32x4 r0 = *(const LAS f32x4*)(YO + (RL_YOSZ / 4) + t * 104 + 8 * ch), r1 = *(const LAS f32x4*)(YO + (RL_YOSZ / 4) + t * 104 + 8 * ch + 4);
                const f32x4 y0 = f0 + r0, y1 = f1 + r1;
                v4u ov;
                ov.x = pk2(y0[0] * __uint_as_float(gv.x << 16), y0[1] * __uint_as_float(gv.x & 0xffff0000u));
                ov.y = pk2(y0[2] * __uint_as_float(gv.y << 16), y0[3] * __uint_as_float(gv.y & 0xffff0000u));
                ov.z = pk2(y1[0] * __uint_as_float(gv.z << 16), y1[1] * __uint_as_float(gv.z & 0xffff0000u));
                ov.w = pk2(y1[2] * __uint_as_float(gv.w << 16), y1[3] * __uint_as_float(gv.w & 0xffff0000u));
                *(v4u*)(GG + (tokbase + t0 + t) * DRNN + 96 * n + 8 * ch) = ov; }
        }
    }
#undef RNN_LOAD_XR
}
__device__ __forceinline__ void rnn_carry_phase(const f32x2* agg, float* cin, int tid, int G, int bid) {
    for (int g = bid * NTHR + tid; g < BATCH * 2 * DRNN; g += G * NTHR) {
        const int ch = g % DRNN, dir = (g / DRNN) & 1, b = g / (2 * DRNN);
        float carry = 0.f;
#pragma unroll 8
        for (int k = 0; k < 128; ++k) { const int chunk = dir ? 127 - k : k; const size_t idx = ((size_t)(b * 128 + chunk) * 2 + dir) * DRNN + ch;
            const f32x2 av = agg[idx]; cin[idx] = carry; carry = av.x * carry + av.y; }
    }
}

__global__ void __launch_bounds__(NTHR, 2) fwd_megakernel(Args args) {
    extern __shared__ __attribute__((aligned(16))) unsigned char lds_raw[];
    LAS unsigned char* lds = (LAS unsigned char*)lds_raw;
    cg::grid_group grid = cg::this_grid();
    const int tid = threadIdx.x, lane = tid & 63, wave = __builtin_amdgcn_readfirstlane(tid >> 6);
    const int G = gridDim.x, bid = blockIdx.x;
    unsigned char* ws = args.ws;
    float* MOD = (float*)(ws + WS_MOD); bf16* XB = (bf16*)(ws + WS_XB); bf16* HB = (bf16*)(ws + WS_HB);
    bf16* Qb = (bf16*)(ws + WS_Q); bf16* Kb = (bf16*)(ws + WS_K); bf16* Vb = (bf16*)(ws + WS_V); bf16* Ob = (bf16*)(ws + WS_O);
    bf16* Hbig = (bf16*)(ws + WS_BIG); bf16* XR = (bf16*)(ws + WS_XR); bf16* GG = (bf16*)(ws + WS_GG);
    const float* ln_g = args.in[4]; const float* ln_b = args.in[5];
    using namespace pg8;

    volatile LAS unsigned* MISC = (volatile LAS unsigned*)(lds + LDS_BYTES - 64);
    if (tid < 2) MISC[tid] = 0u;
    if (bid == 0) { for (int i = tid; i < XCD_BAR_WORDS; i += NTHR) ((unsigned*)(ws + WS_BAR))[i] = 0u; }
    __syncthreads();
    p0_prologue(args, lds, tid, lane, wave, G, bid);
    grid.sync();
    (void)xcd_barrier_post((unsigned*)(ws + WS_BAR), MISC);
#define GRID_BAR() do { XcdBarrier b_; b_.bar = (unsigned*)(args.ws + WS_BAR); b_.x = xb_xcc_id(); b_.st = (volatile LAS unsigned*)(lds + LDS_BYTES - 64); xcd_barrier(b_); } while (0)
    ln_mod_phase<false, true, false>(args.in[0], nullptr, HB, nullptr, nullptr, MOD + 0 * 12288, nullptr, lane, wave, G, bid);
    GRID_BAR();
    { Gemm g{HB, (const bf16_t*)(ws + WS_WQKV), M, NQKV, DM}; StaticOrder S; S.init(M, NQKV, G, bid);
      EpiQKV E{Qb, Kb, Vb, (const float*)(ws + WS_CS), 0.08838834764831845f * LOG2E};
      gemm_phase<EpiQKV, StaticOrder, true, true>(lds, g, S, E); }
    GRID_BAR();
    attn_phase(lds, Qb, Kb, Vb, Ob, args.in[8], tid, lane, wave, G, bid);
    GRID_BAR();
    { Gemm g{Ob, (const bf16_t*)(ws + WS_WO), M, DM, DM}; StaticOrder S; S.init(M, DM, G, bid);
      EpiRes<true> E{ws, args.in[0], ln_g, ln_b, 0};
      gemm_phase<EpiRes<true>, StaticOrder, true, true>(lds, g, S, E); }
    GRID_BAR();
    ln_mod_phase<true, false, false>(XB, nullptr, HB, ln_g + 0 * 1024, ln_b + 0 * 1024, MOD + 1 * 12288, (float*)(ws + WS_STAT), lane, wave, G, bid);
    GRID_BAR();
    { Gemm g{HB, (const bf16_t*)(ws + WS_W1), M, DFF, DM}; StaticOrder S; S.init(M, DFF, G, bid);
      EpiAct<0> E{Hbig, nullptr, DFF};
      gemm_phase<EpiAct<0>, StaticOrder, true, true>(lds, g, S, E); }
    GRID_BAR();
    { Gemm g{Hbig, (const bf16_t*)(ws + WS_W2), M, DM, DFF}; StaticOrder S; S.init(M, DM, G, bid);
      EpiRes<false> E{ws, nullptr, ln_g, ln_b, 1};
      gemm_phase<EpiRes<false>, StaticOrder, true, true>(lds, g, S, E); }
    GRID_BAR();
    ln_mod_phase<true, false, false>(XB, nullptr, HB, ln_g + 1 * 1024, ln_b + 1 * 1024, MOD + 2 * 12288, (float*)(ws + WS_STAT), lane, wave, G, bid);
    GRID_BAR();
    { Gemm g{HB, (const bf16_t*)(ws + WS_WRIN), M, 2 * DRNN, DM}; StaticOrder S; S.init(M, 2 * DRNN, G, bid);
      EpiAct<1> E{XR, GG, DRNN};
      gemm_phase<EpiAct<1>, StaticOrder, true, true>(lds, g, S, E); }
    GRID_BAR();
    rnn_phase<false>(lds, XR, GG, args.in[10], args.in[11], (const bf16*)(ws + WS_WG), args.in[13], args.in[15], (const float*)(ws + WS_SP8), (f32x2*)(ws + WS_AGG), (const float*)(ws + WS_CIN), tid, lane, wave, G, bid);
    GRID_BAR();
    rnn_carry_phase((const f32x2*)(ws + WS_AGG), (float*)(ws + WS_CIN), tid, G, bid);
    GRID_BAR();
    rnn_phase<true>(lds, XR, GG, args.in[10], args.in[11], (const bf16*)(ws + WS_WG), args.in[13], args.in[15], (const float*)(ws + WS_SP8), (f32x2*)(ws + WS_AGG), (const float*)(ws + WS_CIN), tid, lane, wave, G, bid);
    GRID_BAR();
    { Gemm g{GG, (const bf16_t*)(ws + WS_WROUT), M, DM, DRNN}; StaticOrder S; S.init(M, DM, G, bid);
      EpiRes<false> E{ws, nullptr, ln_g, ln_b, 2};
      gemm_phase<EpiRes<false>, StaticOrder, true, true>(lds, g, S, E); }
    GRID_BAR();
    ln_mod_phase<true, false, false>(XB, nullptr, HB, ln_g + 2 * 1024, ln_b + 2 * 1024, MOD + 3 * 12288, (float*)(ws + WS_STAT), lane, wave, G, bid);
    GRID_BAR();
    { Gemm g{HB, (const bf16_t*)(ws + WS_W1) + (size_t)DFF * DM, M, DFF, DM}; StaticOrder S; S.init(M, DFF, G, bid);
      EpiAct<0> E{Hbig, nullptr, DFF};
      gemm_phase<EpiAct<0>, StaticOrder, true, true>(lds, g, S, E); }
    GRID_BAR();
    { Gemm g{Hbig, (const bf16_t*)(ws + WS_W2) + (size_t)DM * DFF, M, DM, DFF}; StaticOrder S; S.init(M, DM, G, bid);
      EpiRes<false> E{ws, nullptr, ln_g, ln_b, 3};
      gemm_phase<EpiRes<false>, StaticOrder, true, true>(lds, g, S, E); }
    GRID_BAR();
    ln_mod_phase<true, false, true>(XB, args.out, nullptr, ln_g + 3 * 1024, ln_b + 3 * 1024, nullptr, nullptr, lane, wave, G, bid);
}

extern "C" void kernel_launch(void* const* d_in, const int* in_sizes, int n_in, void* d_out, int out_size, void* d_ws, size_t ws_size, hipStream_t stream) {
    static int grid = 0;
    if (grid == 0) {
        if (n_in != 20 || out_size != M * DM || ws_size < WS_END) { fprintf(stderr, "kernel_launch: unexpected problem (n_in %d, out %d, ws %zu)\n", n_in, out_size, ws_size); grid = -1; return; }
        int dev = 0, cus = 0, per_cu = 0;
        (void)hipGetDevice(&dev); (void)hipDeviceGetAttribute(&cus, hipDeviceAttributeMultiprocessorCount, dev);
        if (hipFuncSetAttribute((const void*)fwd_megakernel, hipFuncAttributeMaxDynamicSharedMemorySize, LDS_BYTES) != hipSuccess) { fprintf(stderr, "kernel_launch: hipFuncSetAttribute failed\n"); grid = -1; return; }
        if (hipOccupancyMaxActiveBlocksPerMultiprocessor(&per_cu, (const void*)fwd_megakernel, NTHR, LDS_BYTES) != hipSuccess || per_cu < 1) { fprintf(stderr, "kernel_launch: occupancy query gave %d\n", per_cu); per_cu = 1; }
        (void)hipGetLastError();
        grid = cus * 1;
    }
    if (grid < 0) return;
    Args a{};
    for (int i = 0; i < 20; ++i) a.in[i] = (const float*)d_in[i];
    a.out = (float*)d_out; a.ws = (unsigned char*)d_ws;
    void* kargs[] = {&a};
    hipError_t e = hipLaunchCooperativeKernel((const void*)fwd_megakernel, dim3(grid), dim3(NTHR), kargs, LDS_BYTES, stream);
    if (e != hipSuccess) fprintf(stderr, "cooperative launch failed: %s (grid %d)\n", hipGetErrorString(e), grid);
}
```

```cpp
#include <hip/hip_runtime.h>
#include <hip/hip_cooperative_groups.h>
#include <cstdio>
#include <cstdint>
namespace cg = cooperative_groups;
constexpr int NWAVES = 8, NTHR = 512;
constexpr int BATCH = 4, SEQ = 8192, DM = 1024, M = BATCH * SEQ, DFF = 4096, DRNN = 1536, NQKV = 1536;
constexpr float LN_EPS = 1e-5f, DN_ALPHA = 1.4142135623730951f, LOG2E = 1.4426950408889634f;
constexpr int LDS_BYTES = 147456;
constexpr size_t MiB = 1u << 20;
constexpr size_t WS_MOD = 0;
constexpr size_t WS_BAR = 768 * 1024;
constexpr size_t WS_STAT = 256 * 1024;
constexpr size_t WS_SP8 = 512 * 1024;
constexpr size_t WS_CS = 1 * MiB;
constexpr size_t WS_WG = 2 * MiB;
constexpr size_t WS_WQKV = 4 * MiB;
constexpr size_t WS_WO = 7 * MiB;
constexpr size_t WS_WRIN = 9 * MiB;
constexpr size_t WS_WROUT = 15 * MiB;
constexpr size_t WS_W1 = 18 * MiB;
constexpr size_t WS_W2 = 34 * MiB;
constexpr size_t WS_XB = 50 * MiB;
constexpr size_t WS_HB = 178 * MiB;
constexpr size_t WS_BIG = 242 * MiB;
constexpr size_t WS_Q = WS_BIG, WS_K = WS_BIG + 64 * MiB, WS_V = WS_BIG + 80 * MiB, WS_O = WS_BIG + 96 * MiB;
constexpr size_t WS_XR = WS_BIG, WS_GG = WS_BIG + 96 * MiB;
constexpr size_t WS_AGG = WS_BIG + 192 * MiB;
constexpr size_t WS_CIN = WS_BIG + 208 * MiB;
constexpr size_t WS_END = WS_BIG + 256 * MiB;

namespace pg8 {
#define PG8_LAS __attribute__((address_space(3)))
typedef unsigned short bf16_t;
typedef short bf16x8 __attribute__((ext_vector_type(8)));
typedef float f32x4 __attribute__((ext_vector_type(4)));
typedef unsigned u32x4 __attribute__((ext_vector_type(4)));
constexpr int BM = 256, BK = 64, HALF = 128, HTB = HALF * BK * 2  , STAGE_BYTES = 8 * HTB, NXCD = 8, WGM = 8;

__host__ __device__ __forceinline__ int lds_byte(int r, int c) { const int st = (r >> 4) * 2 + (c >> 5), rr = r & 15, cc = c & 31, ob = rr * 64 + cc * 2; return st * 1024 + (ob ^ (((ob >> 9) & 1) << 5)); }
__host__ __device__ __forceinline__ void stage_rc(int b, int& R, int& C) { const int st = b / 1024, sb = b % 1024, swz = sb ^ (((sb >> 9) & 1) << 5); R = (st >> 1) * 16 + swz / 64; C = (st & 1) * 32 + (swz % 64) / 2; }
__host__ __device__ __forceinline__ int perm32(int rho) { const int n = rho >> 4, i = rho & 15; return 8 * (i >> 2) + 4 * n + (i & 3); }

struct Unit { int pm, pn; };
struct Gemm { const bf16_t* A; const bf16_t* Bt; int M, N, K; };

struct StaticOrder {
    int nM, nN, nwg, G, c;
    __host__ __device__ void init(int M, int N, int G_, int c_) { nM = M / BM; nN = N / BM; nwg = nM * nN; G = G_; c = c_; }
    __host__ __device__ bool next(int i, Unit& u) const {
        const long L = (long)i * G + c; if (L >= nwg) return false;
        int wgid = (int)L; { const int q = nwg / NXCD, r = nwg % NXCD, xcd = wgid % NXCD, off = wgid / NXCD; wgid = (xcd < r ? xcd * (q + 1) : r * (q + 1) + (xcd - r) * q) + off; }
        const int nig = WGM * nN, gid = wgid / nig, fm = gid * WGM, gsz = (nM - fm) < WGM ? (nM - fm) : WGM;
        u.pm = fm + ((wgid % nig) % gsz); u.pn = (wgid % nig) / gsz; return true;
    }
    __device__ __forceinline__ void a_ready(const Unit&) const {}
    __device__ __forceinline__ void done(const Unit&) const {}
};

__device__ __forceinline__ unsigned cvt_pk_bf16(float lo, float hi) { unsigned r; asm volatile("v_cvt_pk_bf16_f32 %0, %1, %2" : "=v"(r) : "v"(lo), "v"(hi)); return r; }
__device__ __forceinline__ u32x4 pack8(const f32x4 v0, const f32x4 v1) { u32x4 w; w.x = cvt_pk_bf16(v0[0], v0[1]); w.y = cvt_pk_bf16(v0[2], v0[3]); w.z = cvt_pk_bf16(v1[0], v1[1]); w.w = cvt_pk_bf16(v1[2], v1[3]); return w; }
struct EpiQKV {
    static constexpr bool PERM = true, AFTER_DRAIN = false;
    bf16_t* Q; bf16_t* K; bf16_t* V; const float* cs; float qscale;
    __device__ __forceinline__ void operator()(const f32x4 (&acc)[2][2][4][2], const Unit& u, int wr, int wc, int fr, int fq) const {
        const int row0 = u.pm * BM + wr * 64 + fr;
        bf16_t* base; int ld, colt; float sc = 1.f; bool rope = true;
        if (u.pn < 4) { base = Q; ld = 1024; colt = u.pn * BM; sc = qscale; }
        else if (u.pn == 4) { base = K; ld = 256; colt = 0; }
        else { base = V; ld = 256; colt = 0; rope = false; }
        const int col0 = colt + wc * 32 + 8 * fq;
        const bool dorope = rope && (wc == 0);
#pragma unroll
        for (int ai = 0; ai < 2; ++ai)
#pragma unroll
            for (int m = 0; m < 4; ++m) {
                const int row = row0 + ai * HALF + m * 16; const int pos = row & 8191;
                f32x4 c0 = {1.f, 1.f, 1.f, 1.f}, c1 = c0, s0 = {0.f, 0.f, 0.f, 0.f}, s1 = s0;
                if (dorope) { const float* t = cs + (size_t)pos * 32 + 8 * (fq & 1); c0 = *(const f32x4*)t; c1 = *(const f32x4*)(t + 4); s0 = *(const f32x4*)(t + 16); s1 = *(const f32x4*)(t + 20);
                    if (fq < 2) { s0 = -s0; s1 = -s1; } }
#pragma unroll
                for (int bj = 0; bj < 2; ++bj) {
                    f32x4 v0 = acc[ai][bj][m][0], v1 = acc[ai][bj][m][1];
                    if (dorope) { f32x4 p0, p1;
#pragma unroll
                        for (int j = 0; j < 4; ++j) { p0[j] = __shfl_xor(v0[j], 32); p1[j] = __shfl_xor(v1[j], 32); }
                        v0 = v0 * c0 + p0 * s0; v1 = v1 * c1 + p1 * s1; }
                    v0 = v0 * sc; v1 = v1 * sc;
                    *(u32x4*)(base + (size_t)row * ld + col0 + bj * HALF) = pack8(v0, v1);
                }
            }
    }
};
template <bool XF32> struct EpiRes {
    static constexpr bool PERM = true, AFTER_DRAIN = false;
    unsigned char* ws; const float* xin; const float* lng_all; const float* lnb_all; int k;
    __device__ __forceinline__ void operator()(const f32x4 (&acc)[2][2][4][2], const Unit& u, int wr, int wc, int fr, int fq) const {
        const int row0 = u.pm * BM + wr * 64 + fr, col0 = u.pn * BM + wc * 32 + 8 * fq;
        const int b = (u.pm * BM) >> 13;
        const void* xres = XF32 ? (const void*)xin : (const void*)(ws + WS_XB); bf16_t* out = (bf16_t*)(ws + WS_XB); constexpr float alpha = DN_ALPHA;
        const float* gate = (const float*)(ws + WS_MOD) + k * 12288 + 2048; const float* stat = (const float*)(ws + WS_STAT);
        const float* lng = lng_all + (k - 1) * 1024; const float* lnb = lnb_all + (k - 1) * 1024;
#pragma unroll
        for (int bj = 0; bj < 2; ++bj) {
            const f32x4 g0 = *(const f32x4*)(gate + b * 3072 + col0 + bj * HALF) + 1.0f, g1 = *(const f32x4*)(gate + b * 3072 + col0 + bj * HALF + 4) + 1.0f;
            f32x4 G0, G1, B0, B1;
            if (!XF32) { G0 = *(const f32x4*)(lng + col0 + bj * HALF); G1 = *(const f32x4*)(lng + col0 + bj * HALF + 4); B0 = *(const f32x4*)(lnb + col0 + bj * HALF); B1 = *(const f32x4*)(lnb + col0 + bj * HALF + 4); }
#pragma unroll
            for (int ai = 0; ai < 2; ++ai)
#pragma unroll
                for (int m = 0; m < 4; ++m) { const size_t off = (size_t)(row0 + ai * HALF + m * 16) * 1024 + col0 + bj * HALF;
                    f32x4 x0, x1;
                    if (XF32) { x0 = *(const f32x4*)((const float*)xres + off); x1 = *(const f32x4*)((const float*)xres + off + 4); }
                    else { const u32x4 w = *(const u32x4*)((const bf16_t*)xres + off);
                        x0 = (f32x4){__uint_as_float(w.x << 16), __uint_as_float(w.x & 0xffff0000u), __uint_as_float(w.y << 16), __uint_as_float(w.y & 0xffff0000u)};
                        x1 = (f32x4){__uint_as_float(w.z << 16), __uint_as_float(w.z & 0xffff0000u), __uint_as_float(w.w << 16), __uint_as_float(w.w & 0xffff0000u)};
                        typedef float f32x2e __attribute__((ext_vector_type(2))); const f32x2e sr = *(const f32x2e*)(stat + 2 * (row0 + ai * HALF + m * 16));
                        x0 = (x0 - sr.x) * sr.y * G0 + B0; x1 = (x1 - sr.x) * sr.y * G1 + B1; }
                    *(u32x4*)(out + off) = pack8(x0 * alpha + g0 * acc[ai][bj][m][0], x1 * alpha + g1 * acc[ai][bj][m][1]);
                    if (m & 1) asm volatile("" ::: "memory"); }
        }
    }
};
__device__ __forceinline__ float gelu_tanh(float x) { const float t = x * x * 0.044715f + 1.0f; const float e = __builtin_amdgcn_exp2f(-2.302208198f * (x * t)); return x * __builtin_amdgcn_rcpf(1.0f + e); }
template <int MODE> struct EpiAct {
    static constexpr bool PERM = true, AFTER_DRAIN = false;
    bf16_t* O; bf16_t* O2; int ldc;
    __device__ __forceinline__ void operator()(const f32x4 (&acc)[2][2][4][2], const Unit& u, int wr, int wc, int fr, int fq) const {
        const int row0 = u.pm * BM + wr * 64 + fr; int colt = u.pn * BM; bf16_t* base = O; bool act = (MODE == 0);
        if (MODE == 1 && u.pn >= 6) { base = O2; colt -= 1536; act = true; }
        const int col0 = colt + wc * 32 + 8 * fq;
#pragma unroll
        for (int ai = 0; ai < 2; ++ai)
#pragma unroll
            for (int m = 0; m < 4; ++m) { bf16_t* rowp = base + (size_t)(row0 + ai * HALF + m * 16) * ldc + col0;
#pragma unroll
                for (int bj = 0; bj < 2; ++bj) { f32x4 v0 = acc[ai][bj][m][0], v1 = acc[ai][bj][m][1];
                    if (act) {
#pragma unroll
                        for (int j = 0; j < 4; ++j) {
                            if (MODE == 0) { const float a = fmaxf(v0[j], 0.f), b = fmaxf(v1[j], 0.f); v0[j] = a * a; v1[j] = b * b; }
                            else { v0[j] = gelu_tanh(v0[j]); v1[j] = gelu_tanh(v1[j]); } } }
                    *(u32x4*)(rowp + bj * HALF) = pack8(v0, v1); } }
    }
};
template <class Epi, class Sched, bool ALIGN_EPI = false, bool SP2 = false>
__device__ __forceinline__ void gemm_phase(PG8_LAS unsigned char* lds, const Gemm g, const Sched& S, const Epi& E) {
    int tid_ = threadIdx.x; asm volatile("" : "+v"(tid_));
    const int tid = tid_, wid = __builtin_amdgcn_readfirstlane(tid >> 6), lane = tid & 63, wr = wid >> 2, wc = wid & 3, fr = lane & 15, fq = lane >> 4;
    const int K = g.K, nt = K / BK;
    unsigned voffA[2], voffB[2];
#pragma unroll
    for (int i = 0; i < 2; ++i) { int R, C; stage_rc(tid * 16 + i * 8192, R, C); const int Rb = Epi::PERM ? ((R & ~31) + perm32(R & 31)) : R;
        voffA[i] = (unsigned)(R * K + C) * 2u; voffB[i] = (unsigned)(Rb * K + C) * 2u; }
    const size_t kstep = (size_t)(BK * 2);
    const size_t hstep = (size_t)HALF * K * 2;
    const size_t tstep = 2 * hstep;
    const unsigned ldsw = (unsigned)wid * 1024u;
    const int aoff = lds_byte(wr * 64 + fr, fq * 8), boff = lds_byte(wc * 32 + fr, fq * 8);
#define PG8_SA(b, h) (((b) * 2 + (h)) * HTB)
#define PG8_SB(b, h) ((4 + (b) * 2 + (h)) * HTB)
#define PG8_STAGE(bufoff, gbase, voff) do { _Pragma("unroll") for (int _i = 0; _i < 2; ++_i) \
        __builtin_amdgcn_global_load_lds((const unsigned*)((const char*)(gbase) + (voff)[_i]), (PG8_LAS unsigned*)(lds + (bufoff) + ldsw + _i * 8192), 16, 0, 0); } while (0)
#define PG8_LDA(dst, b, h) do { _Pragma("unroll") for (int m = 0; m < 4; ++m) _Pragma("unroll") for (int k = 0; k < 2; ++k) dst[m][k] = *(const PG8_LAS bf16x8*)(lds + PG8_SA(b, h) + aoff + m * 2048 + k * 1024); } while (0)
#define PG8_LDB(dst, b, h) do { _Pragma("unroll") for (int n = 0; n < 2; ++n) _Pragma("unroll") for (int k = 0; k < 2; ++k) dst[n][k] = *(const PG8_LAS bf16x8*)(lds + PG8_SB(b, h) + boff + n * 2048 + k * 1024); } while (0)
#define PG8_MMA(ai, bj, At, Bt) do { __builtin_amdgcn_s_setprio(1); _Pragma("unroll") for (int m = 0; m < 4; ++m) _Pragma("unroll") for (int n = 0; n < 2; ++n) _Pragma("unroll") for (int k = 0; k < 2; ++k) \
        acc[ai][bj][m][n] = __builtin_amdgcn_mfma_f32_16x16x32_bf16(Bt[n][k], At[m][k], acc[ai][bj][m][n], 0, 0, 0); __builtin_amdgcn_s_setprio(0); } while (0)
#define PG8_WAIT_V(n) asm volatile("s_waitcnt vmcnt(" #n ")" ::: "memory")
#define PG8_WAIT_L(n) asm volatile("s_waitcnt lgkmcnt(" #n ")" ::: "memory")
#define PG8_BAR __builtin_amdgcn_s_barrier()
#define PG8_SCHED __builtin_amdgcn_sched_barrier(0)
    Unit cur, nxt; int ui = 0;
    if (!S.next(0, cur)) return;
    f32x4 acc[2][2][4][2];
#pragma unroll
    for (int a = 0; a < 2; ++a)
#pragma unroll
        for (int b = 0; b < 2; ++b)
#pragma unroll
            for (int m = 0; m < 4; ++m)
#pragma unroll
                for (int n = 0; n < 2; ++n) acc[a][b][m][n] = (f32x4){0.f, 0.f, 0.f, 0.f};
    bf16x8 At[4][2], B0[2][2], B1[2][2];
    const char* cA = (const char*)g.A + (size_t)cur.pm * tstep; const char* cB = (const char*)g.Bt + (size_t)cur.pn * tstep;
    S.a_ready(cur);
    if constexpr (SP2) {
        PG8_STAGE(PG8_SB(0, 0), cB, voffB); PG8_STAGE(PG8_SB(0, 1), cB + hstep, voffB); PG8_STAGE(PG8_SA(0, 0), cA, voffA); PG8_STAGE(PG8_SA(0, 1), cA + hstep, voffA);
        if (wr == 1) PG8_BAR;
        PG8_WAIT_V(2); PG8_BAR;
        PG8_STAGE(PG8_SB(1, 0), cB + kstep, voffB); PG8_STAGE(PG8_SA(1, 0), cA + kstep, voffA); PG8_STAGE(PG8_SB(1, 1), cB + hstep + kstep, voffB);
        PG8_WAIT_V(6); PG8_BAR;
    } else {
        PG8_STAGE(PG8_SB(0, 0), cB, voffB); PG8_STAGE(PG8_SA(0, 0), cA, voffA); PG8_STAGE(PG8_SB(0, 1), cB + hstep, voffB); PG8_STAGE(PG8_SA(0, 1), cA + hstep, voffA);
        if (wr == 1) PG8_BAR;
        PG8_WAIT_V(4); PG8_BAR;
        PG8_STAGE(PG8_SB(1, 0), cB + kstep, voffB); PG8_STAGE(PG8_SA(1, 0), cA + kstep, voffA); PG8_STAGE(PG8_SB(1, 1), cB + hstep + kstep, voffB);
        PG8_WAIT_V(6); PG8_BAR;
    }
    for (;;) {
        const bool has_next = S.next(ui + 1, nxt);
        const char* nA = has_next ? (const char*)g.A + (size_t)nxt.pm * tstep : cA; const char* nB = has_next ? (const char*)g.Bt + (size_t)nxt.pn * tstep : cB;
        for (int t = 0; t < nt; t += 2) {
            const bool last = (t == nt - 2);
            const char* a1 = cA + (size_t)(t + 1) * kstep;
            const char* a2 = last ? nA : cA + (size_t)(t + 2) * kstep; const char* b2 = last ? nB : cB + (size_t)(t + 2) * kstep;
            const char* a3 = a2 + kstep; const char* b3 = b2 + kstep;
            if (last && has_next) S.a_ready(nxt);
            if constexpr (SP2) {
            PG8_LDB(B0, 0, 0); PG8_LDB(B1, 0, 1); PG8_SCHED; PG8_LDA(At, 0, 0); PG8_STAGE(PG8_SA(1, 1), a1 + hstep, voffA);
            PG8_WAIT_V(8); PG8_WAIT_L(0); PG8_BAR; PG8_MMA(0, 0, At, B0); PG8_MMA(0, 1, At, B1); PG8_BAR; PG8_SCHED;
            PG8_LDA(At, 0, 1); PG8_STAGE(PG8_SB(0, 0), b2, voffB); PG8_STAGE(PG8_SB(0, 1), b2 + hstep, voffB); PG8_STAGE(PG8_SA(0, 0), a2, voffA);
            PG8_WAIT_V(8); PG8_WAIT_L(0); PG8_BAR; PG8_MMA(1, 0, At, B0); PG8_MMA(1, 1, At, B1); PG8_BAR; PG8_SCHED;
            PG8_LDB(B0, 1, 0); PG8_LDB(B1, 1, 1); PG8_SCHED; PG8_LDA(At, 1, 0); PG8_STAGE(PG8_SA(0, 1), a2 + hstep, voffA);
            PG8_WAIT_V(8); PG8_WAIT_L(0); PG8_BAR; PG8_MMA(0, 0, At, B0); PG8_MMA(0, 1, At, B1); PG8_BAR; PG8_SCHED;
            PG8_LDA(At, 1, 1); PG8_STAGE(PG8_SB(1, 0), b3, voffB); PG8_STAGE(PG8_SB(1, 1), b3 + hstep, voffB); PG8_STAGE(PG8_SA(1, 0), a3, voffA);
            PG8_WAIT_V(8); PG8_WAIT_L(0); PG8_BAR; PG8_MMA(1, 0, At, B0); PG8_MMA(1, 1, At, B1); PG8_BAR; PG8_SCHED;
            } else {
            PG8_LDB(B0, 0, 0); PG8_SCHED; PG8_LDA(At, 0, 0); PG8_STAGE(PG8_SA(1, 1), a1 + hstep, voffA);
            PG8_WAIT_L(8); PG8_BAR; PG8_WAIT_L(0); PG8_MMA(0, 0, At, B0); PG8_BAR; PG8_SCHED;
            PG8_LDB(B1, 0, 1); PG8_STAGE(PG8_SB(0, 0), b2, voffB);
            PG8_BAR; PG8_WAIT_L(0); PG8_MMA(0, 1, At, B1); PG8_BAR;
            PG8_LDA(At, 0, 1); PG8_STAGE(PG8_SA(0, 0), a2, voffA);
            PG8_BAR; PG8_WAIT_L(0); PG8_MMA(1, 0, At, B0); PG8_BAR; PG8_SCHED;
            PG8_STAGE(PG8_SB(0, 1), b2 + hstep, voffB);
            PG8_WAIT_V(6); PG8_BAR; PG8_MMA(1, 1, At, B1); PG8_BAR;
            PG8_LDB(B0, 1, 0); PG8_SCHED; PG8_LDA(At, 1, 0); PG8_STAGE(PG8_SA(0, 1), a2 + hstep, voffA);
            PG8_WAIT_L(8); PG8_BAR; PG8_WAIT_L(0); PG8_MMA(0, 0, At, B0); PG8_BAR; PG8_SCHED;
            PG8_LDB(B1, 1, 1); PG8_STAGE(PG8_SB(1, 0), b3, voffB);
            PG8_BAR; PG8_WAIT_L(0); PG8_MMA(0, 1, At, B1); PG8_BAR;
            PG8_LDA(At, 1, 1); PG8_STAGE(PG8_SA(1, 0), a3, voffA);
            PG8_BAR; PG8_WAIT_L(0); PG8_MMA(1, 0, At, B0); PG8_BAR; PG8_SCHED;
            PG8_STAGE(PG8_SB(1, 1), b3 + hstep, voffB);
            PG8_WAIT_V(6); PG8_BAR; PG8_MMA(1, 1, At, B1); PG8_BAR;
            }
        }
        if constexpr (ALIGN_EPI) { if (wr == 0) PG8_BAR; }
        if constexpr (!Epi::AFTER_DRAIN) { E(acc, cur, wr, wc, fr, fq); S.done(cur); }
        if (!has_next) break;
#pragma unroll
        for (int a = 0; a < 2; ++a)
#pragma unroll
            for (int b = 0; b < 2; ++b)
#pragma unroll
                for (int m = 0; m < 4; ++m)
#pragma unroll
                    for (int n = 0; n < 2; ++n) acc[a][b][m][n] = (f32x4){0.f, 0.f, 0.f, 0.f};
        cur = nxt; cA = nA; cB = nB; ++ui;
        if constexpr (ALIGN_EPI) { if (wr == 1) PG8_BAR; }
    }
    PG8_WAIT_V(0);
    if constexpr (!ALIGN_EPI) { if (wr == 0) PG8_BAR; }
    PG8_BAR;
    if constexpr (Epi::AFTER_DRAIN) { E.fused(acc, cur, wr, wc, fr, fq, lds, wid, lane); S.done(cur); }
#undef PG8_SA
#undef PG8_SB
#undef PG8_STAGE
#undef PG8_LDA
#undef PG8_LDB
#undef PG8_MMA
#undef PG8_WAIT_V
#undef PG8_WAIT_L
#undef PG8_BAR
#undef PG8_SCHED
}
}

#define LAS __attribute__((address_space(3)))
typedef unsigned short bf16;
typedef unsigned v4u __attribute__((ext_vector_type(4)));
typedef unsigned v2u __attribute__((ext_vector_type(2)));
typedef float f32x4 __attribute__((ext_vector_type(4)));
typedef float f32x2 __attribute__((ext_vector_type(2)));
typedef float f32x16 __attribute__((ext_vector_type(16)));
typedef short bf16x8 __attribute__((ext_vector_type(8)));
typedef short s16x4 __attribute__((ext_vector_type(4)));
typedef __bf16 bf16x2_t __attribute__((ext_vector_type(2)));
__device__ __forceinline__ unsigned pk2(float lo, float hi) { f32x2 v = {lo, hi}; bf16x2_t b = __builtin_convertvector(v, bf16x2_t); return __builtin_bit_cast(unsigned, b); }
__device__ __forceinline__ float bf2f(unsigned short h) { return __uint_as_float((unsigned)h << 16); }
__device__ __forceinline__ float wave_sum(float v) {
#pragma unroll
    for (int o = 1; o < 64; o <<= 1) v += __shfl_xor(v, o);
    return v;
}
__device__ __forceinline__ float sigmoidf_(float x) { return __builtin_amdgcn_rcpf(1.0f + __builtin_amdgcn_exp2f(-1.4426950408889634f * x)); }

struct Args { const float* in[20]; float* out; unsigned char* ws; };


#define GAS __attribute__((address_space(1)))
#define XB_TMO      128
#define XB_XCNT(j)  (256  + 64 * (j))
#define XB_XSUB(j)  (1280 + 64 * (j))
#define XB_XGEN(j)  (2304 + 64 * (j))
#define XB_TOP      3328
#define XB_TOPGEN   3392
#define XCD_BAR_WORDS 3456
#define XB_SPIN_CAP (1u << 18)

__device__ __forceinline__ unsigned xb_ld(unsigned* p)              { return __hip_atomic_load(p, __ATOMIC_RELAXED, __HIP_MEMORY_SCOPE_AGENT); }
__device__ __forceinline__ unsigned xb_add(unsigned* p, unsigned v) { return __hip_atomic_fetch_add(p, v, __ATOMIC_RELAXED, __HIP_MEMORY_SCOPE_AGENT); }
__device__ __forceinline__ unsigned xb_xcc_id() { return (unsigned)__builtin_amdgcn_s_getreg((3 << 11) | 20) & 0xFu; }
#define XB_SPIN(cond, bar) do { unsigned _sp = 0; while (cond) { __builtin_amdgcn_s_sleep(1); \
    if ((++_sp & 255u) == 0u) { if (xb_ld(&(bar)[XB_TMO])) break; if (_sp > XB_SPIN_CAP) { atomicAdd(&(bar)[XB_TMO], 1u); break; } } } } while (0)

struct XcdBarrier {
    unsigned* bar; unsigned x;
    volatile LAS unsigned* st;
};

__device__ __forceinline__ XcdBarrier xcd_barrier_post(unsigned* bar, volatile LAS unsigned* st) {
    XcdBarrier b; b.bar = bar; b.x = xb_xcc_id(); b.st = st;
    if (threadIdx.x == 0) (void)xb_add(&bar[XB_XCNT(b.x)], 1u);
    return b;
}
__device__ __forceinline__ void xcd_barrier_complete(unsigned* bar, unsigned x, unsigned& nloc, unsigned& nx) {
    const unsigned G = gridDim.x * gridDim.y * gridDim.z;
    unsigned sum, cnt, mine, sp = 0u;
    for (;;) {
        sum = 0u; cnt = 0u; mine = 0u;
#pragma unroll
        for (unsigned j = 0; j < 16; ++j) { const unsigned c = xb_ld(&bar[XB_XCNT(j)]); sum += c; cnt += (c > 0u) ? 1u : 0u; mine = (j == x) ? c : mine; }
        if (sum == G) break;
        __builtin_amdgcn_s_sleep(1);
        if ((++sp & 255u) == 0u) { if (xb_ld(&bar[XB_TMO])) break; if (sp > XB_SPIN_CAP) { atomicAdd(&bar[XB_TMO], 1u); break; } }
    }
    nloc = mine > 0u ? mine : 1u; nx = cnt > 0u ? cnt : 1u;
}

__device__ __forceinline__ void xcd_barrier(const XcdBarrier& b) {
    asm volatile("s_waitcnt vmcnt(0)" ::: "memory");
    __syncthreads();
    if (threadIdx.x == 0) {
        unsigned* bar = b.bar;
        __builtin_amdgcn_s_waitcnt(0);
        unsigned nloc = b.st[0], nx = b.st[1];
        if (nloc == 0u) { xcd_barrier_complete(bar, b.x, nloc, nx); b.st[0] = nloc; b.st[1] = nx; }
        const unsigned old = xb_add(&bar[XB_XSUB(b.x)], 1u);
        const unsigned gen = old / nloc;
        if (old + 1u == (gen + 1u) * nloc) {
            __builtin_amdgcn_fence(__ATOMIC_RELEASE, "agent");
            asm volatile("s_waitcnt vmcnt(0)" ::: "memory");
            const unsigned og = xb_add(&bar[XB_TOP], 1u);
            const unsigned tg = og / nx;
            if (og + 1u == (tg + 1u) * nx) xb_add(&bar[XB_TOPGEN], 1u);
            else XB_SPIN(xb_ld(&bar[XB_TOPGEN]) == tg, bar);
            __builtin_amdgcn_fence(__ATOMIC_ACQUIRE, "agent");
            xb_add(&bar[XB_XGEN(b.x)], 1u);
            asm volatile("s_waitcnt vmcnt(0)" ::: "memory");
        } else {
            XB_SPIN(xb_ld(&bar[XB_XGEN(b.x)]) == gen, bar);
            __builtin_amdgcn_fence(__ATOMIC_ACQUIRE, "agent");
            asm volatile("s_waitcnt vmcnt(0)" ::: "memory");
        }
    }
    __syncthreads();
}

__device__ __forceinline__ void p0_transpose_item(const float* W, int K, int N, bf16* WT, LAS float* scr, int item, int lane) {
    const int nblk = N / 32, kb = item / nblk, nb = item % nblk, k0 = 64 * kb, n0 = 32 * nb;
    float wv_[32];
#pragma unroll
    for (int i = 0; i < 32; ++i) wv_[i] = W[(size_t)(k0 + 2 * i + (lane >> 5)) * N + n0 + (lane & 31)];
#pragma unroll
    for (int i = 0; i < 32; ++i) scr[(2 * i + (lane >> 5)) * 33 + (lane & 31)] = wv_[i];
    asm volatile("s_waitcnt lgkmcnt(0)" ::: "memory");
    const int c = lane & 7;
#pragma unroll
    for (int j = 0; j < 4; ++j) { const int n = (lane >> 3) + 8 * j; const LAS float* s = scr + (8 * c) * 33 + n;
        v4u o; o.x = pk2(s[0 * 33], s[1 * 33]); o.y = pk2(s[2 * 33], s[3 * 33]); o.z = pk2(s[4 * 33], s[5 * 33]); o.w = pk2(s[6 * 33], s[7 * 33]);
        *(v4u*)(WT + (size_t)(n0 + n) * K + k0 + 8 * c) = o; }
    asm volatile("s_waitcnt lgkmcnt(0)" ::: "memory");
}

__device__ __forceinline__ void p0_prologue(const Args& a, LAS unsigned char* lds, int tid, int lane, int wave, int G, int bid) {
    unsigned char* ws = a.ws;
    {
        LAS float* sc = (LAS float*)lds;
        LAS float* red = (LAS float*)(lds + 16384);
        const float* c = a.in[1];
        for (int i = tid; i < 4096; i += NTHR) { const float v = c[i]; sc[i] = v / (1.0f + __expf(-v)); }
        __syncthreads();
        for (int item = bid; item < 192; item += G) {
            const int s = item / 48, n0 = (item % 48) * 64;
            const float* w = a.in[2] + (size_t)s * 1024 * 3072 + n0 + lane;
            float acc0 = 0.f, acc1 = 0.f, acc2 = 0.f, acc3 = 0.f;
            const int kbeg = wave * 128;
#pragma unroll 16
            for (int k = 0; k < 128; ++k) { const float wv = w[(size_t)(kbeg + k) * 3072];
                acc0 += wv * sc[kbeg + k]; acc1 += wv * sc[1024 + kbeg + k]; acc2 += wv * sc[2048 + kbeg + k]; acc3 += wv * sc[3072 + kbeg + k]; }
            red[(wave * 4 + 0) * 64 + lane] = acc0; red[(wave * 4 + 1) * 64 + lane] = acc1; red[(wave * 4 + 2) * 64 + lane] = acc2; red[(wave * 4 + 3) * 64 + lane] = acc3;
            __syncthreads();
            if (tid < 256) { const int b = tid >> 6, l = tid & 63; float t = a.in[3][s * 3072 + n0 + l];
#pragma unroll
                for (int wv = 0; wv < 8; ++wv) t += red[(wv * 4 + b) * 64 + l];
                ((float*)(ws + WS_MOD))[(s * 4 + b) * 3072 + n0 + l] = t; }
            __syncthreads();
        }
    }
    __syncthreads();
    {
        const float invf[16] = {1.000000000e+00f, 4.403665960e-01f, 1.939227432e-01f, 8.539710194e-02f, 3.760603070e-02f, 1.656043902e-02f, 7.292664610e-03f, 3.211445874e-03f,
                                1.414213562e-03f, 6.227723788e-04f, 2.742481884e-04f, 1.207697351e-04f, 5.318296098e-05f, 2.341999971e-05f, 1.031338616e-05f, 4.541670478e-06f};
        float* cs = (float*)(ws + WS_CS);
        for (int idx = bid * NTHR + tid; idx < 8192 * 16; idx += G * NTHR) {
            const int pos = idx >> 4, i = idx & 15;
            float f = invf[0];
#pragma unroll
            for (int q = 1; q < 16; ++q) f = (i == q) ? invf[q] : f;
            const float ang = (float)pos * f;
            double t = (double)ang * 0.15915494309189535; t -= __builtin_rint(t);
            const float r = (float)t;
            cs[pos * 32 + i] = __builtin_amdgcn_cosf(r); cs[pos * 32 + 16 + i] = __builtin_amdgcn_sinf(r);
        }
    }
    { float* sp8 = (float*)(ws + WS_SP8); for (int idx = bid * NTHR + tid; idx < 2 * DRNN; idx += G * NTHR) sp8[idx] = 8.0f * log1pf(__expf(-a.in[16][idx])); }
    {
        bf16* wg = (bf16*)(ws + WS_WG);
        for (int idx = bid * NTHR + tid; idx < 2 * 16 * 2 * 96 * 96; idx += G * NTHR) {
            const int i = idx % 96, j = (idx / 96) % 96, gate = (idx / 9216) & 1, n = (idx / 18432) & 15, dir = idx / 294912;
            const float* src = gate ? a.in[14] : a.in[12];
            const float v = src[((size_t)(dir * 16 + n) * 96 + i) * 96 + j];
            wg[idx] = (bf16)(pk2(v, 0.f) & 0xffffu);
        }
    }
    {
        LAS float* scr = (LAS float*)(lds + wave * 16384);
        const int gw = bid * NWAVES + wave, NGW = G * NWAVES;
        constexpr int I_QKV = 16 * 48, I_O = 16 * 32, I_RIN = 16 * 96, I_ROUT = 24 * 32, I_1 = 16 * 128, I_2 = 64 * 32;
        constexpr int NITEMS = I_QKV + I_O + I_RIN + I_ROUT + 2 * I_1 + 2 * I_2;
        for (int it = gw; it < NITEMS; it += NGW) {
            int r = it;
            if (r < I_QKV) { p0_transpose_item(a.in[6], 1024, 1536, (bf16*)(ws + WS_WQKV), scr, r, lane); continue; } r -= I_QKV;
            if (r < I_O) { p0_transpose_item(a.in[7], 1024, 1024, (bf16*)(ws + WS_WO), scr, r, lane); continue; } r -= I_O;
            if (r < I_RIN) { p0_transpose_item(a.in[9], 1024, 3072, (bf16*)(ws + WS_WRIN), scr, r, lane); continue; } r -= I_RIN;
            if (r < I_ROUT) { p0_transpose_item(a.in[17], 1536, 1024, (bf16*)(ws + WS_WROUT), scr, r, lane); continue; } r -= I_ROUT;
            if (r < I_1) { p0_transpose_item(a.in[18], 1024, 4096, (bf16*)(ws + WS_W1), scr, r, lane); continue; } r -= I_1;
            if (r < I_1) { p0_transpose_item(a.in[18] + (size_t)1024 * 4096, 1024, 4096, (bf16*)(ws + WS_W1) + (size_t)4096 * 1024, scr, r, lane); continue; } r -= I_1;
            if (r < I_2) { p0_transpose_item(a.in[19], 4096, 1024, (bf16*)(ws + WS_W2), scr, r, lane); continue; } r -= I_2;
            p0_transpose_item(a.in[19] + (size_t)4096 * 1024, 4096, 1024, (bf16*)(ws + WS_W2) + (size_t)1024 * 4096, scr, r, lane);
        }
    }
}

template <bool DO_LN, bool IN_F32, bool OUT_F32> __device__ __forceinline__ void ln_mod_phase(const void* xin, void* xout, bf16* hout, const float* lng, const float* lnb, const float* mod, float* stat, int lane, int wave, int G, int bid) {
    const int gw = bid * NWAVES + wave, NGW = G * NWAVES;
    for (int row = gw; row < M; row += NGW) {
        f32x4 v[4];
#pragma unroll
        for (int j = 0; j < 2; ++j) { const size_t e = (size_t)row * DM + 512 * j + 8 * lane;
            if (IN_F32) { v[2 * j] = *(const f32x4*)((const float*)xin + e); v[2 * j + 1] = *(const f32x4*)((const float*)xin + e + 4); }
            else { const v4u w = *(const v4u*)((const bf16*)xin + e);
                v[2 * j] = (f32x4){__uint_as_float(w.x << 16), __uint_as_float(w.x & 0xffff0000u), __uint_as_float(w.y << 16), __uint_as_float(w.y & 0xffff0000u)};
                v[2 * j + 1] = (f32x4){__uint_as_float(w.z << 16), __uint_as_float(w.z & 0xffff0000u), __uint_as_float(w.w << 16), __uint_as_float(w.w & 0xffff0000u)}; } }
        if (DO_LN) {
            float s = 0.f;
#pragma unroll
            for (int j = 0; j < 4; ++j) s += (v[j].x + v[j].y) + (v[j].z + v[j].w);
            const float mean = wave_sum(s) * (1.f / DM); float s2 = 0.f;
#pragma unroll
            for (int j = 0; j < 4; ++j) { v[j] = v[j] - mean; s2 += (v[j].x * v[j].x + v[j].y * v[j].y) + (v[j].z * v[j].z + v[j].w * v[j].w); }
            const float rstd = __builtin_amdgcn_rsqf(wave_sum(s2) * (1.f / DM) + LN_EPS);
            if (stat && lane == 0) { stat[2 * row] = mean; stat[2 * row + 1] = rstd; }
#pragma unroll
            for (int j = 0; j < 4; ++j) { const int c = 512 * (j >> 1) + 8 * lane + 4 * (j & 1); const f32x4 g = *(const f32x4*)(lng + c), bb = *(const f32x4*)(lnb + c); v[j] = v[j] * rstd * g + bb; }
        }
        if (xout) {
#pragma unroll
            for (int j = 0; j < 2; ++j) { const size_t e = (size_t)row * DM + 512 * j + 8 * lane;
                if (OUT_F32) { *(f32x4*)((float*)xout + e) = v[2 * j]; *(f32x4*)((float*)xout + e + 4) = v[2 * j + 1]; }
                else { v4u w; w.x = pk2(v[2 * j].x, v[2 * j].y); w.y = pk2(v[2 * j].z, v[2 * j].w); w.z = pk2(v[2 * j + 1].x, v[2 * j + 1].y); w.w = pk2(v[2 * j + 1].z, v[2 * j + 1].w); *(v4u*)((bf16*)xout + e) = w; } } }
        if (hout) { const int b = row >> 13; const float* sh = mod + b * 3072; const float* scl = mod + b * 3072 + 1024;
#pragma unroll
            for (int j = 0; j < 2; ++j) { const int c = 512 * j + 8 * lane;
                const f32x4 h0 = v[2 * j] * (*(const f32x4*)(scl + c) + 1.0f) + *(const f32x4*)(sh + c), h1 = v[2 * j + 1] * (*(const f32x4*)(scl + c + 4) + 1.0f) + *(const f32x4*)(sh + c + 4);
                v4u w; w.x = pk2(h0.x, h0.y); w.y = pk2(h0.z, h0.w); w.z = pk2(h1.x, h1.y); w.w = pk2(h1.z, h1.w); *(v4u*)(hout + (size_t)row * DM + c) = w; } }
    }
}

__device__ __forceinline__ unsigned off_b(unsigned row, unsigned ch) { return 256u * row + 16u * (ch ^ (((row & 3) << 2) | ((row >> 2) & 3))); }
__device__ __forceinline__ s16x4 vtr(const LAS unsigned char* p) { typedef short v4i16_t __attribute__((ext_vector_type(4))); return __builtin_bit_cast(s16x4, __builtin_amdgcn_ds_read_tr16_b64_v4i16((LAS v4i16_t*)p)); }
__device__ __forceinline__ void attn_phase(LAS unsigned char* lds, const bf16* Q, const bf16* K, const bf16* V, bf16* O, const float* sinks, int tid, int lane, int wave, int G, int bid) {
    const int r32 = lane & 31, h = lane >> 5;
    const int blk = (lane >> 4) & 1, q4 = (lane & 15) >> 2, p4 = lane & 3;
    unsigned kofs[8], vofs[4][2];
    { const unsigned swzk = ((r32 & 3) << 2) | ((r32 >> 2) & 3);
#pragma unroll
      for (int s_ = 0; s_ < 8; ++s_) kofs[s_] = 256u * r32 + 16u * ((2u * s_ + h) ^ swzk);
#pragma unroll
      for (int c = 0; c < 4; ++c)
#pragma unroll
          for (int t_ = 0; t_ < 2; ++t_) { const unsigned xr = ((unsigned)q4 << 2) | ((h + 2u * t_) & 3u); vofs[c][t_] = 256u * (4u * h + q4) + 16u * ((4u * c + 2u * blk + (p4 >> 1)) ^ xr) + 8u * (p4 & 1); } }
    for (int unit = bid; unit < 1024; unit += G) {
        const int u = unit & 127, kvh = (unit >> 7) & 1, b = unit >> 8;
        const int head = kvh * 4 + (wave >> 1); const int qpos = 64 * u + 32 * (wave & 1) + r32;
        const size_t tokbase = (size_t)b * SEQ;
        bf16x8 qf[8];
        { const bf16* qp = Q + (tokbase + qpos) * 1024 + head * 128 + 8 * h;
#pragma unroll
          for (int s = 0; s < 8; ++s) qf[s] = *(const bf16x8*)(qp + 16 * s); }
        float mrun = sinks[head] * LOG2E; float lrun = (h == 0) ? 1.f : 0.f;
        f32x16 o[4];
#pragma unroll
        for (int c = 0; c < 4; ++c)
#pragma unroll
            for (int i = 0; i < 16; ++i) o[c][i] = 0.f;
        const int c_lo = (u < 2) ? 2 - u : 0, c_hi = (u > 125) ? 129 - u : 4;
        const int lrow0 = tid >> 4, lch = tid & 15;
        v4u kreg[2], vreg[2];
        __syncthreads();
        { const int kc = u - 2 + c_lo;
#pragma unroll
          for (int i = 0; i < 2; ++i) { const size_t g = (tokbase + 64 * kc + lrow0 + 32 * i) * 256 + kvh * 128 + lch * 8; kreg[i] = *(const v4u*)(K + g); vreg[i] = *(const v4u*)(V + g); }
#pragma unroll
          for (int i = 0; i < 2; ++i) { const unsigned ob = off_b(lrow0 + 32 * i, lch); *(LAS v4u*)(lds + ob) = kreg[i]; *(LAS v4u*)(lds + 32768 + ob) = vreg[i]; } }
        __syncthreads();
        for (int ci = c_lo; ci <= c_hi; ++ci) {
            const int buf = (ci - c_lo) & 1; const int kc = u - 2 + ci;
            const bool more = ci < c_hi;
            if (more) {
#pragma unroll
                for (int i = 0; i < 2; ++i) { const size_t g = (tokbase + 64 * (kc + 1) + lrow0 + 32 * i) * 256 + kvh * 128 + lch * 8; kreg[i] = *(const v4u*)(K + g); vreg[i] = *(const v4u*)(V + g); } }
            const LAS unsigned char* Kb = lds + buf * 16384; const LAS unsigned char* Vb = lds + 32768 + buf * 16384;
            f32x16 sa[2];
#pragma unroll
            for (int kt = 0; kt < 2; ++kt) {
                { const f32x16 zero16 = {0.f, 0.f, 0.f, 0.f, 0.f, 0.f, 0.f, 0.f, 0.f, 0.f, 0.f, 0.f, 0.f, 0.f, 0.f, 0.f};
                  const bf16x8 kf0 = *(const LAS bf16x8*)(Kb + kofs[0] + 8192 * kt); sa[kt] = __builtin_amdgcn_mfma_f32_32x32x16_bf16(kf0, qf[0], zero16, 0, 0, 0); }
#pragma unroll
                for (int s = 1; s < 8; ++s) { const bf16x8 kf = *(const LAS bf16x8*)(Kb + kofs[s] + 8192 * kt); sa[kt] = __builtin_amdgcn_mfma_f32_32x32x16_bf16(kf, qf[s], sa[kt], 0, 0, 0); }
            }
            float mx = -INFINITY;
            if (ci == 0 || ci == 4) {
#pragma unroll
                for (int kt = 0; kt < 2; ++kt)
#pragma unroll
                    for (int i = 0; i < 16; ++i) { const int kp = 64 * kc + 32 * kt + (i & 3) + 8 * (i >> 2) + 4 * h; const int d = qpos - kp; if (d > 128 || d < -128) sa[kt][i] = -INFINITY; }
            }
#pragma unroll
            for (int kt = 0; kt < 2; ++kt)
#pragma unroll
                for (int i = 0; i < 16; ++i) mx = fmaxf(mx, sa[kt][i]);
            mx = fmaxf(mx, __shfl_xor(mx, 32));
            const float mnew = fmaxf(mrun, mx); const float alpha = __builtin_amdgcn_exp2f(mrun - mnew); mrun = mnew;
            float ls = 0.f;
#pragma unroll
            for (int kt = 0; kt < 2; ++kt) {
                sa[kt] = sa[kt] - mnew;
#pragma unroll
                for (int i = 0; i < 16; ++i) sa[kt][i] = __builtin_amdgcn_exp2f(sa[kt][i]);
                f32x4 q4s = (f32x4){sa[kt][0], sa[kt][1], sa[kt][2], sa[kt][3]} + (f32x4){sa[kt][4], sa[kt][5], sa[kt][6], sa[kt][7]} + (f32x4){sa[kt][8], sa[kt][9], sa[kt][10], sa[kt][11]} + (f32x4){sa[kt][12], sa[kt][13], sa[kt][14], sa[kt][15]};
                ls += (q4s.x + q4s.y) + (q4s.z + q4s.w);
            }
            lrun = lrun * alpha + ls;
            if (__any(alpha != 1.0f)) {
#pragma unroll
                for (int c = 0; c < 4; ++c) o[c] = o[c] * alpha;
            }
#pragma unroll
            for (int kt = 0; kt < 2; ++kt)
#pragma unroll
                for (int s2 = 0; s2 < 2; ++s2) {
                    v4u pw; pw.x = pk2(sa[kt][8 * s2 + 0], sa[kt][8 * s2 + 1]); pw.y = pk2(sa[kt][8 * s2 + 2], sa[kt][8 * s2 + 3]); pw.z = pk2(sa[kt][8 * s2 + 4], sa[kt][8 * s2 + 5]); pw.w = pk2(sa[kt][8 * s2 + 6], sa[kt][8 * s2 + 7]);
                    const bf16x8 pf = __builtin_bit_cast(bf16x8, pw);
#pragma unroll
                    for (int c = 0; c < 4; ++c) {
                        const s16x4 lo = vtr(Vb + vofs[c][0] + (8192 * kt + 4096 * s2));
                        const s16x4 hi = vtr(Vb + vofs[c][1] + (8192 * kt + 4096 * s2 + 2048));
                        const bf16x8 vf = __builtin_shufflevector(lo, hi, 0, 1, 2, 3, 4, 5, 6, 7);
                        o[c] = __builtin_amdgcn_mfma_f32_32x32x16_bf16(vf, pf, o[c], 0, 0, 0);
                    }
                }
            if (more) {
#pragma unroll
                for (int i = 0; i < 2; ++i) { const unsigned ob = off_b(lrow0 + 32 * i, lch); *(LAS v4u*)(lds + (buf ^ 1) * 16384 + ob) = kreg[i]; *(LAS v4u*)(lds + 32768 + (buf ^ 1) * 16384 + ob) = vreg[i]; } }
            __syncthreads();
        }
        lrun += __shfl_xor(lrun, 32);
        const float rl = 1.0f / lrun;
        bf16* op = O + (tokbase + qpos) * 1024 + head * 128 + 4 * h;
#pragma unroll
        for (int c = 0; c < 4; ++c)
#pragma unroll
            for (int g = 0; g < 4; ++g) { v2u w; w.x = pk2(o[c][4 * g] * rl, o[c][4 * g + 1] * rl); w.y = pk2(o[c][4 * g + 2] * rl, o[c][4 * g + 3] * rl); *(v2u*)(op + 32 * c + 8 * g) = w; }
    }
}

constexpr int RL_XCB = 0, RL_XCT = 13312, RL_XRS = 27136, RL_T = 40000, RL_YO = 46144, RL_YOSZ = 26624, RL_PAR = 99392;
template <bool FINAL> __device__ __forceinline__ void rnn_phase(LAS unsigned char* lds, const bf16* XR, bf16* GG, const float* conv_w, const float* conv_b, const bf16* Wg,
        const float* b_a, const float* b_x, const float* sp8t, f32x2* agg, const float* cin, int tid, int lane, int wave, int G, int bid) {
    LAS unsigned short* XCB = (LAS unsigned short*)(lds + RL_XCB); LAS unsigned short* XCT = (LAS unsigned short*)(lds + RL_XCT); LAS unsigned short* XRS = (LAS unsigned short*)(lds + RL_XRS);
    LAS f32x2* T = (LAS f32x2*)(lds + RL_T); LAS float* YO = (LAS float*)(lds + RL_YO); LAS float* PAR = (LAS float*)(lds + RL_PAR);
    const int n = bid & 15, slot = bid >> 4, nslots = (G + 15 - n) >> 4;
    const int xr_r0 = tid / 12, xr_c0 = tid % 12, xr_r1 = (tid + 512) / 12, xr_c1 = (tid + 512) % 12; const bool xr_v1 = (tid + 512) < 67 * 12;
    const int cc = tid % 96, ctq = tid / 96; const int ccg = 96 * n + cc;
    float cw0 = 0.f, cw1 = 0.f, cw2 = 0.f, cw3 = 0.f, cbb = 0.f;
    if (tid < 384) { cw0 = conv_w[ccg]; cw1 = conv_w[DRNN + ccg]; cw2 = conv_w[2 * DRNN + ccg]; cw3 = conv_w[3 * DRNN + ccg]; cbb = conv_b[ccg]; }
    const int rtp = wave & 1, dir = wave >> 2, cth = (wave >> 1) & 1, l15 = lane & 15, l4 = lane >> 4; const bool fwd = (dir == 0);
    const bf16* wlane = Wg + ((size_t)((dir * 16 + n) * 2) * 96 + l15) * 96 + 8 * l4;
    __syncthreads();
    for (int i = tid; i < 576; i += NTHR) { const int d_ = i / 288, w_ = (i / 96) % 3, c_ = i % 96; const float* src = (w_ == 0) ? b_a : (w_ == 1) ? b_x : sp8t; PAR[i] = src[d_ * DRNN + 96 * n + c_]; }
    v4u xq0 = {0u, 0u, 0u, 0u}, xq1 = {0u, 0u, 0u, 0u};
#define RNN_LOAD_XR(pair) do { const int b_ = (pair) >> 7, ch_ = (pair) & 127; const size_t tb_ = (size_t)b_ * SEQ; const int tk0 = 64 * ch_ - 2 + xr_r0, tk1 = 64 * ch_ - 2 + xr_r1; \
        xq0 = (v4u){0u, 0u, 0u, 0u}; xq1 = xq0; \
        if (tk0 >= 0 && tk0 < SEQ) xq0 = *(const v4u*)(XR + (tb_ + tk0) * DRNN + 96 * n + 8 * xr_c0); \
        if (xr_v1 && tk1 >= 0 && tk1 < SEQ) xq1 = *(const v4u*)(XR + (tb_ + tk1) * DRNN + 96 * n + 8 * xr_c1); } while (0)
    bf16x8 wa[3][3], wx[3][3];
#pragma unroll
    for (int i = 0; i < 3; ++i)
#pragma unroll
        for (int ks = 0; ks < 3; ++ks) { wa[i][ks] = *(const bf16x8*)(wlane + (size_t)(16 * (3 * cth + i)) * 96 + 32 * ks); wx[i][ks] = *(const bf16x8*)(wlane + (size_t)(96 + 16 * (3 * cth + i)) * 96 + 32 * ks); }
    int pair = slot;
    if (pair < 512) RNN_LOAD_XR(pair);
    for (; pair < 512; pair += nslots) {
        const int b = pair >> 7, chunk = pair & 127; const size_t tokbase = (size_t)b * SEQ; const int t0 = 64 * chunk;
        *(LAS v4u*)(XRS + xr_r0 * 96 + xr_c0 * 8) = xq0; if (xr_v1) *(LAS v4u*)(XRS + xr_r1 * 96 + xr_c1 * 8) = xq1;
        __syncthreads();
        if (pair + nslots < 512) RNN_LOAD_XR(pair + nslots);
        v4u gq0 = {0u, 0u, 0u, 0u}, gq1 = gq0; float cinr[3] = {0.f, 0.f, 0.f};
        if (FINAL) {
            gq0 = *(const v4u*)(GG + (tokbase + t0 + tid / 12) * DRNN + 96 * n + 8 * (tid % 12));
            if (tid < 256) gq1 = *(const v4u*)(GG + (tokbase + t0 + (tid + 512) / 12) * DRNN + 96 * n + 8 * ((tid + 512) % 12));
#pragma unroll
            for (int i = 0; i < 3; ++i) cinr[i] = cin[((size_t)(b * 128 + chunk) * 2 + dir) * DRNN + 96 * n + 16 * (3 * cth + i) + l15];
        }
        if (tid < 384) {
            float x0 = bf2f(XRS[(16 * ctq + 0) * 96 + cc]), x1 = bf2f(XRS[(16 * ctq + 1) * 96 + cc]), x2 = bf2f(XRS[(16 * ctq + 2) * 96 + cc]);
#pragma unroll
            for (int k = 0; k < 16; ++k) { const int t = 16 * ctq + k; const float x3 = bf2f(XRS[(t + 3) * 96 + cc]);
                const float v = cbb + x0 * cw0 + x1 * cw1 + x2 * cw2 + x3 * cw3;
                const unsigned short vb = (unsigned short)(pk2(v, 0.f) & 0xffffu);
                XCB[t * 104 + cc] = vb; XCT[cc * 72 + t] = vb;
                x0 = x1; x1 = x2; x2 = x3; } }
        __syncthreads();
        float ar[6][4], ur[6][4], Ae[6], He[6];
#pragma unroll
        for (int tt = 0; tt < 2; ++tt) {
            const int rt = 2 * rtp + tt;
            bf16x8 xa[3];
#pragma unroll
            for (int ks = 0; ks < 3; ++ks) xa[ks] = *(const LAS bf16x8*)(XCB + (16 * rt + l15) * 104 + 32 * ks + 8 * l4);
#pragma unroll
            for (int i = 0; i < 3; ++i) {
                const int it = tt * 3 + i;
                f32x4 ga = {0.f, 0.f, 0.f, 0.f}, gx = {0.f, 0.f, 0.f, 0.f};
#pragma unroll
                for (int ks = 0; ks < 3; ++ks) {
                    ga = __builtin_amdgcn_mfma_f32_16x16x32_bf16(xa[ks], wa[i][ks], ga, 0, 0, 0);
                    gx = __builtin_amdgcn_mfma_f32_16x16x32_bf16(xa[ks], wx[i][ks], gx, 0, 0, 0);
                }
                const int c = 16 * (3 * cth + i) + l15;
                const float ba = PAR[dir * 288 + c], bx = PAR[dir * 288 + 96 + c], lm = PAR[dir * 288 + 192 + c];
                const v2u xcw = *(const LAS v2u*)(XCT + c * 72 + 16 * rt + 4 * l4);
                const float xc[4] = {__uint_as_float(xcw.x << 16), __uint_as_float(xcw.x & 0xffff0000u), __uint_as_float(xcw.y << 16), __uint_as_float(xcw.y & 0xffff0000u)};
#pragma unroll
                for (int p2 = 0; p2 < 2; ++p2) {
                    const f32x2 za = (f32x2){ga[2 * p2], ga[2 * p2 + 1]} + ba, zx = (f32x2){gx[2 * p2], gx[2 * p2 + 1]} + bx;
                    const f32x2 ta = za * (-1.4426950408889634f), tx = zx * (-1.4426950408889634f);
                    const f32x2 da = (f32x2){__builtin_amdgcn_exp2f(ta.x), __builtin_amdgcn_exp2f(ta.y)} + 1.0f, dx = (f32x2){__builtin_amdgcn_exp2f(tx.x), __builtin_amdgcn_exp2f(tx.y)} + 1.0f;
                    const f32x2 ra = {__builtin_amdgcn_rcpf(da.x), __builtin_amdgcn_rcpf(da.y)}, ii = {__builtin_amdgcn_rcpf(dx.x), __builtin_amdgcn_rcpf(dx.y)};
                    const f32x2 la = ra * (-lm);
                    const f32x2 tl = la * 1.4426950408889634f;
                    const f32x2 x = la + la;
                    f32x2 pz = x * (1.0f / 24.0f) + (1.0f / 6.0f); pz = pz * x + 0.5f; pz = pz * x + 1.0f;
                    const f32x2 m2 = x * pz;
                    const f32x2 w2 = ii * (f32x2){xc[2 * p2], xc[2 * p2 + 1]};
                    const f32x2 uu = (f32x2){__builtin_amdgcn_sqrtf(-m2.x), __builtin_amdgcn_sqrtf(-m2.y)} * w2;
                    ar[it][2 * p2] = __builtin_amdgcn_exp2f(tl.x); ar[it][2 * p2 + 1] = __builtin_amdgcn_exp2f(tl.y);
                    ur[it][2 * p2] = uu.x; ur[it][2 * p2 + 1] = uu.y;
                }
                float A = 1.f, H = 0.f;
#pragma unroll
                for (int k = 0; k < 4; ++k) { const int r = fwd ? k : 3 - k; H = ar[it][r] * H + ur[it][r]; A *= ar[it][r]; }
                const int p = fwd ? l4 : 3 - l4;
#pragma unroll
                for (int d = 1; d <= 2; d <<= 1) {
                    const int src = fwd ? lane - 16 * d : lane + 16 * d;
                    const float Ap = __shfl(A, src & 63), Hp = __shfl(H, src & 63);
                    if (p >= d) { H = A * Hp + H; A = Ap * A; }
                }
                { const int src = fwd ? lane - 16 : lane + 16;
                  const float Ap = __shfl(A, src & 63), Hp = __shfl(H, src & 63);
                  Ae[it] = (p >= 1) ? Ap : 1.f; He[it] = (p >= 1) ? Hp : 0.f; }
                if (p == 3) T[(dir * 4 + rt) * 96 + c] = (f32x2){A, H};
            }
        }
        __syncthreads();
        if (!FINAL) {
            if (rtp == 0 && l4 == 0) {
#pragma unroll
                for (int i = 0; i < 3; ++i) { const int c = 16 * (3 * cth + i) + l15; float A = 1.f, H = 0.f;
#pragma unroll
                    for (int k = 0; k < 4; ++k) { const f32x2 tv = T[(dir * 4 + (fwd ? k : 3 - k)) * 96 + c]; H = tv.x * H + tv.y; A *= tv.x; }
                    agg[((size_t)(b * 128 + chunk) * 2 + dir) * DRNN + 96 * n + c] = (f32x2){A, H}; }
            }
        } else {
            LAS float* YOd = YO + dir * (RL_YOSZ / 4);
#pragma unroll
            for (int tt = 0; tt < 2; ++tt) {
                const int rt = 2 * rtp + tt;
#pragma unroll
                for (int i = 0; i < 3; ++i) { const int it = tt * 3 + i; const int c = 16 * (3 * cth + i) + l15;
                    float Hc = cinr[i];
#pragma unroll
                    for (int k = 0; k < 3; ++k) { const int tq = fwd ? k : 3 - k; const bool before = fwd ? (tq < rt) : (tq > rt); const f32x2 tv = T[(dir * 4 + tq) * 96 + c]; if (before) Hc = tv.x * Hc + tv.y; }
                    float h = Ae[it] * Hc + He[it];
#pragma unroll
                    for (int k = 0; k < 4; ++k) { const int r = fwd ? k : 3 - k; h = ar[it][r] * h + ur[it][r]; YOd[(16 * rt + 4 * l4 + r) * 104 + c] = h; }
                }
            }
            __syncthreads();
#pragma unroll
            for (int it2 = 0; it2 < 2; ++it2) { const int idx = tid + 512 * it2; if (it2 == 1 && tid >= 256) break; const int t = idx / 12, ch = idx % 12;
                const v4u gv = it2 ? gq1 : gq0;
                const f32x4 f0 = *(const LAS f32x4*)(YO + t * 104 + 8 * ch), f1 = *(const LAS f32x4*)(YO + t * 104 + 8 * ch + 4);
                const f32x4 r0 = *(const LAS f32x4*)(YO + (RL_YOSZ / 4) + t * 104 + 8 * ch), r1 = *(const LAS f32x4*)(YO + (RL_YOSZ / 4) + t * 104 + 8 * ch + 4);
                const f32x4 y0 = f0 + r0, y1 = f1 + r1;
                v4u ov;
                ov.x = pk2(y0[0] * __uint_as_float(gv.x << 16), y0[1] * __uint_as_float(gv.x & 0xffff0000u));
                ov.y = pk2(y0[2] * __uint_as_float(gv.y << 16), y0[3] * __uint_as_float(gv.y & 0xffff0000u));
                ov.z = pk2(y1[0] * __uint_as_float(gv.z << 16), y1[1] * __uint_as_float(gv.z & 0xffff0000u));
                ov.w = pk2(y1[2] * __uint_as_float(gv.w << 16), y1[3] * __uint_as_float(gv.w & 0xffff0000u));
                *(v4u*)(GG + (tokbase + t0 + t) * DRNN + 96 * n + 8 * ch) = ov; }
        }
    }
#undef RNN_LOAD_XR
}
__device__ __forceinline__ void rnn_carry_phase(const f32x2* agg, float* cin, int tid, int G, int bid) {
    for (int g = bid * NTHR + tid; g < BATCH * 2 * DRNN; g += G * NTHR) {
        const int ch = g % DRNN, dir = (g / DRNN) & 1, b = g / (2 * DRNN);
        float carry = 0.f;
#pragma unroll 8
        for (int k = 0; k < 128; ++k) { const int chunk = dir ? 127 - k : k; const size_t idx = ((size_t)(b * 128 + chunk) * 2 + dir) * DRNN + ch;
            const f32x2 av = agg[idx]; cin[idx] = carry; carry = av.x * carry + av.y; }
    }
}

__global__ void __launch_bounds__(NTHR, 2) fwd_megakernel(Args args) {
    extern __shared__ __attribute__((aligned(16))) unsigned char lds_raw[];
    LAS unsigned char* lds = (LAS unsigned char*)lds_raw;
    cg::grid_group grid = cg::this_grid();
    const int tid = threadIdx.x, lane = tid & 63, wave = __builtin_amdgcn_readfirstlane(tid >> 6);
    const int G = gridDim.x, bid = blockIdx.x;
    unsigned char* ws = args.ws;
    float* MOD = (float*)(ws + WS_MOD); bf16* XB = (bf16*)(ws + WS_XB); bf16* HB = (bf16*)(ws + WS_HB);
    bf16* Qb = (bf16*)(ws + WS_Q); bf16* Kb = (bf16*)(ws + WS_K); bf16* Vb = (bf16*)(ws + WS_V); bf16* Ob = (bf16*)(ws + WS_O);
    bf16* Hbig = (bf16*)(ws + WS_BIG); bf16* XR = (bf16*)(ws + WS_XR); bf16* GG = (bf16*)(ws + WS_GG);
    const float* ln_g = args.in[4]; const float* ln_b = args.in[5];
    using namespace pg8;

    volatile LAS unsigned* MISC = (volatile LAS unsigned*)(lds + LDS_BYTES - 64);
    if (tid < 2) MISC[tid] = 0u;
    if (bid == 0) { for (int i = tid; i < XCD_BAR_WORDS; i += NTHR) ((unsigned*)(ws + WS_BAR))[i] = 0u; }
    __syncthreads();
    p0_prologue(args, lds, tid, lane, wave, G, bid);
    grid.sync();
    (void)xcd_barrier_post((unsigned*)(ws + WS_BAR), MISC);
#define GRID_BAR() do { XcdBarrier b_; b_.bar = (unsigned*)(args.ws + WS_BAR); b_.x = xb_xcc_id(); b_.st = (volatile LAS unsigned*)(lds + LDS_BYTES - 64); xcd_barrier(b_); } while (0)
    ln_mod_phase<false, true, false>(args.in[0], nullptr, HB, nullptr, nullptr, MOD + 0 * 12288, nullptr, lane, wave, G, bid);
    GRID_BAR();
    { Gemm g{HB, (const bf16_t*)(ws + WS_WQKV), M, NQKV, DM}; StaticOrder S; S.init(M, NQKV, G, bid);
      EpiQKV E{Qb, Kb, Vb, (const float*)(ws + WS_CS), 0.08838834764831845f * LOG2E};
      gemm_phase<EpiQKV, StaticOrder, true, true>(lds, g, S, E); }
    GRID_BAR();
    attn_phase(lds, Qb, Kb, Vb, Ob, args.in[8], tid, lane, wave, G, bid);
    GRID_BAR();
    { Gemm g{Ob, (const bf16_t*)(ws + WS_WO), M, DM, DM}; StaticOrder S; S.init(M, DM, G, bid);
      EpiRes<true> E{ws, args.in[0], ln_g, ln_b, 0};
      gemm_phase<EpiRes<true>, StaticOrder, true, true>(lds, g, S, E); }
    GRID_BAR();
    ln_mod_phase<true, false, false>(XB, nullptr, HB, ln_g + 0 * 1024, ln_b + 0 * 1024, MOD + 1 * 12288, (float*)(ws + WS_STAT), lane, wave, G, bid);
    GRID_BAR();
    { Gemm g{HB, (const bf16_t*)(ws + WS_W1), M, DFF, DM}; StaticOrder S; S.init(M, DFF, G, bid);
      EpiAct<0> E{Hbig, nullptr, DFF};
      gemm_phase<EpiAct<0>, StaticOrder, true, true>(lds, g, S, E); }
    GRID_BAR();
    { Gemm g{Hbig, (const bf16_t*)(ws + WS_W2), M, DM, DFF}; StaticOrder S; S.init(M, DM, G, bid);
      EpiRes<false> E{ws, nullptr, ln_g, ln_b, 1};
      gemm_phase<EpiRes<false>, StaticOrder, true, true>(lds, g, S, E); }
    GRID_BAR();
    ln_mod_phase<true, false, false>(XB, nullptr, HB, ln_g + 1 * 1024, ln_b + 1 * 1024, MOD + 2 * 12288, (float*)(ws + WS_STAT), lane, wave, G, bid);
    GRID_BAR();
    { Gemm g{HB, (const bf16_t*)(ws + WS_WRIN), M, 2 * DRNN, DM}; StaticOrder S; S.init(M, 2 * DRNN, G, bid);
      EpiAct<1> E{XR, GG, DRNN};
      gemm_phase<EpiAct<1>, StaticOrder, true, true>(lds, g, S, E); }
    GRID_BAR();
    rnn_phase<false>(lds, XR, GG, args.in[10], args.in[11], (const bf16*)(ws + WS_WG), args.in[13], args.in[15], (const float*)(ws + WS_SP8), (f32x2*)(ws + WS_AGG), (const float*)(ws + WS_CIN), tid, lane, wave, G, bid);
    GRID_BAR();
    rnn_carry_phase((const f32x2*)(ws + WS_AGG), (float*)(ws + WS_CIN), tid, G, bid);
    GRID_BAR();
    rnn_phase<true>(lds, XR, GG, args.in[10], args.in[11], (const bf16*)(ws + WS_WG), args.in[13], args.in[15], (const float*)(ws + WS_SP8), (f32x2*)(ws + WS_AGG), (const float*)(ws + WS_CIN), tid, lane, wave, G, bid);
    GRID_BAR();
    { Gemm g{GG, (const bf16_t*)(ws + WS_WROUT), M, DM, DRNN}; StaticOrder S; S.init(M, DM, G, bid);
      EpiRes<false> E{ws, nullptr, ln_g, ln_b, 2};
      gemm_phase<EpiRes<false>, StaticOrder, true, true>(lds, g, S, E); }
    GRID_BAR();
    ln_mod_phase<true, false, false>(XB, nullptr, HB, ln_g + 2 * 1024, ln_b + 2 * 1024, MOD + 3 * 12288, (float*)(ws + WS_STAT), lane, wave, G, bid);
    GRID_BAR();
    { Gemm g{HB, (const bf16_t*)(ws + WS_W1) + (size_t)DFF * DM, M, DFF, DM}; StaticOrder S; S.init(M, DFF, G, bid);
      EpiAct<0> E{Hbig, nullptr, DFF};
      gemm_phase<EpiAct<0>, StaticOrder, true, true>(lds, g, S, E); }
    GRID_BAR();
    { Gemm g{Hbig, (const bf16_t*)(ws + WS_W2) + (size_t)DM * DFF, M, DM, DFF}; StaticOrder S; S.init(M, DM, G, bid);
      EpiRes<false> E{ws, nullptr, ln_g, ln_b, 3};
      gemm_phase<EpiRes<false>, StaticOrder, true, true>(lds, g, S, E); }
    GRID_BAR();
    ln_mod_phase<true, false, true>(XB, args.out, nullptr, ln_g + 3 * 1024, ln_b + 3 * 1024, nullptr, nullptr, lane, wave, G, bid);
}

extern "C" void kernel_launch(void* const* d_in, const int* in_sizes, int n_in, void* d_out, int out_size, void* d_ws, size_t ws_size, hipStream_t stream) {
    static int grid = 0;
    if (grid == 0) {
        if (n_in != 20 || out_size != M * DM || ws_size < WS_END) { fprintf(stderr, "kernel_launch: unexpected problem (n_in %d, out %d, ws %zu)\n", n_in, out_size, ws_size); grid = -1; return; }
        int dev = 0, cus = 0, per_cu = 0;
        (void)hipGetDevice(&dev); (void)hipDeviceGetAttribute(&cus, hipDeviceAttributeMultiprocessorCount, dev);
        if (hipFuncSetAttribute((const void*)fwd_megakernel, hipFuncAttributeMaxDynamicSharedMemorySize, LDS_BYTES) != hipSuccess) { fprintf(stderr, "kernel_launch: hipFuncSetAttribute failed\n"); grid = -1; return; }
        if (hipOccupancyMaxActiveBlocksPerMultiprocessor(&per_cu, (const void*)fwd_megakernel, NTHR, LDS_BYTES) != hipSuccess || per_cu < 1) { fprintf(stderr, "kernel_launch: occupancy query gave %d\n", per_cu); per_cu = 1; }
        (void)hipGetLastError();
        grid = cus * 1;
    }
    if (grid < 0) return;
    Args a{};
    for (int i = 0; i < 20; ++i) a.in[i] = (const float*)d_in[i];
    a.out = (float*)d_out; a.ws = (unsigned char*)d_ws;
    void* kargs[] = {&a};
    hipError_t e = hipLaunchCooperativeKernel((const void*)fwd_megakernel, dim3(grid), dim3(NTHR), kargs, LDS_BYTES, stream);
    if (e != hipSuccess) fprintf(stderr, "cooperative launch failed: %s (grid %d)\n", hipGetErrorString(e), grid);
}
```

```cpp
#include <hip/hip_runtime.h>
#include <hip/hip_cooperative_groups.h>
#include <cstdio>
#include <cstdint>
namespace cg = cooperative_groups;
constexpr int NWAVES = 8, NTHR = 512;
constexpr int BATCH = 4, SEQ = 8192, DM = 1024, M = BATCH * SEQ, DFF = 4096, DRNN = 1536, NQKV = 1536;
constexpr float LN_EPS = 1e-5f, DN_ALPHA = 1.4142135623730951f, LOG2E = 1.4426950408889634f;
constexpr int LDS_BYTES = 147456;
constexpr size_t MiB = 1u << 20;
constexpr size_t WS_MOD = 0;
constexpr size_t WS_BAR = 768 * 1024;
constexpr size_t WS_STAT = 256 * 1024;
constexpr size_t WS_SP8 = 512 * 1024;
constexpr size_t WS_CS = 1 * MiB;
constexpr size_t WS_WG = 2 * MiB;
constexpr size_t WS_WQKV = 4 * MiB;
constexpr size_t WS_WO = 7 * MiB;
constexpr size_t WS_WRIN = 9 * MiB;
constexpr size_t WS_WROUT = 15 * MiB;
constexpr size_t WS_W1 = 18 * MiB;
constexpr size_t WS_W2 = 34 * MiB;
constexpr size_t WS_XB = 50 * MiB;
constexpr size_t WS_HB = 178 * MiB;
constexpr size_t WS_BIG = 242 * MiB;
constexpr size_t WS_Q = WS_BIG, WS_K = WS_BIG + 64 * MiB, WS_V = WS_BIG + 80 * MiB, WS_O = WS_BIG + 96 * MiB;
constexpr size_t WS_XR = WS_BIG, WS_GG = WS_BIG + 96 * MiB;
constexpr size_t WS_AGG = WS_BIG + 192 * MiB;
constexpr size_t WS_CIN = WS_BIG + 208 * MiB;
constexpr size_t WS_END = WS_BIG + 256 * MiB;

namespace pg8 {
#define PG8_LAS __attribute__((address_space(3)))
typedef unsigned short bf16_t;
typedef short bf16x8 __attribute__((ext_vector_type(8)));
typedef float f32x4 __attribute__((ext_vector_type(4)));
typedef unsigned u32x4 __attribute__((ext_vector_type(4)));
constexpr int BM = 256, BK = 64, HALF = 128, HTB = HALF * BK * 2  , STAGE_BYTES = 8 * HTB, NXCD = 8, WGM = 8;

__host__ __device__ __forceinline__ int lds_byte(int r, int c) { const int st = (r >> 4) * 2 + (c >> 5), rr = r & 15, cc = c & 31, ob = rr * 64 + cc * 2; return st * 1024 + (ob ^ (((ob >> 9) & 1) << 5)); }
__host__ __device__ __forceinline__ void stage_rc(int b, int& R, int& C) { const int st = b / 1024, sb = b % 1024, swz = sb ^ (((sb >> 9) & 1) << 5); R = (st >> 1) * 16 + swz / 64; C = (st & 1) * 32 + (swz % 64) / 2; }
__host__ __device__ __forceinline__ int perm32(int rho) { const int n = rho >> 4, i = rho & 15; return 8 * (i >> 2) + 4 * n + (i & 3); }

struct Unit { int pm, pn; };
struct Gemm { const bf16_t* A; const bf16_t* Bt; int M, N, K; };

struct StaticOrder {
    int nM, nN, nwg, G, c;
    __host__ __device__ void init(int M, int N, int G_, int c_) { nM = M / BM; nN = N / BM; nwg = nM * nN; G = G_; c = c_; }
    __host__ __device__ bool next(int i, Unit& u) const {
        const long L = (long)i * G + c; if (L >= nwg) return false;
        int wgid = (int)L; { const int q = nwg / NXCD, r = nwg % NXCD, xcd = wgid % NXCD, off = wgid / NXCD; wgid = (xcd < r ? xcd * (q + 1) : r * (q + 1) + (xcd - r) * q) + off; }
        const int nig = WGM * nN, gid = wgid / nig, fm = gid * WGM, gsz = (nM - fm) < WGM ? (nM - fm) : WGM;
        u.pm = fm + ((wgid % nig) % gsz); u.pn = (wgid % nig) / gsz; return true;
    }
    __device__ __forceinline__ void a_ready(const Unit&) const {}
    __device__ __forceinline__ void done(const Unit&) const {}
};

__device__ __forceinline__ unsigned cvt_pk_bf16(float lo, float hi) { unsigned r; asm volatile("v_cvt_pk_bf16_f32 %0, %1, %2" : "=v"(r) : "v"(lo), "v"(hi)); return r; }
__device__ __forceinline__ u32x4 pack8(const f32x4 v0, const f32x4 v1) { u32x4 w; w.x = cvt_pk_bf16(v0[0], v0[1]); w.y = cvt_pk_bf16(v0[2], v0[3]); w.z = cvt_pk_bf16(v1[0], v1[1]); w.w = cvt_pk_bf16(v1[2], v1[3]); return w; }
struct EpiQKV {
    static constexpr bool PERM = true, AFTER_DRAIN = false;
    bf16_t* Q; bf16_t* K; bf16_t* V; const float* cs; float qscale;
    __device__ __forceinline__ void operator()(const f32x4 (&acc)[2][2][4][2], const Unit& u, int wr, int wc, int fr, int fq) const {
        const int row0 = u.pm * BM + wr * 64 + fr;
        bf16_t* base; int ld, colt; float sc = 1.f; bool rope = true;
        if (u.pn < 4) { base = Q; ld = 1024; colt = u.pn * BM; sc = qscale; }
        else if (u.pn == 4) { base = K; ld = 256; colt = 0; }
        else { base = V; ld = 256; colt = 0; rope = false; }
        const int col0 = colt + wc * 32 + 8 * fq;
        const bool dorope = rope && (wc == 0);
#pragma unroll
        for (int ai = 0; ai < 2; ++ai)
#pragma unroll
            for (int m = 0; m < 4; ++m) {
                const int row = row0 + ai * HALF + m * 16; const int pos = row & 8191;
                f32x4 c0 = {1.f, 1.f, 1.f, 1.f}, c1 = c0, s0 = {0.f, 0.f, 0.f, 0.f}, s1 = s0;
                if (dorope) { const float* t = cs + (size_t)pos * 32 + 8 * (fq & 1); c0 = *(const f32x4*)t; c1 = *(const f32x4*)(t + 4); s0 = *(const f32x4*)(t + 16); s1 = *(const f32x4*)(t + 20);
                    if (fq < 2) { s0 = -s0; s1 = -s1; } }
#pragma unroll
                for (int bj = 0; bj < 2; ++bj) {
                    f32x4 v0 = acc[ai][bj][m][0], v1 = acc[ai][bj][m][1];
                    if (dorope) { f32x4 p0, p1;
#pragma unroll
                        for (int j = 0; j < 4; ++j) { p0[j] = __shfl_xor(v0[j], 32); p1[j] = __shfl_xor(v1[j], 32); }
                        v0 = v0 * c0 + p0 * s0; v1 = v1 * c1 + p1 * s1; }
                    v0 = v0 * sc; v1 = v1 * sc;
                    *(u32x4*)(base + (size_t)row * ld + col0 + bj * HALF) = pack8(v0, v1);
                }
            }
    }
};
template <bool XF32> struct EpiRes {
    static constexpr bool PERM = true, AFTER_DRAIN = false;
    unsigned char* ws; const float* xin; const float* lng_all; const float* lnb_all; int k;
    __device__ __forceinline__ void operator()(const f32x4 (&acc)[2][2][4][2], const Unit& u, int wr, int wc, int fr, int fq) const {
        const int row0 = u.pm * BM + wr * 64 + fr, col0 = u.pn * BM + wc * 32 + 8 * fq;
        const int b = (u.pm * BM) >> 13;
        const void* xres = XF32 ? (const void*)xin : (const void*)(ws + WS_XB); bf16_t* out = (bf16_t*)(ws + WS_XB); constexpr float alpha = DN_ALPHA;
        const float* gate = (const float*)(ws + WS_MOD) + k * 12288 + 2048; const float* stat = (const float*)(ws + WS_STAT);
        const float* lng = lng_all + (k - 1) * 1024; const float* lnb = lnb_all + (k - 1) * 1024;
#pragma unroll
        for (int bj = 0; bj < 2; ++bj) {
            const f32x4 g0 = *(const f32x4*)(gate + b * 3072 + col0 + bj * HALF) + 1.0f, g1 = *(const f32x4*)(gate + b * 3072 + col0 + bj * HALF + 4) + 1.0f;
            f32x4 G0, G1, B0, B1;
            if (!XF32) { G0 = *(const f32x4*)(lng + col0 + bj * HALF); G1 = *(const f32x4*)(lng + col0 + bj * HALF + 4); B0 = *(const f32x4*)(lnb + col0 + bj * HALF); B1 = *(const f32x4*)(lnb + col0 + bj * HALF + 4); }
#pragma unroll
            for (int ai = 0; ai < 2; ++ai)
#pragma unroll
                for (int m = 0; m < 4; ++m) { const size_t off = (size_t)(row0 + ai * HALF + m * 16) * 1024 + col0 + bj * HALF;
                    f32x4 x0, x1;
                    if (XF32) { x0 = *(const f32x4*)((const float*)xres + off); x1 = *(const f32x4*)((const float*)xres + off + 4); }
                    else { const u32x4 w = *(const u32x4*)((const bf16_t*)xres + off);
                        x0 = (f32x4){__uint_as_float(w.x << 16), __uint_as_float(w.x & 0xffff0000u), __uint_as_float(w.y << 16), __uint_as_float(w.y & 0xffff0000u)};
                        x1 = (f32x4){__uint_as_float(w.z << 16), __uint_as_float(w.z & 0xffff0000u), __uint_as_float(w.w << 16), __uint_as_float(w.w & 0xffff0000u)};
                        typedef float f32x2e __attribute__((ext_vector_type(2))); const f32x2e sr = *(const f32x2e*)(stat + 2 * (row0 + ai * HALF + m * 16));
                        x0 = (x0 - sr.x) * sr.y * G0 + B0; x1 = (x1 - sr.x) * sr.y * G1 + B1; }
                    *(u32x4*)(out + off) = pack8(x0 * alpha + g0 * acc[ai][bj][m][0], x1 * alpha + g1 * acc[ai][bj][m][1]);
                    if (m & 1) asm volatile("" ::: "memory"); }
        }
    }
};
__device__ __forceinline__ float gelu_tanh(float x) { const float t = x * x * 0.044715f + 1.0f; const float e = __builtin_amdgcn_exp2f(-2.302208198f * (x * t)); return x * __builtin_amdgcn_rcpf(1.0f + e); }
template <int MODE> struct EpiAct {
    static constexpr bool PERM = true, AFTER_DRAIN = false;
    bf16_t* O; bf16_t* O2; int ldc;
    __device__ __forceinline__ void operator()(const f32x4 (&acc)[2][2][4][2], const Unit& u, int wr, int wc, int fr, int fq) const {
        const int row0 = u.pm * BM + wr * 64 + fr; int colt = u.pn * BM; bf16_t* base = O; bool act = (MODE == 0);
        if (MODE == 1 && u.pn >= 6) { base = O2; colt -= 1536; act = true; }
        const int col0 = colt + wc * 32 + 8 * fq;
#pragma unroll
        for (int ai = 0; ai < 2; ++ai)
#pragma unroll
            for (int m = 0; m < 4; ++m) { bf16_t* rowp = base + (size_t)(row0 + ai * HALF + m * 16) * ldc + col0;
#pragma unroll
                for (int bj = 0; bj < 2; ++bj) { f32x4 v0 = acc[ai][bj][m][0], v1 = acc[ai][bj][m][1];
                    if (act) {
#pragma unroll
                        for (int j = 0; j < 4; ++j) {
                            if (MODE == 0) { const float a = fmaxf(v0[j], 0.f), b = fmaxf(v1[j], 0.f); v0[j] = a * a; v1[j] = b * b; }
                            else { v0[j] = gelu_tanh(v0[j]); v1[j] = gelu_tanh(v1[j]); } } }
                    *(u32x4*)(rowp + bj * HALF) = pack8(v0, v1); } }
    }
};
template <class Epi, class Sched, bool ALIGN_EPI = false, bool SP2 = false>
__device__ __forceinline__ void gemm_phase(PG8_LAS unsigned char* lds, const Gemm g, const Sched& S, const Epi& E) {
    int tid_ = threadIdx.x; asm volatile("" : "+v"(tid_));
    const int tid = tid_, wid = __builtin_amdgcn_readfirstlane(tid >> 6), lane = tid & 63, wr = wid >> 2, wc = wid & 3, fr = lane & 15, fq = lane >> 4;
    const int K = g.K, nt = K / BK;
    unsigned voffA[2], voffB[2];
#pragma unroll
    for (int i = 0; i < 2; ++i) { int R, C; stage_rc(tid * 16 + i * 8192, R, C); const int Rb = Epi::PERM ? ((R & ~31) + perm32(R & 31)) : R;
        voffA[i] = (unsigned)(R * K + C) * 2u; voffB[i] = (unsigned)(Rb * K + C) * 2u; }
    const size_t kstep = (size_t)(BK * 2);
    const size_t hstep = (size_t)HALF * K * 2;
    const size_t tstep = 2 * hstep;
    const unsigned ldsw = (unsigned)wid * 1024u;
    const int aoff = lds_byte(wr * 64 + fr, fq * 8), boff = lds_byte(wc * 32 + fr, fq * 8);
#define PG8_SA(b, h) (((b) * 2 + (h)) * HTB)
#define PG8_SB(b, h) ((4 + (b) * 2 + (h)) * HTB)
#define PG8_STAGE(bufoff, gbase, voff) do { _Pragma("unroll") for (int _i = 0; _i < 2; ++_i) \
        __builtin_amdgcn_global_load_lds((const unsigned*)((const char*)(gbase) + (voff)[_i]), (PG8_LAS unsigned*)(lds + (bufoff) + ldsw + _i * 8192), 16, 0, 0); } while (0)
#define PG8_LDA(dst, b, h) do { _Pragma("unroll") for (int m = 0; m < 4; ++m) _Pragma("unroll") for (int k = 0; k < 2; ++k) dst[m][k] = *(const PG8_LAS bf16x8*)(lds + PG8_SA(b, h) + aoff + m * 2048 + k * 1024); } while (0)
#define PG8_LDB(dst, b, h) do { _Pragma("unroll") for (int n = 0; n < 2; ++n) _Pragma("unroll") for (int k = 0; k < 2; ++k) dst[n][k] = *(const PG8_LAS bf16x8*)(lds + PG8_SB(b, h) + boff + n * 2048 + k * 1024); } while (0)
#define PG8_MMA(ai, bj, At, Bt) do { __builtin_amdgcn_s_setprio(1); _Pragma("unroll") for (int m = 0; m < 4; ++m) _Pragma("unroll") for (int n = 0; n < 2; ++n) _Pragma("unroll") for (int k = 0; k < 2; ++k) \
        acc[ai][bj][m][n] = __builtin_amdgcn_mfma_f32_16x16x32_bf16(Bt[n][k], At[m][k], acc[ai][bj][m][n], 0, 0, 0); __builtin_amdgcn_s_setprio(0); } while (0)
#define PG8_WAIT_V(n) asm volatile("s_waitcnt vmcnt(" #n ")" ::: "memory")
#define PG8_WAIT_L(n) asm volatile("s_waitcnt lgkmcnt(" #n ")" ::: "memory")
#define PG8_BAR __builtin_amdgcn_s_barrier()
#define PG8_SCHED __builtin_amdgcn_sched_barrier(0)
    Unit cur, nxt; int ui = 0;
    if (!S.next(0, cur)) return;
    f32x4 acc[2][2][4][2];
#pragma unroll
    for (int a = 0; a < 2; ++a)
#pragma unroll
        for (int b = 0; b < 2; ++b)
#pragma unroll
            for (int m = 0; m < 4; ++m)
#pragma unroll
                for (int n = 0; n < 2; ++n) acc[a][b][m][n] = (f32x4){0.f, 0.f, 0.f, 0.f};
    bf16x8 At[4][2], B0[2][2], B1[2][2];
    const char* cA = (const char*)g.A + (size_t)cur.pm * tstep; const char* cB = (const char*)g.Bt + (size_t)cur.pn * tstep;
    S.a_ready(cur);
    if constexpr (SP2) {
        PG8_STAGE(PG8_SB(0, 0), cB, voffB); PG8_STAGE(PG8_SB(0, 1), cB + hstep, voffB); PG8_STAGE(PG8_SA(0, 0), cA, voffA); PG8_STAGE(PG8_SA(0, 1), cA + hstep, voffA);
        if (wr == 1) PG8_BAR;
        PG8_WAIT_V(2); PG8_BAR;
        PG8_STAGE(PG8_SB(1, 0), cB + kstep, voffB); PG8_STAGE(PG8_SA(1, 0), cA + kstep, voffA); PG8_STAGE(PG8_SB(1, 1), cB + hstep + kstep, voffB);
        PG8_WAIT_V(6); PG8_BAR;
    } else {
        PG8_STAGE(PG8_SB(0, 0), cB, voffB); PG8_STAGE(PG8_SA(0, 0), cA, voffA); PG8_STAGE(PG8_SB(0, 1), cB + hstep, voffB); PG8_STAGE(PG8_SA(0, 1), cA + hstep, voffA);
        if (wr == 1) PG8_BAR;
        PG8_WAIT_V(4); PG8_BAR;
        PG8_STAGE(PG8_SB(1, 0), cB + kstep, voffB); PG8_STAGE(PG8_SA(1, 0), cA + kstep, voffA); PG8_STAGE(PG8_SB(1, 1), cB + hstep + kstep, voffB);
        PG8_WAIT_V(6); PG8_BAR;
    }
    for (;;) {
        const bool has_next = S.next(ui + 1, nxt);
        const char* nA = has_next ? (const char*)g.A + (size_t)nxt.pm * tstep : cA; const char* nB = has_next ? (const char*)g.Bt + (size_t)nxt.pn * tstep : cB;
        for (int t = 0; t < nt; t += 2) {
            const bool last = (t == nt - 2);
            const char* a1 = cA + (size_t)(t + 1) * kstep;
            const char* a2 = last ? nA : cA + (size_t)(t + 2) * kstep; const char* b2 = last ? nB : cB + (size_t)(t + 2) * kstep;
            const char* a3 = a2 + kstep; const char* b3 = b2 + kstep;
            if (last && has_next) S.a_ready(nxt);
            if constexpr (SP2) {
            PG8_LDB(B0, 0, 0); PG8_LDB(B1, 0, 1); PG8_SCHED; PG8_LDA(At, 0, 0); PG8_STAGE(PG8_SA(1, 1), a1 + hstep, voffA);
            PG8_WAIT_V(8); PG8_WAIT_L(0); PG8_BAR; PG8_MMA(0, 0, At, B0); PG8_MMA(0, 1, At, B1); PG8_BAR; PG8_SCHED;
            PG8_LDA(At, 0, 1); PG8_STAGE(PG8_SB(0, 0), b2, voffB); PG8_STAGE(PG8_SB(0, 1), b2 + hstep, voffB); PG8_STAGE(PG8_SA(0, 0), a2, voffA);
            PG8_WAIT_V(8); PG8_WAIT_L(0); PG8_BAR; PG8_MMA(1, 0, At, B0); PG8_MMA(1, 1, At, B1); PG8_BAR; PG8_SCHED;
            PG8_LDB(B0, 1, 0); PG8_LDB(B1, 1, 1); PG8_SCHED; PG8_LDA(At, 1, 0); PG8_STAGE(PG8_SA(0, 1), a2 + hstep, voffA);
            PG8_WAIT_V(8); PG8_WAIT_L(0); PG8_BAR; PG8_MMA(0, 0, At, B0); PG8_MMA(0, 1, At, B1); PG8_BAR; PG8_SCHED;
            PG8_LDA(At, 1, 1); PG8_STAGE(PG8_SB(1, 0), b3, voffB); PG8_STAGE(PG8_SB(1, 1), b3 + hstep, voffB); PG8_STAGE(PG8_SA(1, 0), a3, voffA);
            PG8_WAIT_V(8); PG8_WAIT_L(0); PG8_BAR; PG8_MMA(1, 0, At, B0); PG8_MMA(1, 1, At, B1); PG8_BAR; PG8_SCHED;
            } else {
            PG8_LDB(B0, 0, 0); PG8_SCHED; PG8_LDA(At, 0, 0); PG8_STAGE(PG8_SA(1, 1), a1 + hstep, voffA);
            PG8_WAIT_L(8); PG8_BAR; PG8_WAIT_L(0); PG8_MMA(0, 0, At, B0); PG8_BAR; PG8_SCHED;
            PG8_LDB(B1, 0, 1); PG8_STAGE(PG8_SB(0, 0), b2, voffB);
            PG8_BAR; PG8_WAIT_L(0); PG8_MMA(0, 1, At, B1); PG8_BAR;
            PG8_LDA(At, 0, 1); PG8_STAGE(PG8_SA(0, 0), a2, voffA);
            PG8_BAR; PG8_WAIT_L(0); PG8_MMA(1, 0, At, B0); PG8_BAR; PG8_SCHED;
            PG8_STAGE(PG8_SB(0, 1), b2 + hstep, voffB);
            PG8_WAIT_V(6); PG8_BAR; PG8_MMA(1, 1, At, B1); PG8_BAR;
            PG8_LDB(B0, 1, 0); PG8_SCHED; PG8_LDA(At, 1, 0); PG8_STAGE(PG8_SA(0, 1), a2 + hstep, voffA);
            PG8_WAIT_L(8); PG8_BAR; PG8_WAIT_L(0); PG8_MMA(0, 0, At, B0); PG8_BAR; PG8_SCHED;
            PG8_LDB(B1, 1, 1); PG8_STAGE(PG8_SB(1, 0), b3, voffB);
            PG8_BAR; PG8_WAIT_L(0); PG8_MMA(0, 1, At, B1); PG8_BAR;
            PG8_LDA(At, 1, 1); PG8_STAGE(PG8_SA(1, 0), a3, voffA);
            PG8_BAR; PG8_WAIT_L(0); PG8_MMA(1, 0, At, B0); PG8_BAR; PG8_SCHED;
            PG8_STAGE(PG8_SB(1, 1), b3 + hstep, voffB);
            PG8_WAIT_V(6); PG8_BAR; PG8_MMA(1, 1, At, B1); PG8_BAR;
            }
        }
        if constexpr (ALIGN_EPI) { if (wr == 0) PG8_BAR; }
        if constexpr (!Epi::AFTER_DRAIN) { E(acc, cur, wr, wc, fr, fq); S.done(cur); }
        if (!has_next) break;
#pragma unroll
        for (int a = 0; a < 2; ++a)
#pragma unroll
            for (int b = 0; b < 2; ++b)
#pragma unroll
                for (int m = 0; m < 4; ++m)
#pragma unroll
                    for (int n = 0; n < 2; ++n) acc[a][b][m][n] = (f32x4){0.f, 0.f, 0.f, 0.f};
        cur = nxt; cA = nA; cB = nB; ++ui;
        if constexpr (ALIGN_EPI) { if (wr == 1) PG8_BAR; }
    }
    PG8_WAIT_V(0);
    if constexpr (!ALIGN_EPI) { if (wr == 0) PG8_BAR; }
    PG8_BAR;
    if constexpr (Epi::AFTER_DRAIN) { E.fused(acc, cur, wr, wc, fr, fq, lds, wid, lane); S.done(cur); }
#undef PG8_SA
#undef PG8_SB
#undef PG8_STAGE
#undef PG8_LDA
#undef PG8_LDB
#undef PG8_MMA
#undef PG8_WAIT_V
#undef PG8_WAIT_L
#undef PG8_BAR
#undef PG8_SCHED
}
}

#define LAS __attribute__((address_space(3)))
typedef unsigned short bf16;
typedef unsigned v4u __attribute__((ext_vector_type(4)));
typedef unsigned v2u __attribute__((ext_vector_type(2)));
typedef float f32x4 __attribute__((ext_vector_type(4)));
typedef float f32x2 __attribute__((ext_vector_type(2)));
typedef float f32x16 __attribute__((ext_vector_type(16)));
typedef short bf16x8 __attribute__((ext_vector_type(8)));
typedef short s16x4 __attribute__((ext_vector_type(4)));
typedef __bf16 bf16x2_t __attribute__((ext_vector_type(2)));
__device__ __forceinline__ unsigned pk2(float lo, float hi) { f32x2 v = {lo, hi}; bf16x2_t b = __builtin_convertvector(v, bf16x2_t); return __builtin_bit_cast(unsigned, b); }
__device__ __forceinline__ float bf2f(unsigned short h) { return __uint_as_float((unsigned)h << 16); }
__device__ __forceinline__ float wave_sum(float v) {
#pragma unroll
    for (int o = 1; o < 64; o <<= 1) v += __shfl_xor(v, o);
    return v;
}
__device__ __forceinline__ float sigmoidf_(float x) { return __builtin_amdgcn_rcpf(1.0f + __builtin_amdgcn_exp2f(-1.4426950408889634f * x)); }

struct Args { const float* in[20]; float* out; unsigned char* ws; };


#define GAS __attribute__((address_space(1)))
#define XB_TMO      128
#define XB_XCNT(j)  (256  + 64 * (j))
#define XB_XSUB(j)  (1280 + 64 * (j))
#define XB_XGEN(j)  (2304 + 64 * (j))
#define XB_TOP      3328
#define XB_TOPGEN   3392
#define XCD_BAR_WORDS 3456
#define XB_SPIN_CAP (1u << 18)

__device__ __forceinline__ unsigned xb_ld(unsigned* p)              { return __hip_atomic_load(p, __ATOMIC_RELAXED, __HIP_MEMORY_SCOPE_AGENT); }
__device__ __forceinline__ unsigned xb_add(unsigned* p, unsigned v) { return __hip_atomic_fetch_add(p, v, __ATOMIC_RELAXED, __HIP_MEMORY_SCOPE_AGENT); }
__device__ __forceinline__ unsigned xb_xcc_id() { return (unsigned)__builtin_amdgcn_s_getreg((3 << 11) | 20) & 0xFu; }
#define XB_SPIN(cond, bar) do { unsigned _sp = 0; while (cond) { __builtin_amdgcn_s_sleep(1); \
    if ((++_sp & 255u) == 0u) { if (xb_ld(&(bar)[XB_TMO])) break; if (_sp > XB_SPIN_CAP) { atomicAdd(&(bar)[XB_TMO], 1u); break; } } } } while (0)

struct XcdBarrier {
    unsigned* bar; unsigned x;
    volatile LAS unsigned* st;
};

__device__ __forceinline__ XcdBarrier xcd_barrier_post(unsigned* bar, volatile LAS unsigned* st) {
    XcdBarrier b; b.bar = bar; b.x = xb_xcc_id(); b.st = st;
    if (threadIdx.x == 0) (void)xb_add(&bar[XB_XCNT(b.x)], 1u);
    return b;
}
__device__ __forceinline__ void xcd_barrier_complete(unsigned* bar, unsigned x, unsigned& nloc, unsigned& nx) {
    const unsigned G = gridDim.x * gridDim.y * gridDim.z;
    unsigned sum, cnt, mine, sp = 0u;
    for (;;) {
        sum = 0u; cnt = 0u; mine = 0u;
#pragma unroll
        for (unsigned j = 0; j < 16; ++j) { const unsigned c = xb_ld(&bar[XB_XCNT(j)]); sum += c; cnt += (c > 0u) ? 1u : 0u; mine = (j == x) ? c : mine; }
        if (sum == G) break;
        __builtin_amdgcn_s_sleep(1);
        if ((++sp & 255u) == 0u) { if (xb_ld(&bar[XB_TMO])) break; if (sp > XB_SPIN_CAP) { atomicAdd(&bar[XB_TMO], 1u); break; } }
    }
    nloc = mine > 0u ? mine : 1u; nx = cnt > 0u ? cnt : 1u;
}

__device__ __forceinline__ void xcd_barrier(const XcdBarrier& b) {
    asm volatile("s_waitcnt vmcnt(0)" ::: "memory");
    __syncthreads();
    if (threadIdx.x == 0) {
        unsigned* bar = b.bar;
        __builtin_amdgcn_s_waitcnt(0);
        unsigned nloc = b.st[0], nx = b.st[1];
        if (nloc == 0u) { xcd_barrier_complete(bar, b.x, nloc, nx); b.st[0] = nloc; b.st[1] = nx; }
        const unsigned old = xb_add(&bar[XB_XSUB(b.x)], 1u);
        const unsigned gen = old / nloc;
        if (old + 1u == (gen + 1u) * nloc) {
            __builtin_amdgcn_fence(__ATOMIC_RELEASE, "agent");
            asm volatile("s_waitcnt vmcnt(0)" ::: "memory");
            const unsigned og = xb_add(&bar[XB_TOP], 1u);
            const unsigned tg = og / nx;
            if (og + 1u == (tg + 1u) * nx) xb_add(&bar[XB_TOPGEN], 1u);
            else XB_SPIN(xb_ld(&bar[XB_TOPGEN]) == tg, bar);
            __builtin_amdgcn_fence(__ATOMIC_ACQUIRE, "agent");
            xb_add(&bar[XB_XGEN(b.x)], 1u);
            asm volatile("s_waitcnt vmcnt(0)" ::: "memory");
        } else {
            XB_SPIN(xb_ld(&bar[XB_XGEN(b.x)]) == gen, bar);
            __builtin_amdgcn_fence(__ATOMIC_ACQUIRE, "agent");
            asm volatile("s_waitcnt vmcnt(0)" ::: "memory");
        }
    }
    __syncthreads();
}

__device__ __forceinline__ void p0_transpose_item(const float* W, int K, int N, bf16* WT, LAS float* scr, int item, int lane) {
    const int nblk = N / 32, kb = item / nblk, nb = item % nblk, k0 = 64 * kb, n0 = 32 * nb;
    float wv_[32];
#pragma unroll
    for (int i = 0; i < 32; ++i) wv_[i] = W[(size_t)(k0 + 2 * i + (lane >> 5)) * N + n0 + (lane & 31)];
#pragma unroll
    for (int i = 0; i < 32; ++i) scr[(2 * i + (lane >> 5)) * 33 + (lane & 31)] = wv_[i];
    asm volatile("s_waitcnt lgkmcnt(0)" ::: "memory");
    const int c = lane & 7;
#pragma unroll
    for (int j = 0; j < 4; ++j) { const int n = (lane >> 3) + 8 * j; const LAS float* s = scr + (8 * c) * 33 + n;
        v4u o; o.x = pk2(s[0 * 33], s[1 * 33]); o.y = pk2(s[2 * 33], s[3 * 33]); o.z = pk2(s[4 * 33], s[5 * 33]); o.w = pk2(s[6 * 33], s[7 * 33]);
        *(v4u*)(WT + (size_t)(n0 + n) * K + k0 + 8 * c) = o; }
    asm volatile("s_waitcnt lgkmcnt(0)" ::: "memory");
}

__device__ __forceinline__ void p0_prologue(const Args& a, LAS unsigned char* lds, int tid, int lane, int wave, int G, int bid) {
    unsigned char* ws = a.ws;
    {
        LAS float* sc = (LAS float*)lds;
        LAS float* red = (LAS float*)(lds + 16384);
        const float* c = a.in[1];
        for (int i = tid; i < 4096; i += NTHR) { const float v = c[i]; sc[i] = v / (1.0f + __expf(-v)); }
        __syncthreads();
        for (int item = bid; item < 192; item += G) {
            const int s = item / 48, n0 = (item % 48) * 64;
            const float* w = a.in[2] + (size_t)s * 1024 * 3072 + n0 + lane;
            float acc0 = 0.f, acc1 = 0.f, acc2 = 0.f, acc3 = 0.f;
            const int kbeg = wave * 128;
#pragma unroll 16
            for (int k = 0; k < 128; ++k) { const float wv = w[(size_t)(kbeg + k) * 3072];
                acc0 += wv * sc[kbeg + k]; acc1 += wv * sc[1024 + kbeg + k]; acc2 += wv * sc[2048 + kbeg + k]; acc3 += wv * sc[3072 + kbeg + k]; }
            red[(wave * 4 + 0) * 64 + lane] = acc0; red[(wave * 4 + 1) * 64 + lane] = acc1; red[(wave * 4 + 2) * 64 + lane] = acc2; red[(wave * 4 + 3) * 64 + lane] = acc3;
            __syncthreads();
            if (tid < 256) { const int b = tid >> 6, l = tid & 63; float t = a.in[3][s * 3072 + n0 + l];
#pragma unroll
                for (int wv = 0; wv < 8; ++wv) t += red[(wv * 4 + b) * 64 + l];
                ((float*)(ws + WS_MOD))[(s * 4 + b) * 3072 + n0 + l] = t; }
            __syncthreads();
        }
    }
    __syncthreads();
    {
        const float invf[16] = {1.000000000e+00f, 4.403665960e-01f, 1.939227432e-01f, 8.539710194e-02f, 3.760603070e-02f, 1.656043902e-02f, 7.292664610e-03f, 3.211445874e-03f,
                                1.414213562e-03f, 6.227723788e-04f, 2.742481884e-04f, 1.207697351e-04f, 5.318296098e-05f, 2.341999971e-05f, 1.031338616e-05f, 4.541670478e-06f};
        float* cs = (float*)(ws + WS_CS);
        for (int idx = bid * NTHR + tid; idx < 8192 * 16; idx += G * NTHR) {
            const int pos = idx >> 4, i = idx & 15;
            float f = invf[0];
#pragma unroll
            for (int q = 1; q < 16; ++q) f = (i == q) ? invf[q] : f;
            const float ang = (float)pos * f;
            double t = (double)ang * 0.15915494309189535; t -= __builtin_rint(t);
            const float r = (float)t;
            cs[pos * 32 + i] = __builtin_amdgcn_cosf(r); cs[pos * 32 + 16 + i] = __builtin_amdgcn_sinf(r);
        }
    }
    { float* sp8 = (float*)(ws + WS_SP8); for (int idx = bid * NTHR + tid; idx < 2 * DRNN; idx += G * NTHR) sp8[idx] = 8.0f * log1pf(__expf(-a.in[16][idx])); }
    {
        bf16* wg = (bf16*)(ws + WS_WG);
        for (int idx = bid * NTHR + tid; idx < 2 * 16 * 2 * 96 * 96; idx += G * NTHR) {
            const int i = idx % 96, j = (idx / 96) % 96, gate = (idx / 9216) & 1, n = (idx / 18432) & 15, dir = idx / 294912;
            const float* src = gate ? a.in[14] : a.in[12];
            const float v = src[((size_t)(dir * 16 + n) * 96 + i) * 96 + j];
            wg[idx] = (bf16)(pk2(v, 0.f) & 0xffffu);
        }
    }
    {
        LAS float* scr = (LAS float*)(lds + wave * 16384);
        const int gw = bid * NWAVES + wave, NGW = G * NWAVES;
        constexpr int I_QKV = 16 * 48, I_O = 16 * 32, I_RIN = 16 * 96, I_ROUT = 24 * 32, I_1 = 16 * 128, I_2 = 64 * 32;
        constexpr int NITEMS = I_QKV + I_O + I_RIN + I_ROUT + 2 * I_1 + 2 * I_2;
        for (int it = gw; it < NITEMS; it += NGW) {
            int r = it;
            if (r < I_QKV) { p0_transpose_item(a.in[6], 1024, 1536, (bf16*)(ws + WS_WQKV), scr, r, lane); continue; } r -= I_QKV;
            if (r < I_O) { p0_transpose_item(a.in[7], 1024, 1024, (bf16*)(ws + WS_WO), scr, r, lane); continue; } r -= I_O;
            if (r < I_RIN) { p0_transpose_item(a.in[9], 1024, 3072, (bf16*)(ws + WS_WRIN), scr, r, lane); continue; } r -= I_RIN;
            if (r < I_ROUT) { p0_transpose_item(a.in[17], 1536, 1024, (bf16*)(ws + WS_WROUT), scr, r, lane); continue; } r -= I_ROUT;
            if (r < I_1) { p0_transpose_item(a.in[18], 1024, 4096, (bf16*)(ws + WS_W1), scr, r, lane); continue; } r -= I_1;
            if (r < I_1) { p0_transpose_item(a.in[18] + (size_t)1024 * 4096, 1024, 4096, (bf16*)(ws + WS_W1) + (size_t)4096 * 1024, scr, r, lane); continue; } r -= I_1;
            if (r < I_2) { p0_transpose_item(a.in[19], 4096, 1024, (bf16*)(ws + WS_W2), scr, r, lane); continue; } r -= I_2;
            p0_transpose_item(a.in[19] + (size_t)4096 * 1024, 4096, 1024, (bf16*)(ws + WS_W2) + (size_t)1024 * 4096, scr, r, lane);
        }
    }
}

template <bool DO_LN, bool IN_F32, bool OUT_F32> __device__ __forceinline__ void ln_mod_phase(const void* xin, void* xout, bf16* hout, const float* lng, const float* lnb, const float* mod, float* stat, int lane, int wave, int G, int bid) {
    const int gw = bid * NWAVES + wave, NGW = G * NWAVES;
    for (int row = gw; row < M; row += NGW) {
        f32x4 v[4];
#pragma unroll
        for (int j = 0; j < 2; ++j) { const size_t e = (size_t)row * DM + 512 * j + 8 * lane;
            if (IN_F32) { v[2 * j] = *(const f32x4*)((const float*)xin + e); v[2 * j + 1] = *(const f32x4*)((const float*)xin + e + 4); }
            else { const v4u w = *(const v4u*)((const bf16*)xin + e);
                v[2 * j] = (f32x4){__uint_as_float(w.x << 16), __uint_as_float(w.x & 0xffff0000u), __uint_as_float(w.y << 16), __uint_as_float(w.y & 0xffff0000u)};
                v[2 * j + 1] = (f32x4){__uint_as_float(w.z << 16), __uint_as_float(w.z & 0xffff0000u), __uint_as_float(w.w << 16), __uint_as_float(w.w & 0xffff0000u)}; } }
        if (DO_LN) {
            float s = 0.f;
#pragma unroll
            for (int j = 0; j < 4; ++j) s += (v[j].x + v[j].y) + (v[j].z + v[j].w);
            const float mean = wave_sum(s) * (1.f / DM); float s2 = 0.f;
#pragma unroll
            for (int j = 0; j < 4; ++j) { v[j] = v[j] - mean; s2 += (v[j].x * v[j].x + v[j].y * v[j].y) + (v[j].z * v[j].z + v[j].w * v[j].w); }
            const float rstd = __builtin_amdgcn_rsqf(wave_sum(s2) * (1.f / DM) + LN_EPS);
            if (stat && lane == 0) { stat[2 * row] = mean; stat[2 * row + 1] = rstd; }
#pragma unroll
            for (int j = 0; j < 4; ++j) { const int c = 512 * (j >> 1) + 8 * lane + 4 * (j & 1); const f32x4 g = *(const f32x4*)(lng + c), bb = *(const f32x4*)(lnb + c); v[j] = v[j] * rstd * g + bb; }
        }
        if (xout) {
#pragma unroll
            for (int j = 0; j < 2; ++j) { const size_t e = (size_t)row * DM + 512 * j + 8 * lane;
                if (OUT_F32) { *(f32x4*)((float*)xout + e) = v[2 * j]; *(f32x4*)((float*)xout + e + 4) = v[2 * j + 1]; }
                else { v4u w; w.x = pk2(v[2 * j].x, v[2 * j].y); w.y = pk2(v[2 * j].z, v[2 * j].w); w.z = pk2(v[2 * j + 1].x, v[2 * j + 1].y); w.w = pk2(v[2 * j + 1].z, v[2 * j + 1].w); *(v4u*)((bf16*)xout + e) = w; } } }
        if (hout) { const int b = row >> 13; const float* sh = mod + b * 3072; const float* scl = mod + b * 3072 + 1024;
#pragma unroll
            for (int j = 0; j < 2; ++j) { const int c = 512 * j + 8 * lane;
                const f32x4 h0 = v[2 * j] * (*(const f32x4*)(scl + c) + 1.0f) + *(const f32x4*)(sh + c), h1 = v[2 * j + 1] * (*(const f32x4*)(scl + c + 4) + 1.0f) + *(const f32x4*)(sh + c + 4);
                v4u w; w.x = pk2(h0.x, h0.y); w.y = pk2(h0.z, h0.w); w.z = pk2(h1.x, h1.y); w.w = pk2(h1.z, h1.w); *(v4u*)(hout + (size_t)row * DM + c) = w; } }
    }
}

__device__ __forceinline__ unsigned off_b(unsigned row, unsigned ch) { return 256u * row + 16u * (ch ^ (((row & 3) << 2) | ((row >> 2) & 3))); }
__device__ __forceinline__ s16x4 vtr(const LAS unsigned char* p) { typedef short v4i16_t __attribute__((ext_vector_type(4))); return __builtin_bit_cast(s16x4, __builtin_amdgcn_ds_read_tr16_b64_v4i16((LAS v4i16_t*)p)); }
__device__ __forceinline__ void attn_phase(LAS unsigned char* lds, const bf16* Q, const bf16* K, const bf16* V, bf16* O, const float* sinks, int tid, int lane, int wave, int G, int bid) {
    const int r32 = lane & 31, h = lane >> 5;
    const int blk = (lane >> 4) & 1, q4 = (lane & 15) >> 2, p4 = lane & 3;
    unsigned kofs[8], vofs[4][2];
    { const unsigned swzk = ((r32 & 3) << 2) | ((r32 >> 2) & 3);
#pragma unroll
      for (int s_ = 0; s_ < 8; ++s_) kofs[s_] = 256u * r32 + 16u * ((2u * s_ + h) ^ swzk);
#pragma unroll
      for (int c = 0; c < 4; ++c)
#pragma unroll
          for (int t_ = 0; t_ < 2; ++t_) { const unsigned xr = ((unsigned)q4 << 2) | ((h + 2u * t_) & 3u); vofs[c][t_] = 256u * (4u * h + q4) + 16u * ((4u * c + 2u * blk + (p4 >> 1)) ^ xr) + 8u * (p4 & 1); } }
    for (int unit = bid; unit < 1024; unit += G) {
        const int u = unit & 127, kvh = (unit >> 7) & 1, b = unit >> 8;
        const int head = kvh * 4 + (wave >> 1); const int qpos = 64 * u + 32 * (wave & 1) + r32;
        const size_t tokbase = (size_t)b * SEQ;
        bf16x8 qf[8];
        { const bf16* qp = Q + (tokbase + qpos) * 1024 + head * 128 + 8 * h;
#pragma unroll
          for (int s = 0; s < 8; ++s) qf[s] = *(const bf16x8*)(qp + 16 * s); }
        float mrun = sinks[head] * LOG2E; float lrun = (h == 0) ? 1.f : 0.f;
        f32x16 o[4];
#pragma unroll
        for (int c = 0; c < 4; ++c)
#pragma unroll
            for (int i = 0; i < 16; ++i) o[c][i] = 0.f;
        const int c_lo = (u < 2) ? 2 - u : 0, c_hi = (u > 125) ? 129 - u : 4;
        const int lrow0 = tid >> 4, lch = tid & 15;
        v4u kreg[2], vreg[2];
        __syncthreads();
        { const int kc = u - 2 + c_lo;
#pragma unroll
          for (int i = 0; i < 2; ++i) { const size_t g = (tokbase + 64 * kc + lrow0 + 32 * i) * 256 + kvh * 128 + lch * 8; kreg[i] = *(const v4u*)(K + g); vreg[i] = *(const v4u*)(V + g); }
#pragma unroll
          for (int i = 0; i < 2; ++i) { const unsigned ob = off_b(lrow0 + 32 * i, lch); *(LAS v4u*)(lds + ob) = kreg[i]; *(LAS v4u*)(lds + 32768 + ob) = vreg[i]; } }
        __syncthreads();
        for (int ci = c_lo; ci <= c_hi; ++ci) {
            const int buf = (ci - c_lo) & 1; const int kc = u - 2 + ci;
            const bool more = ci < c_hi;
            if (more) {
#pragma unroll
                for (int i = 0; i < 2; ++i) { const size_t g = (tokbase + 64 * (kc + 1) + lrow0 + 32 * i) * 256 + kvh * 128 + lch * 8; kreg[i] = *(const v4u*)(K + g); vreg[i] = *(const v4u*)(V + g); } }
            const LAS unsigned char* Kb = lds + buf * 16384; const LAS unsigned char* Vb = lds + 32768 + buf * 16384;
            f32x16 sa[2];
#pragma unroll
            for (int kt = 0; kt < 2; ++kt) {
#pragma unroll
                for (int i = 0; i < 16; ++i) sa[kt][i] = 0.f;
#pragma unroll
                for (int s = 0; s < 8; ++s) { const bf16x8 kf = *(const LAS bf16x8*)(Kb + kofs[s] + 8192 * kt); sa[kt] = __builtin_amdgcn_mfma_f32_32x32x16_bf16(kf, qf[s], sa[kt], 0, 0, 0); }
            }
            float mx = -INFINITY;
            if (ci == 0 || ci == 4) {
#pragma unroll
                for (int kt = 0; kt < 2; ++kt)
#pragma unroll
                    for (int i = 0; i < 16; ++i) { const int kp = 64 * kc + 32 * kt + (i & 3) + 8 * (i >> 2) + 4 * h; const int d = qpos - kp; if (d > 128 || d < -128) sa[kt][i] = -INFINITY; }
            }
#pragma unroll
            for (int kt = 0; kt < 2; ++kt)
#pragma unroll
                for (int i = 0; i < 16; ++i) mx = fmaxf(mx, sa[kt][i]);
            mx = fmaxf(mx, __shfl_xor(mx, 32));
            const float mnew = fmaxf(mrun, mx); const float alpha = __builtin_amdgcn_exp2f(mrun - mnew); mrun = mnew;
            float ls = 0.f;
#pragma unroll
            for (int kt = 0; kt < 2; ++kt) {
                sa[kt] = sa[kt] - mnew;
#pragma unroll
                for (int i = 0; i < 16; ++i) sa[kt][i] = __builtin_amdgcn_exp2f(sa[kt][i]);
                f32x4 q4s = (f32x4){sa[kt][0], sa[kt][1], sa[kt][2], sa[kt][3]} + (f32x4){sa[kt][4], sa[kt][5], sa[kt][6], sa[kt][7]} + (f32x4){sa[kt][8], sa[kt][9], sa[kt][10], sa[kt][11]} + (f32x4){sa[kt][12], sa[kt][13], sa[kt][14], sa[kt][15]};
                ls += (q4s.x + q4s.y) + (q4s.z + q4s.w);
            }
            lrun = lrun * alpha + ls;
            if (__any(alpha != 1.0f)) {
#pragma unroll
                for (int c = 0; c < 4; ++c) o[c] = o[c] * alpha;
            }
#pragma unroll
            for (int kt = 0; kt < 2; ++kt)
#pragma unroll
                for (int s2 = 0; s2 < 2; ++s2) {
                    v4u pw; pw.x = pk2(sa[kt][8 * s2 + 0], sa[kt][8 * s2 + 1]); pw.y = pk2(sa[kt][8 * s2 + 2], sa[kt][8 * s2 + 3]); pw.z = pk2(sa[kt][8 * s2 + 4], sa[kt][8 * s2 + 5]); pw.w = pk2(sa[kt][8 * s2 + 6], sa[kt][8 * s2 + 7]);
                    const bf16x8 pf = __builtin_bit_cast(bf16x8, pw);
#pragma unroll
                    for (int c = 0; c < 4; ++c) {
                        const s16x4 lo = vtr(Vb + vofs[c][0] + (8192 * kt + 4096 * s2));
                        const s16x4 hi = vtr(Vb + vofs[c][1] + (8192 * kt + 4096 * s2 + 2048));
                        const bf16x8 vf = __builtin_shufflevector(lo, hi, 0, 1, 2, 3, 4, 5, 6, 7);
                        o[c] = __builtin_amdgcn_mfma_f32_32x32x16_bf16(vf, pf, o[c], 0, 0, 0);
                    }
                }
            if (more) {
#pragma unroll
                for (int i = 0; i < 2; ++i) { const unsigned ob = off_b(lrow0 + 32 * i, lch); *(LAS v4u*)(lds + (buf ^ 1) * 16384 + ob) = kreg[i]; *(LAS v4u*)(lds + 32768 + (buf ^ 1) * 16384 + ob) = vreg[i]; } }
            __syncthreads();
        }
        lrun += __shfl_xor(lrun, 32);
        const float rl = 1.0f / lrun;
        bf16* op = O + (tokbase + qpos) * 1024 + head * 128 + 4 * h;
#pragma unroll
        for (int c = 0; c < 4; ++c)
#pragma unroll
            for (int g = 0; g < 4; ++g) { v2u w; w.x = pk2(o[c][4 * g] * rl, o[c][4 * g + 1] * rl); w.y = pk2(o[c][4 * g + 2] * rl, o[c][4 * g + 3] * rl); *(v2u*)(op + 32 * c + 8 * g) = w; }
    }
}

constexpr int RL_XCB = 0, RL_XCT = 13312, RL_XRS = 27136, RL_T = 40000, RL_YO = 46144, RL_YOSZ = 26624, RL_PAR = 99392;
template <bool FINAL> __device__ __forceinline__ void rnn_phase(LAS unsigned char* lds, const bf16* XR, bf16* GG, const float* conv_w, const float* conv_b, const bf16* Wg,
        const float* b_a, const float* b_x, const float* sp8t, f32x2* agg, const float* cin, int tid, int lane, int wave, int G, int bid) {
    LAS unsigned short* XCB = (LAS unsigned short*)(lds + RL_XCB); LAS unsigned short* XCT = (LAS unsigned short*)(lds + RL_XCT); LAS unsigned short* XRS = (LAS unsigned short*)(lds + RL_XRS);
    LAS f32x2* T = (LAS f32x2*)(lds + RL_T); LAS float* YO = (LAS float*)(lds + RL_YO); LAS float* PAR = (LAS float*)(lds + RL_PAR);
    const int n = bid & 15, slot = bid >> 4, nslots = (G + 15 - n) >> 4;
    const int xr_r0 = tid / 12, xr_c0 = tid % 12, xr_r1 = (tid + 512) / 12, xr_c1 = (tid + 512) % 12; const bool xr_v1 = (tid + 512) < 67 * 12;
    const int cc = tid % 96, ctq = tid / 96; const int ccg = 96 * n + cc;
    float cw0 = 0.f, cw1 = 0.f, cw2 = 0.f, cw3 = 0.f, cbb = 0.f;
    if (tid < 384) { cw0 = conv_w[ccg]; cw1 = conv_w[DRNN + ccg]; cw2 = conv_w[2 * DRNN + ccg]; cw3 = conv_w[3 * DRNN + ccg]; cbb = conv_b[ccg]; }
    const int rtp = wave & 1, dir = wave >> 2, cth = (wave >> 1) & 1, l15 = lane & 15, l4 = lane >> 4; const bool fwd = (dir == 0);
    const bf16* wlane = Wg + ((size_t)((dir * 16 + n) * 2) * 96 + l15) * 96 + 8 * l4;
    __syncthreads();
    for (int i = tid; i < 576; i += NTHR) { const int d_ = i / 288, w_ = (i / 96) % 3, c_ = i % 96; const float* src = (w_ == 0) ? b_a : (w_ == 1) ? b_x : sp8t; PAR[i] = src[d_ * DRNN + 96 * n + c_]; }
    v4u xq0 = {0u, 0u, 0u, 0u}, xq1 = {0u, 0u, 0u, 0u};
#define RNN_LOAD_XR(pair) do { const int b_ = (pair) >> 7, ch_ = (pair) & 127; const size_t tb_ = (size_t)b_ * SEQ; const int tk0 = 64 * ch_ - 2 + xr_r0, tk1 = 64 * ch_ - 2 + xr_r1; \
        xq0 = (v4u){0u, 0u, 0u, 0u}; xq1 = xq0; \
        if (tk0 >= 0 && tk0 < SEQ) xq0 = *(const v4u*)(XR + (tb_ + tk0) * DRNN + 96 * n + 8 * xr_c0); \
        if (xr_v1 && tk1 >= 0 && tk1 < SEQ) xq1 = *(const v4u*)(XR + (tb_ + tk1) * DRNN + 96 * n + 8 * xr_c1); } while (0)
    bf16x8 wa[3][3], wx[3][3];
#pragma unroll
    for (int i = 0; i < 3; ++i)
#pragma unroll
        for (int ks = 0; ks < 3; ++ks) { wa[i][ks] = *(const bf16x8*)(wlane + (size_t)(16 * (3 * cth + i)) * 96 + 32 * ks); wx[i][ks] = *(const bf16x8*)(wlane + (size_t)(96 + 16 * (3 * cth + i)) * 96 + 32 * ks); }
    int pair = slot;
    if (pair < 512) RNN_LOAD_XR(pair);
    for (; pair < 512; pair += nslots) {
        const int b = pair >> 7, chunk = pair & 127; const size_t tokbase = (size_t)b * SEQ; const int t0 = 64 * chunk;
        *(LAS v4u*)(XRS + xr_r0 * 96 + xr_c0 * 8) = xq0; if (xr_v1) *(LAS v4u*)(XRS + xr_r1 * 96 + xr_c1 * 8) = xq1;
        __syncthreads();
        if (pair + nslots < 512) RNN_LOAD_XR(pair + nslots);
        v4u gq0 = {0u, 0u, 0u, 0u}, gq1 = gq0; float cinr[3] = {0.f, 0.f, 0.f};
        if (FINAL) {
            gq0 = *(const v4u*)(GG + (tokbase + t0 + tid / 12) * DRNN + 96 * n + 8 * (tid % 12));
            if (tid < 256) gq1 = *(const v4u*)(GG + (tokbase + t0 + (tid + 512) / 12) * DRNN + 96 * n + 8 * ((tid + 512) % 12));
#pragma unroll
            for (int i = 0; i < 3; ++i) cinr[i] = cin[((size_t)(b * 128 + chunk) * 2 + dir) * DRNN + 96 * n + 16 * (3 * cth + i) + l15];
        }
        if (tid < 384) {
            float x0 = bf2f(XRS[(16 * ctq + 0) * 96 + cc]), x1 = bf2f(XRS[(16 * ctq + 1) * 96 + cc]), x2 = bf2f(XRS[(16 * ctq + 2) * 96 + cc]);
#pragma unroll
            for (int k = 0; k < 16; ++k) { const int t = 16 * ctq + k; const float x3 = bf2f(XRS[(t + 3) * 96 + cc]);
                const float v = cbb + x0 * cw0 + x1 * cw1 + x2 * cw2 + x3 * cw3;
                const unsigned short vb = (unsigned short)(pk2(v, 0.f) & 0xffffu);
                XCB[t * 104 + cc] = vb; XCT[cc * 72 + t] = vb;
                x0 = x1; x1 = x2; x2 = x3; } }
        __syncthreads();
        float ar[6][4], ur[6][4], Ae[6], He[6];
#pragma unroll
        for (int tt = 0; tt < 2; ++tt) {
            const int rt = 2 * rtp + tt;
            bf16x8 xa[3];
#pragma unroll
            for (int ks = 0; ks < 3; ++ks) xa[ks] = *(const LAS bf16x8*)(XCB + (16 * rt + l15) * 104 + 32 * ks + 8 * l4);
#pragma unroll
            for (int i = 0; i < 3; ++i) {
                const int it = tt * 3 + i;
                f32x4 ga = {0.f, 0.f, 0.f, 0.f}, gx = {0.f, 0.f, 0.f, 0.f};
#pragma unroll
                for (int ks = 0; ks < 3; ++ks) {
                    ga = __builtin_amdgcn_mfma_f32_16x16x32_bf16(xa[ks], wa[i][ks], ga, 0, 0, 0);
                    gx = __builtin_amdgcn_mfma_f32_16x16x32_bf16(xa[ks], wx[i][ks], gx, 0, 0, 0);
                }
                const int c = 16 * (3 * cth + i) + l15;
                const float ba = PAR[dir * 288 + c], bx = PAR[dir * 288 + 96 + c], lm = PAR[dir * 288 + 192 + c];
                const v2u xcw = *(const LAS v2u*)(XCT + c * 72 + 16 * rt + 4 * l4);
                const float xc[4] = {__uint_as_float(xcw.x << 16), __uint_as_float(xcw.x & 0xffff0000u), __uint_as_float(xcw.y << 16), __uint_as_float(xcw.y & 0xffff0000u)};
#pragma unroll
                for (int p2 = 0; p2 < 2; ++p2) {
                    const f32x2 za = (f32x2){ga[2 * p2], ga[2 * p2 + 1]} + ba, zx = (f32x2){gx[2 * p2], gx[2 * p2 + 1]} + bx;
                    const f32x2 ta = za * (-1.4426950408889634f), tx = zx * (-1.4426950408889634f);
                    const f32x2 da = (f32x2){__builtin_amdgcn_exp2f(ta.x), __builtin_amdgcn_exp2f(ta.y)} + 1.0f, dx = (f32x2){__builtin_amdgcn_exp2f(tx.x), __builtin_amdgcn_exp2f(tx.y)} + 1.0f;
                    const f32x2 ra = {__builtin_amdgcn_rcpf(da.x), __builtin_amdgcn_rcpf(da.y)}, ii = {__builtin_amdgcn_rcpf(dx.x), __builtin_amdgcn_rcpf(dx.y)};
                    const f32x2 la = ra * (-lm);
                    const f32x2 tl = la * 1.4426950408889634f;
                    const f32x2 av2 = {__builtin_amdgcn_exp2f(tl.x), __builtin_amdgcn_exp2f(tl.y)};
                    const f32x2 m2 = (1.0f - av2) * (1.0f + av2);
                    const f32x2 w2 = ii * (f32x2){xc[2 * p2], xc[2 * p2 + 1]};
                    const f32x2 uu = (f32x2){__builtin_amdgcn_sqrtf(m2.x), __builtin_amdgcn_sqrtf(m2.y)} * w2;
                    ar[it][2 * p2] = av2.x; ar[it][2 * p2 + 1] = av2.y;
                    ur[it][2 * p2] = uu.x; ur[it][2 * p2 + 1] = uu.y;
                }
                float A = 1.f, H = 0.f;
#pragma unroll
                for (int k = 0; k < 4; ++k) { const int r = fwd ? k : 3 - k; H = ar[it][r] * H + ur[it][r]; A *= ar[it][r]; }
                const int p = fwd ? l4 : 3 - l4;
#pragma unroll
                for (int d = 1; d <= 2; d <<= 1) {
                    const int src = fwd ? lane - 16 * d : lane + 16 * d;
                    const float Ap = __shfl(A, src & 63), Hp = __shfl(H, src & 63);
                    if (p >= d) { H = A * Hp + H; A = Ap * A; }
                }
                { const int src = fwd ? lane - 16 : lane + 16;
                  const float Ap = __shfl(A, src & 63), Hp = __shfl(H, src & 63);
                  Ae[it] = (p >= 1) ? Ap : 1.f; He[it] = (p >= 1) ? Hp : 0.f; }
                if (p == 3) T[(dir * 4 + rt) * 96 + c] = (f32x2){A, H};
            }
        }
        __syncthreads();
        if (!FINAL) {
            if (rtp == 0 && l4 == 0) {
#pragma unroll
                for (int i = 0; i < 3; ++i) { const int c = 16 * (3 * cth + i) + l15; float A = 1.f, H = 0.f;
#pragma unroll
                    for (int k = 0; k < 4; ++k) { const f32x2 tv = T[(dir * 4 + (fwd ? k : 3 - k)) * 96 + c]; H = tv.x * H + tv.y; A *= tv.x; }
                    agg[((size_t)(b * 128 + chunk) * 2 + dir) * DRNN + 96 * n + c] = (f32x2){A, H}; }
            }
        } else {
            LAS float* YOd = YO + dir * (RL_YOSZ / 4);
#pragma unroll
            for (int tt = 0; tt < 2; ++tt) {
                const int rt = 2 * rtp + tt;
#pragma unroll
                for (int i = 0; i < 3; ++i) { const int it = tt * 3 + i; const int c = 16 * (3 * cth + i) + l15;
                    float Hc = cinr[i];
#pragma unroll
                    for (int k = 0; k < 3; ++k) { const int tq = fwd ? k : 3 - k; const bool before = fwd ? (tq < rt) : (tq > rt); const f32x2 tv = T[(dir * 4 + tq) * 96 + c]; if (before) Hc = tv.x * Hc + tv.y; }
                    float h = Ae[it] * Hc + He[it];
#pragma unroll
                    for (int k = 0; k < 4; ++k) { const int r = fwd ? k : 3 - k; h = ar[it][r] * h + ur[it][r]; YOd[(16 * rt + 4 * l4 + r) * 104 + c] = h; }
                }
            }
            __syncthreads();
#pragma unroll
            for (int it2 = 0; it2 < 2; ++it2) { const int idx = tid + 512 * it2; if (it2 == 1 && tid >= 256) break; const int t = idx / 12, ch = idx % 12;
                const v4u gv = it2 ? gq1 : gq0;
                const f32x4 f0 = *(const LAS f32x4*)(YO + t * 104 + 8 * ch), f1 = *(const LAS f32x4*)(YO + t * 104 + 8 * ch + 4);
                const f32x4 r0 = *(const LAS f32x4*)(YO + (RL_YOSZ / 4) + t * 104 + 8 * ch), r1 = *(const LAS f32x4*)(YO + (RL_YOSZ / 4) + t * 104 + 8 * ch + 4);
                const f32x4 y0 = f0 + r0, y1 = f1 + r1;
                v4u ov;
                ov.x = pk2(y0[0] * __uint_as_float(gv.x << 16), y0[1] * __uint_as_float(gv.x & 0xffff0000u));
                ov.y = pk2(y0[2] * __uint_as_float(gv.y << 16), y0[3] * __uint_as_float(gv.y & 0xffff0000u));
                ov.z = pk2(y1[0] * __uint_as_float(gv.z << 16), y1[1] * __uint_as_float(gv.z & 0xffff0000u));
                ov.w = pk2(y1[2] * __uint_as_float(gv.w << 16), y1[3] * __uint_as_float(gv.w & 0xffff0000u));
                *(v4u*)(GG + (tokbase + t0 + t) * DRNN + 96 * n + 8 * ch) = ov; }
        }
    }
#undef RNN_LOAD_XR
}
__device__ __forceinline__ void rnn_carry_phase(const f32x2* agg, float* cin, int tid, int G, int bid) {
    for (int g = bid * NTHR + tid; g < BATCH * 2 * DRNN; g += G * NTHR) {
        const int ch = g % DRNN, dir = (g / DRNN) & 1, b = g / (2 * DRNN);
        float carry = 0.f;
#pragma unroll 8
        for (int k = 0; k < 128; ++k) { const int chunk = dir ? 127 - k : k; const size_t idx = ((size_t)(b * 128 + chunk) * 2 + dir) * DRNN + ch;
            const f32x2 av = agg[idx]; cin[idx] = carry; carry = av.x * carry + av.y; }
    }
}

__global__ void __launch_bounds__(NTHR, 2) fwd_megakernel(Args args) {
    extern __shared__ __attribute__((aligned(16))) unsigned char lds_raw[];
    LAS unsigned char* lds = (LAS unsigned char*)lds_raw;
    cg::grid_group grid = cg::this_grid();
    const int tid = threadIdx.x, lane = tid & 63, wave = __builtin_amdgcn_readfirstlane(tid >> 6);
    const int G = gridDim.x, bid = blockIdx.x;
    unsigned char* ws = args.ws;
    float* MOD = (float*)(ws + WS_MOD); bf16* XB = (bf16*)(ws + WS_XB); bf16* HB = (bf16*)(ws + WS_HB);
    bf16* Qb = (bf16*)(ws + WS_Q); bf16* Kb = (bf16*)(ws + WS_K); bf16* Vb = (bf16*)(ws + WS_V); bf16* Ob = (bf16*)(ws + WS_O);
    bf16* Hbig = (bf16*)(ws + WS_BIG); bf16* XR = (bf16*)(ws + WS_XR); bf16* GG = (bf16*)(ws + WS_GG);
    const float* ln_g = args.in[4]; const float* ln_b = args.in[5];
    using namespace pg8;

    volatile LAS unsigned* MISC = (volatile LAS unsigned*)(lds + LDS_BYTES - 64);
    if (tid < 2) MISC[tid] = 0u;
    if (bid == 0) { for (int i = tid; i < XCD_BAR_WORDS; i += NTHR) ((unsigned*)(ws + WS_BAR))[i] = 0u; }
    __syncthreads();
    p0_prologue(args, lds, tid, lane, wave, G, bid);
    grid.sync();
    (void)xcd_barrier_post((unsigned*)(ws + WS_BAR), MISC);
#define GRID_BAR() do { XcdBarrier b_; b_.bar = (unsigned*)(args.ws + WS_BAR); b_.x = xb_xcc_id(); b_.st = (volatile LAS unsigned*)(lds + LDS_BYTES - 64); xcd_barrier(b_); } while (0)
    ln_mod_phase<false, true, false>(args.in[0], nullptr, HB, nullptr, nullptr, MOD + 0 * 12288, nullptr, lane, wave, G, bid);
    GRID_BAR();
    { Gemm g{HB, (const bf16_t*)(ws + WS_WQKV), M, NQKV, DM}; StaticOrder S; S.init(M, NQKV, G, bid);
      EpiQKV E{Qb, Kb, Vb, (const float*)(ws + WS_CS), 0.08838834764831845f * LOG2E};
      gemm_phase<EpiQKV, StaticOrder, true, true>(lds, g, S, E); }
    GRID_BAR();
    attn_phase(lds, Qb, Kb, Vb, Ob, args.in[8], tid, lane, wave, G, bid);
    GRID_BAR();
    { Gemm g{Ob, (const bf16_t*)(ws + WS_WO), M, DM, DM}; StaticOrder S; S.init(M, DM, G, bid);
      EpiRes<true> E{ws, args.in[0], ln_g, ln_b, 0};
      gemm_phase<EpiRes<true>, StaticOrder, true, true>(lds, g, S, E); }
    GRID_BAR();
    ln_mod_phase<true, false, false>(XB, nullptr, HB, ln_g + 0 * 1024, ln_b + 0 * 1024, MOD + 1 * 12288, (float*)(ws + WS_STAT), lane, wave, G, bid);
    GRID_BAR();
    { Gemm g{HB, (const bf16_t*)(ws + WS_W1), M, DFF, DM}; StaticOrder S; S.init(M, DFF, G, bid);
      EpiAct<0> E{Hbig, nullptr, DFF};
      gemm_phase<EpiAct<0>, StaticOrder, true, true>(lds, g, S, E); }
    GRID_BAR();
    { Gemm g{Hbig, (const bf16_t*)(ws + WS_W2), M, DM, DFF}; StaticOrder S; S.init(M, DM, G, bid);
      EpiRes<false> E{ws, nullptr, ln_g, ln_b, 1};
      gemm_phase<EpiRes<false>, StaticOrder, true, true>(lds, g, S, E); }
    GRID_BAR();
    ln_mod_phase<true, false, false>(XB, nullptr, HB, ln_g + 1 * 1024, ln_b + 1 * 1024, MOD + 2 * 12288, (float*)(ws + WS_STAT), lane, wave, G, bid);
    GRID_BAR();
    { Gemm g{HB, (const bf16_t*)(ws + WS_WRIN), M, 2 * DRNN, DM}; StaticOrder S; S.init(M, 2 * DRNN, G, bid);
      EpiAct<1> E{XR, GG, DRNN};
      gemm_phase<EpiAct<1>, StaticOrder, true, true>(lds, g, S, E); }
    GRID_BAR();
    rnn_phase<false>(lds, XR, GG, args.in[10], args.in[11], (const bf16*)(ws + WS_WG), args.in[13], args.in[15], (const float*)(ws + WS_SP8), (f32x2*)(ws + WS_AGG), (const float*)(ws + WS_CIN), tid, lane, wave, G, bid);
    GRID_BAR();
    rnn_carry_phase((const f32x2*)(ws + WS_AGG), (float*)(ws + WS_CIN), tid, G, bid);
    GRID_BAR();
    rnn_phase<true>(lds, XR, GG, args.in[10], args.in[11], (const bf16*)(ws + WS_WG), args.in[13], args.in[15], (const float*)(ws + WS_SP8), (f32x2*)(ws + WS_AGG), (const float*)(ws + WS_CIN), tid, lane, wave, G, bid);
    GRID_BAR();
    { Gemm g{GG, (const bf16_t*)(ws + WS_WROUT), M, DM, DRNN}; StaticOrder S; S.init(M, DM, G, bid);
      EpiRes<false> E{ws, nullptr, ln_g, ln_b, 2};
      gemm_phase<EpiRes<false>, StaticOrder, true, true>(lds, g, S, E); }
    GRID_BAR();
    ln_mod_phase<true, false, false>(XB, nullptr, HB, ln_g + 2 * 1024, ln_b + 2 * 1024, MOD + 3 * 12288, (float*)(ws + WS_STAT), lane, wave, G, bid);
    GRID_BAR();
    { Gemm g{HB, (const bf16_t*)(ws + WS_W1) + (size_t)DFF * DM, M, DFF, DM}; StaticOrder S; S.init(M, DFF, G, bid);
      EpiAct<0> E{Hbig, nullptr, DFF};
      gemm_phase<EpiAct<0>, StaticOrder, true, true>(lds, g, S, E); }
    GRID_BAR();
    { Gemm g{Hbig, (const bf16_t*)(ws + WS_W2) + (size_t)DM * DFF, M, DM, DFF}; StaticOrder S; S.init(M, DM, G, bid);
      EpiRes<false> E{ws, nullptr, ln_g, ln_b, 3};
      gemm_phase<EpiRes<false>, StaticOrder, true, true>(lds, g, S, E); }
    GRID_BAR();
    ln_mod_phase<true, false, true>(XB, args.out, nullptr, ln_g + 3 * 1024, ln_b + 3 * 1024, nullptr, nullptr, lane, wave, G, bid);
}

extern "C" void kernel_launch(void* const* d_in, const int* in_sizes, int n_in, void* d_out, int out_size, void* d_ws, size_t ws_size, hipStream_t stream) {
    static int grid = 0;
    if (grid == 0) {
        if (n_in != 20 || out_size != M * DM || ws_size < WS_END) { fprintf(stderr, "kernel_launch: unexpected problem (n_in %d, out %d, ws %zu)\n", n_in, out_size, ws_size); grid = -1; return; }
        int dev = 0, cus = 0, per_cu = 0;
        (void)hipGetDevice(&dev); (void)hipDeviceGetAttribute(&cus, hipDeviceAttributeMultiprocessorCount, dev);
        if (hipFuncSetAttribute((const void*)fwd_megakernel, hipFuncAttributeMaxDynamicSharedMemorySize, LDS_BYTES) != hipSuccess) { fprintf(stderr, "kernel_launch: hipFuncSetAttribute failed\n"); grid = -1; return; }
        if (hipOccupancyMaxActiveBlocksPerMultiprocessor(&per_cu, (const void*)fwd_megakernel, NTHR, LDS_BYTES) != hipSuccess || per_cu < 1) { fprintf(stderr, "kernel_launch: occupancy query gave %d\n", per_cu); per_cu = 1; }
        (void)hipGetLastError();
        grid = cus * 1;
    }
    if (grid < 0) return;
    Args a{};
    for (int i = 0; i < 20; ++i) a.in[i] = (const float*)d_in[i];
    a.out = (float*)d_out; a.ws = (unsigned char*)d_ws;
    void* kargs[] = {&a};
    hipError_t e = hipLaunchCooperativeKernel((const void*)fwd_megakernel, dim3(grid), dim3(NTHR), kargs, LDS_BYTES, stream);
    if (e != hipSuccess) fprintf(stderr, "cooperative launch failed: %s (grid %d)\n", hipGetErrorString(e), grid);
}
```

```cpp
#include <hip/hip_runtime.h>
#include <hip/hip_cooperative_groups.h>
#include <cstdio>
#include <cstdint>
namespace cg = cooperative_groups;
constexpr int NWAVES = 8, NTHR = 512;
constexpr int BATCH = 4, SEQ = 8192, DM = 1024, M = BATCH * SEQ, DFF = 4096, DRNN = 1536, NQKV = 1536;
constexpr float LN_EPS = 1e-5f, DN_ALPHA = 1.4142135623730951f, LOG2E = 1.4426950408889634f;
constexpr int LDS_BYTES = 147456;
constexpr size_t MiB = 1u << 20;
constexpr size_t WS_MOD = 0;
constexpr size_t WS_BAR = 768 * 1024;
constexpr size_t WS_STAT = 256 * 1024;
constexpr size_t WS_SP8 = 512 * 1024;
constexpr size_t WS_CS = 1 * MiB;
constexpr size_t WS_WG = 2 * MiB;
constexpr size_t WS_WQKV = 4 * MiB;
constexpr size_t WS_WO = 7 * MiB;
constexpr size_t WS_WRIN = 9 * MiB;
constexpr size_t WS_WROUT = 15 * MiB;
constexpr size_t WS_W1 = 18 * MiB;
constexpr size_t WS_W2 = 34 * MiB;
constexpr size_t WS_XB = 50 * MiB;
constexpr size_t WS_HB = 178 * MiB;
constexpr size_t WS_BIG = 242 * MiB;
constexpr size_t WS_Q = WS_BIG, WS_K = WS_BIG + 64 * MiB, WS_V = WS_BIG + 80 * MiB, WS_O = WS_BIG + 96 * MiB;
constexpr size_t WS_XR = WS_BIG, WS_GG = WS_BIG + 96 * MiB;
constexpr size_t WS_AGG = WS_BIG + 192 * MiB;
constexpr size_t WS_CIN = WS_BIG + 208 * MiB;
constexpr size_t WS_END = WS_BIG + 256 * MiB;

namespace pg8 {
#define PG8_LAS __attribute__((address_space(3)))
typedef unsigned short bf16_t;
typedef short bf16x8 __attribute__((ext_vector_type(8)));
typedef float f32x4 __attribute__((ext_vector_type(4)));
typedef unsigned u32x4 __attribute__((ext_vector_type(4)));
constexpr int BM = 256, BK = 64, HALF = 128, HTB = HALF * BK * 2  , STAGE_BYTES = 8 * HTB, NXCD = 8, WGM = 8;

__host__ __device__ __forceinline__ int lds_byte(int r, int c) { const int st = (r >> 4) * 2 + (c >> 5), rr = r & 15, cc = c & 31, ob = rr * 64 + cc * 2; return st * 1024 + (ob ^ (((ob >> 9) & 1) << 5)); }
__host__ __device__ __forceinline__ void stage_rc(int b, int& R, int& C) { const int st = b / 1024, sb = b % 1024, swz = sb ^ (((sb >> 9) & 1) << 5); R = (st >> 1) * 16 + swz / 64; C = (st & 1) * 32 + (swz % 64) / 2; }
__host__ __device__ __forceinline__ int perm32(int rho) { const int n = rho >> 4, i = rho & 15; return 8 * (i >> 2) + 4 * n + (i & 3); }

struct Unit { int pm, pn; };
struct Gemm { const bf16_t* A; const bf16_t* Bt; int M, N, K; };

struct StaticOrder {
    int nM, nN, nwg, G, c;
    __host__ __device__ void init(int M, int N, int G_, int c_) { nM = M / BM; nN = N / BM; nwg = nM * nN; G = G_; c = c_; }
    __host__ __device__ bool next(int i, Unit& u) const {
        const long L = (long)i * G + c; if (L >= nwg) return false;
        int wgid = (int)L; { const int q = nwg / NXCD, r = nwg % NXCD, xcd = wgid % NXCD, off = wgid / NXCD; wgid = (xcd < r ? xcd * (q + 1) : r * (q + 1) + (xcd - r) * q) + off; }
        const int nig = WGM * nN, gid = wgid / nig, fm = gid * WGM, gsz = (nM - fm) < WGM ? (nM - fm) : WGM;
        u.pm = fm + ((wgid % nig) % gsz); u.pn = (wgid % nig) / gsz; return true;
    }
    __device__ __forceinline__ void a_ready(const Unit&) const {}
    __device__ __forceinline__ void done(const Unit&) const {}
};

__device__ __forceinline__ unsigned cvt_pk_bf16(float lo, float hi) { unsigned r; asm volatile("v_cvt_pk_bf16_f32 %0, %1, %2" : "=v"(r) : "v"(lo), "v"(hi)); return r; }
__device__ __forceinline__ u32x4 pack8(const f32x4 v0, const f32x4 v1) { u32x4 w; w.x = cvt_pk_bf16(v0[0], v0[1]); w.y = cvt_pk_bf16(v0[2], v0[3]); w.z = cvt_pk_bf16(v1[0], v1[1]); w.w = cvt_pk_bf16(v1[2], v1[3]); return w; }
struct EpiQKV {
    static constexpr bool PERM = true, AFTER_DRAIN = false;
    bf16_t* Q; bf16_t* K; bf16_t* V; const float* cs; float qscale;
    __device__ __forceinline__ void operator()(const f32x4 (&acc)[2][2][4][2], const Unit& u, int wr, int wc, int fr, int fq) const {
        const int row0 = u.pm * BM + wr * 64 + fr;
        bf16_t* base; int ld, colt; float sc = 1.f; bool rope = true;
        if (u.pn < 4) { base = Q; ld = 1024; colt = u.pn * BM; sc = qscale; }
        else if (u.pn == 4) { base = K; ld = 256; colt = 0; }
        else { base = V; ld = 256; colt = 0; rope = false; }
        const int col0 = colt + wc * 32 + 8 * fq;
        const bool dorope = rope && (wc == 0);
#pragma unroll
        for (int ai = 0; ai < 2; ++ai)
#pragma unroll
            for (int m = 0; m < 4; ++m) {
                const int row = row0 + ai * HALF + m * 16; const int pos = row & 8191;
                f32x4 c0 = {1.f, 1.f, 1.f, 1.f}, c1 = c0, s0 = {0.f, 0.f, 0.f, 0.f}, s1 = s0;
                if (dorope) { const float* t = cs + (size_t)pos * 32 + 8 * (fq & 1); c0 = *(const f32x4*)t; c1 = *(const f32x4*)(t + 4); s0 = *(const f32x4*)(t + 16); s1 = *(const f32x4*)(t + 20);
                    if (fq < 2) { s0 = -s0; s1 = -s1; } }
#pragma unroll
                for (int bj = 0; bj < 2; ++bj) {
                    f32x4 v0 = acc[ai][bj][m][0], v1 = acc[ai][bj][m][1];
                    if (dorope) { f32x4 p0, p1;
#pragma unroll
                        for (int j = 0; j < 4; ++j) { p0[j] = __shfl_xor(v0[j], 32); p1[j] = __shfl_xor(v1[j], 32); }
                        v0 = v0 * c0 + p0 * s0; v1 = v1 * c1 + p1 * s1; }
                    v0 = v0 * sc; v1 = v1 * sc;
                    *(u32x4*)(base + (size_t)row * ld + col0 + bj * HALF) = pack8(v0, v1);
                }
            }
    }
};
template <bool XF32> struct EpiRes {
    static constexpr bool PERM = true, AFTER_DRAIN = false;
    unsigned char* ws; const float* xin; const float* lng_all; const float* lnb_all; int k;
    __device__ __forceinline__ void operator()(const f32x4 (&acc)[2][2][4][2], const Unit& u, int wr, int wc, int fr, int fq) const {
        const int row0 = u.pm * BM + wr * 64 + fr, col0 = u.pn * BM + wc * 32 + 8 * fq;
        const int b = (u.pm * BM) >> 13;
        const void* xres = XF32 ? (const void*)xin : (const void*)(ws + WS_XB); bf16_t* out = (bf16_t*)(ws + WS_XB); constexpr float alpha = DN_ALPHA;
        const float* gate = (const float*)(ws + WS_MOD) + k * 12288 + 2048; const float* stat = (const float*)(ws + WS_STAT);
        const float* lng = lng_all + (k - 1) * 1024; const float* lnb = lnb_all + (k - 1) * 1024;
#pragma unroll
        for (int bj = 0; bj < 2; ++bj) {
            const f32x4 g0 = *(const f32x4*)(gate + b * 3072 + col0 + bj * HALF) + 1.0f, g1 = *(const f32x4*)(gate + b * 3072 + col0 + bj * HALF + 4) + 1.0f;
            f32x4 G0, G1, B0, B1;
            if (!XF32) { G0 = *(const f32x4*)(lng + col0 + bj * HALF); G1 = *(const f32x4*)(lng + col0 + bj * HALF + 4); B0 = *(const f32x4*)(lnb + col0 + bj * HALF); B1 = *(const f32x4*)(lnb + col0 + bj * HALF + 4); }
            typedef float f32x2e __attribute__((ext_vector_type(2)));
#pragma unroll
            for (int ai = 0; ai < 2; ++ai) {
                u32x4 xw[4]; f32x2e srs[4];
                if (!XF32) {
#pragma unroll
                    for (int m = 0; m < 4; ++m) { const int r_ = row0 + ai * HALF + m * 16; xw[m] = *(const u32x4*)((const bf16_t*)xres + (size_t)r_ * 1024 + col0 + bj * HALF); srs[m] = *(const f32x2e*)(stat + 2 * r_); }
                    asm volatile("" ::: "memory");
                }
#pragma unroll
                for (int m = 0; m < 4; ++m) { const size_t off = (size_t)(row0 + ai * HALF + m * 16) * 1024 + col0 + bj * HALF;
                    f32x4 x0, x1;
                    if (XF32) { x0 = *(const f32x4*)((const float*)xres + off); x1 = *(const f32x4*)((const float*)xres + off + 4); }
                    else { const u32x4 w = xw[m]; const f32x2e sr = srs[m];
                        x0 = (f32x4){__uint_as_float(w.x << 16), __uint_as_float(w.x & 0xffff0000u), __uint_as_float(w.y << 16), __uint_as_float(w.y & 0xffff0000u)};
                        x1 = (f32x4){__uint_as_float(w.z << 16), __uint_as_float(w.z & 0xffff0000u), __uint_as_float(w.w << 16), __uint_as_float(w.w & 0xffff0000u)};
                        x0 = (x0 - sr.x) * sr.y * G0 + B0; x1 = (x1 - sr.x) * sr.y * G1 + B1; }
                    *(u32x4*)(out + off) = pack8(x0 * alpha + g0 * acc[ai][bj][m][0], x1 * alpha + g1 * acc[ai][bj][m][1]);
                    if (XF32 && (m & 1)) asm volatile("" ::: "memory"); }
                asm volatile("" ::: "memory");
            }
        }
    }
};
__device__ __forceinline__ float gelu_tanh(float x) { const float t = x * x * 0.044715f + 1.0f; const float e = __builtin_amdgcn_exp2f(-2.302208198f * (x * t)); return x * __builtin_amdgcn_rcpf(1.0f + e); }
template <int MODE> struct EpiAct {
    static constexpr bool PERM = true, AFTER_DRAIN = false;
    bf16_t* O; bf16_t* O2; int ldc;
    __device__ __forceinline__ void operator()(const f32x4 (&acc)[2][2][4][2], const Unit& u, int wr, int wc, int fr, int fq) const {
        const int row0 = u.pm * BM + wr * 64 + fr; int colt = u.pn * BM; bf16_t* base = O; bool act = (MODE == 0);
        if (MODE == 1 && u.pn >= 6) { base = O2; colt -= 1536; act = true; }
        const int col0 = colt + wc * 32 + 8 * fq;
#pragma unroll
        for (int ai = 0; ai < 2; ++ai)
#pragma unroll
            for (int m = 0; m < 4; ++m) { bf16_t* rowp = base + (size_t)(row0 + ai * HALF + m * 16) * ldc + col0;
#pragma unroll
                for (int bj = 0; bj < 2; ++bj) { f32x4 v0 = acc[ai][bj][m][0], v1 = acc[ai][bj][m][1];
                    if (act) {
#pragma unroll
                        for (int j = 0; j < 4; ++j) {
                            if (MODE == 0) { const float a = fmaxf(v0[j], 0.f), b = fmaxf(v1[j], 0.f); v0[j] = a * a; v1[j] = b * b; }
                            else { v0[j] = gelu_tanh(v0[j]); v1[j] = gelu_tanh(v1[j]); } } }
                    *(u32x4*)(rowp + bj * HALF) = pack8(v0, v1); } }
    }
};
template <class Epi, class Sched, bool ALIGN_EPI = false, bool SP2 = false>
__device__ __forceinline__ void gemm_phase(PG8_LAS unsigned char* lds, const Gemm g, const Sched& S, const Epi& E) {
    int tid_ = threadIdx.x; asm volatile("" : "+v"(tid_));
    const int tid = tid_, wid = __builtin_amdgcn_readfirstlane(tid >> 6), lane = tid & 63, wr = wid >> 2, wc = wid & 3, fr = lane & 15, fq = lane >> 4;
    const int K = g.K, nt = K / BK;
    unsigned voffA[2], voffB[2];
#pragma unroll
    for (int i = 0; i < 2; ++i) { int R, C; stage_rc(tid * 16 + i * 8192, R, C); const int Rb = Epi::PERM ? ((R & ~31) + perm32(R & 31)) : R;
        voffA[i] = (unsigned)(R * K + C) * 2u; voffB[i] = (unsigned)(Rb * K + C) * 2u; }
    const size_t kstep = (size_t)(BK * 2);
    const size_t hstep = (size_t)HALF * K * 2;
    const size_t tstep = 2 * hstep;
    const unsigned ldsw = (unsigned)wid * 1024u;
    const int aoff = lds_byte(wr * 64 + fr, fq * 8), boff = lds_byte(wc * 32 + fr, fq * 8);
#define PG8_SA(b, h) (((b) * 2 + (h)) * HTB)
#define PG8_SB(b, h) ((4 + (b) * 2 + (h)) * HTB)
#define PG8_STAGE(bufoff, gbase, voff) do { _Pragma("unroll") for (int _i = 0; _i < 2; ++_i) \
        __builtin_amdgcn_global_load_lds((const unsigned*)((const char*)(gbase) + (voff)[_i]), (PG8_LAS unsigned*)(lds + (bufoff) + ldsw + _i * 8192), 16, 0, 0); } while (0)
#define PG8_LDA(dst, b, h) do { _Pragma("unroll") for (int m = 0; m < 4; ++m) _Pragma("unroll") for (int k = 0; k < 2; ++k) dst[m][k] = *(const PG8_LAS bf16x8*)(lds + PG8_SA(b, h) + aoff + m * 2048 + k * 1024); } while (0)
#define PG8_LDB(dst, b, h) do { _Pragma("unroll") for (int n = 0; n < 2; ++n) _Pragma("unroll") for (int k = 0; k < 2; ++k) dst[n][k] = *(const PG8_LAS bf16x8*)(lds + PG8_SB(b, h) + boff + n * 2048 + k * 1024); } while (0)
#define PG8_MMA(ai, bj, At, Bt) do { __builtin_amdgcn_s_setprio(1); _Pragma("unroll") for (int m = 0; m < 4; ++m) _Pragma("unroll") for (int n = 0; n < 2; ++n) _Pragma("unroll") for (int k = 0; k < 2; ++k) \
        acc[ai][bj][m][n] = __builtin_amdgcn_mfma_f32_16x16x32_bf16(Bt[n][k], At[m][k], acc[ai][bj][m][n], 0, 0, 0); __builtin_amdgcn_s_setprio(0); } while (0)
#define PG8_WAIT_V(n) asm volatile("s_waitcnt vmcnt(" #n ")" ::: "memory")
#define PG8_WAIT_L(n) asm volatile("s_waitcnt lgkmcnt(" #n ")" ::: "memory")
#define PG8_BAR __builtin_amdgcn_s_barrier()
#define PG8_SCHED __builtin_amdgcn_sched_barrier(0)
    Unit cur, nxt; int ui = 0;
    if (!S.next(0, cur)) return;
    f32x4 acc[2][2][4][2];
#pragma unroll
    for (int a = 0; a < 2; ++a)
#pragma unroll
        for (int b = 0; b < 2; ++b)
#pragma unroll
            for (int m = 0; m < 4; ++m)
#pragma unroll
                for (int n = 0; n < 2; ++n) acc[a][b][m][n] = (f32x4){0.f, 0.f, 0.f, 0.f};
    bf16x8 At[4][2], B0[2][2], B1[2][2];
    const char* cA = (const char*)g.A + (size_t)cur.pm * tstep; const char* cB = (const char*)g.Bt + (size_t)cur.pn * tstep;
    S.a_ready(cur);
    if constexpr (SP2) {
        PG8_STAGE(PG8_SB(0, 0), cB, voffB); PG8_STAGE(PG8_SB(0, 1), cB + hstep, voffB); PG8_STAGE(PG8_SA(0, 0), cA, voffA); PG8_STAGE(PG8_SA(0, 1), cA + hstep, voffA);
        if (wr == 1) PG8_BAR;
        PG8_WAIT_V(2); PG8_BAR;
        PG8_STAGE(PG8_SB(1, 0), cB + kstep, voffB); PG8_STAGE(PG8_SA(1, 0), cA + kstep, voffA); PG8_STAGE(PG8_SB(1, 1), cB + hstep + kstep, voffB);
        PG8_WAIT_V(6); PG8_BAR;
    } else {
        PG8_STAGE(PG8_SB(0, 0), cB, voffB); PG8_STAGE(PG8_SA(0, 0), cA, voffA); PG8_STAGE(PG8_SB(0, 1), cB + hstep, voffB); PG8_STAGE(PG8_SA(0, 1), cA + hstep, voffA);
        if (wr == 1) PG8_BAR;
        PG8_WAIT_V(4); PG8_BAR;
        PG8_STAGE(PG8_SB(1, 0), cB + kstep, voffB); PG8_STAGE(PG8_SA(1, 0), cA + kstep, voffA); PG8_STAGE(PG8_SB(1, 1), cB + hstep + kstep, voffB);
        PG8_WAIT_V(6); PG8_BAR;
    }
    for (;;) {
        const bool has_next = S.next(ui + 1, nxt);
        const char* nA = has_next ? (const char*)g.A + (size_t)nxt.pm * tstep : cA; const char* nB = has_next ? (const char*)g.Bt + (size_t)nxt.pn * tstep : cB;
        asm volatile(".p2align 8");
        for (int t = 0; t < nt; t += 2) {
            const bool last = (t == nt - 2);
            const char* a1 = cA + (size_t)(t + 1) * kstep;
            const char* a2 = last ? nA : cA + (size_t)(t + 2) * kstep; const char* b2 = last ? nB : cB + (size_t)(t + 2) * kstep;
            const char* a3 = a2 + kstep; const char* b3 = b2 + kstep;
            if (last && has_next) S.a_ready(nxt);
            if constexpr (SP2) {
            PG8_LDB(B0, 0, 0); PG8_LDB(B1, 0, 1); PG8_SCHED; PG8_LDA(At, 0, 0); PG8_STAGE(PG8_SA(1, 1), a1 + hstep, voffA);
            PG8_WAIT_V(8); PG8_WAIT_L(0); PG8_BAR; PG8_MMA(0, 0, At, B0); PG8_MMA(0, 1, At, B1); PG8_BAR; PG8_SCHED;
            PG8_LDA(At, 0, 1); PG8_STAGE(PG8_SB(0, 0), b2, voffB); PG8_STAGE(PG8_SB(0, 1), b2 + hstep, voffB); PG8_STAGE(PG8_SA(0, 0), a2, voffA);
            PG8_WAIT_V(8); PG8_WAIT_L(0); PG8_BAR; PG8_MMA(1, 0, At, B0); PG8_MMA(1, 1, At, B1); PG8_BAR; PG8_SCHED;
            PG8_LDB(B0, 1, 0); PG8_LDB(B1, 1, 1); PG8_SCHED; PG8_LDA(At, 1, 0); PG8_STAGE(PG8_SA(0, 1), a2 + hstep, voffA);
            PG8_WAIT_V(8); PG8_WAIT_L(0); PG8_BAR; PG8_MMA(0, 0, At, B0); PG8_MMA(0, 1, At, B1); PG8_BAR; PG8_SCHED;
            PG8_LDA(At, 1, 1); PG8_STAGE(PG8_SB(1, 0), b3, voffB); PG8_STAGE(PG8_SB(1, 1), b3 + hstep, voffB); PG8_STAGE(PG8_SA(1, 0), a3, voffA);
            PG8_WAIT_V(8); PG8_WAIT_L(0); PG8_BAR; PG8_MMA(1, 0, At, B0); PG8_MMA(1, 1, At, B1); PG8_BAR; PG8_SCHED;
            } else {
            PG8_LDB(B0, 0, 0); PG8_SCHED; PG8_LDA(At, 0, 0); PG8_STAGE(PG8_SA(1, 1), a1 + hstep, voffA);
            PG8_WAIT_L(8); PG8_BAR; PG8_WAIT_L(0); PG8_MMA(0, 0, At, B0); PG8_BAR; PG8_SCHED;
            PG8_LDB(B1, 0, 1); PG8_STAGE(PG8_SB(0, 0), b2, voffB);
            PG8_BAR; PG8_WAIT_L(0); PG8_MMA(0, 1, At, B1); PG8_BAR;
            PG8_LDA(At, 0, 1); PG8_STAGE(PG8_SA(0, 0), a2, voffA);
            PG8_BAR; PG8_WAIT_L(0); PG8_MMA(1, 0, At, B0); PG8_BAR; PG8_SCHED;
            PG8_STAGE(PG8_SB(0, 1), b2 + hstep, voffB);
            PG8_WAIT_V(6); PG8_BAR; PG8_MMA(1, 1, At, B1); PG8_BAR;
            PG8_LDB(B0, 1, 0); PG8_SCHED; PG8_LDA(At, 1, 0); PG8_STAGE(PG8_SA(0, 1), a2 + hstep, voffA);
            PG8_WAIT_L(8); PG8_BAR; PG8_WAIT_L(0); PG8_MMA(0, 0, At, B0); PG8_BAR; PG8_SCHED;
            PG8_LDB(B1, 1, 1); PG8_STAGE(PG8_SB(1, 0), b3, voffB);
            PG8_BAR; PG8_WAIT_L(0); PG8_MMA(0, 1, At, B1); PG8_BAR;
            PG8_LDA(At, 1, 1); PG8_STAGE(PG8_SA(1, 0), a3, voffA);
            PG8_BAR; PG8_WAIT_L(0); PG8_MMA(1, 0, At, B0); PG8_BAR; PG8_SCHED;
            PG8_STAGE(PG8_SB(1, 1), b3 + hstep, voffB);
            PG8_WAIT_V(6); PG8_BAR; PG8_MMA(1, 1, At, B1); PG8_BAR;
            }
        }
        if constexpr (ALIGN_EPI) { if (wr == 0) PG8_BAR; }
        if constexpr (!Epi::AFTER_DRAIN) { E(acc, cur, wr, wc, fr, fq); S.done(cur); }
        if (!has_next) break;
#pragma unroll
        for (int a = 0; a < 2; ++a)
#pragma unroll
            for (int b = 0; b < 2; ++b)
#pragma unroll
                for (int m = 0; m < 4; ++m)
#pragma unroll
                    for (int n = 0; n < 2; ++n) acc[a][b][m][n] = (f32x4){0.f, 0.f, 0.f, 0.f};
        cur = nxt; cA = nA; cB = nB; ++ui;
        if constexpr (ALIGN_EPI) { if (wr == 1) PG8_BAR; }
    }
    PG8_WAIT_V(0);
    if constexpr (!ALIGN_EPI) { if (wr == 0) PG8_BAR; }
    PG8_BAR;
    if constexpr (Epi::AFTER_DRAIN) { E.fused(acc, cur, wr, wc, fr, fq, lds, wid, lane); S.done(cur); }
#undef PG8_SA
#undef PG8_SB
#undef PG8_STAGE
#undef PG8_LDA
#undef PG8_LDB
#undef PG8_MMA
#undef PG8_WAIT_V
#undef PG8_WAIT_L
#undef PG8_BAR
#undef PG8_SCHED
}
}

#define LAS __attribute__((address_space(3)))
typedef unsigned short bf16;
typedef unsigned v4u __attribute__((ext_vector_type(4)));
typedef unsigned v2u __attribute__((ext_vector_type(2)));
typedef float f32x4 __attribute__((ext_vector_type(4)));
typedef float f32x2 __attribute__((ext_vector_type(2)));
typedef float f32x16 __attribute__((ext_vector_type(16)));
typedef short bf16x8 __attribute__((ext_vector_type(8)));
typedef short s16x4 __attribute__((ext_vector_type(4)));
typedef __bf16 bf16x2_t __attribute__((ext_vector_type(2)));
__device__ __forceinline__ unsigned pk2(float lo, float hi) { f32x2 v = {lo, hi}; bf16x2_t b = __builtin_convertvector(v, bf16x2_t); return __builtin_bit_cast(unsigned, b); }
__device__ __forceinline__ float bf2f(unsigned short h) { return __uint_as_float((unsigned)h << 16); }
__device__ __forceinline__ float wave_sum(float v) {
#pragma unroll
    for (int o = 1; o < 64; o <<= 1) v += __shfl_xor(v, o);
    return v;
}
__device__ __forceinline__ float sigmoidf_(float x) { return __builtin_amdgcn_rcpf(1.0f + __builtin_amdgcn_exp2f(-1.4426950408889634f * x)); }

struct Args { const float* in[20]; float* out; unsigned char* ws; };


#define GAS __attribute__((address_space(1)))
#define XB_TMO      128
#define XB_XCNT(j)  (256  + 64 * (j))
#define XB_XSUB(j)  (1280 + 64 * (j))
#define XB_XGEN(j)  (2304 + 64 * (j))
#define XB_TOP      3328
#define XB_TOPGEN   3392
#define XCD_BAR_WORDS 3456
#define XB_SPIN_CAP (1u << 18)

__device__ __forceinline__ unsigned xb_ld(unsigned* p)              { return __hip_atomic_load(p, __ATOMIC_RELAXED, __HIP_MEMORY_SCOPE_AGENT); }
__device__ __forceinline__ unsigned xb_add(unsigned* p, unsigned v) { return __hip_atomic_fetch_add(p, v, __ATOMIC_RELAXED, __HIP_MEMORY_SCOPE_AGENT); }
__device__ __forceinline__ unsigned xb_xcc_id() { return (unsigned)__builtin_amdgcn_s_getreg((3 << 11) | 20) & 0xFu; }
#define XB_SPIN(cond, bar) do { unsigned _sp = 0; while (cond) { __builtin_amdgcn_s_sleep(1); \
    if ((++_sp & 255u) == 0u) { if (xb_ld(&(bar)[XB_TMO])) break; if (_sp > XB_SPIN_CAP) { atomicAdd(&(bar)[XB_TMO], 1u); break; } } } } while (0)

struct XcdBarrier {
    unsigned* bar; unsigned x;
    volatile LAS unsigned* st;
};

__device__ __forceinline__ XcdBarrier xcd_barrier_post(unsigned* bar, volatile LAS unsigned* st) {
    XcdBarrier b; b.bar = bar; b.x = xb_xcc_id(); b.st = st;
    if (threadIdx.x == 0) (void)xb_add(&bar[XB_XCNT(b.x)], 1u);
    return b;
}
__device__ __forceinline__ void xcd_barrier_complete(unsigned* bar, unsigned x, unsigned& nloc, unsigned& nx) {
    const unsigned G = gridDim.x * gridDim.y * gridDim.z;
    unsigned sum, cnt, mine, sp = 0u;
    for (;;) {
        sum = 0u; cnt = 0u; mine = 0u;
#pragma unroll
        for (unsigned j = 0; j < 16; ++j) { const unsigned c = xb_ld(&bar[XB_XCNT(j)]); sum += c; cnt += (c > 0u) ? 1u : 0u; mine = (j == x) ? c : mine; }
        if (sum == G) break;
        __builtin_amdgcn_s_sleep(1);
        if ((++sp & 255u) == 0u) { if (xb_ld(&bar[XB_TMO])) break; if (sp > XB_SPIN_CAP) { atomicAdd(&bar[XB_TMO], 1u); break; } }
    }
    nloc = mine > 0u ? mine : 1u; nx = cnt > 0u ? cnt : 1u;
}

__device__ __forceinline__ void xcd_barrier(const XcdBarrier& b) {
    asm volatile("s_waitcnt vmcnt(0)" ::: "memory");
    __syncthreads();
    if (threadIdx.x == 0) {
        unsigned* bar = b.bar;
        __builtin_amdgcn_s_waitcnt(0);
        unsigned nloc = b.st[0], nx = b.st[1];
        if (nloc == 0u) { xcd_barrier_complete(bar, b.x, nloc, nx); b.st[0] = nloc; b.st[1] = nx; }
        const unsigned old = xb_add(&bar[XB_XSUB(b.x)], 1u);
        const unsigned gen = old / nloc;
        if (old + 1u == (gen + 1u) * nloc) {
            __builtin_amdgcn_fence(__ATOMIC_RELEASE, "agent");
            asm volatile("s_waitcnt vmcnt(0)" ::: "memory");
            const unsigned og = xb_add(&bar[XB_TOP], 1u);
            const unsigned tg = og / nx;
            if (og + 1u == (tg + 1u) * nx) xb_add(&bar[XB_TOPGEN], 1u);
            else XB_SPIN(xb_ld(&bar[XB_TOPGEN]) == tg, bar);
            __builtin_amdgcn_fence(__ATOMIC_ACQUIRE, "agent");
            xb_add(&bar[XB_XGEN(b.x)], 1u);
            asm volatile("s_waitcnt vmcnt(0)" ::: "memory");
        } else {
            XB_SPIN(xb_ld(&bar[XB_XGEN(b.x)]) == gen, bar);
            __builtin_amdgcn_fence(__ATOMIC_ACQUIRE, "agent");
            asm volatile("s_waitcnt vmcnt(0)" ::: "memory");
        }
    }
    __syncthreads();
}

__device__ __forceinline__ void p0_transpose_item(const float* W, int K, int N, bf16* WT, LAS float* scr, int item, int lane) {
    const int nblk = N / 32, kb = item / nblk, nb = item % nblk, k0 = 64 * kb, n0 = 32 * nb;
    float wv_[32];
#pragma unroll
    for (int i = 0; i < 32; ++i) wv_[i] = W[(size_t)(k0 + 2 * i + (lane >> 5)) * N + n0 + (lane & 31)];
#pragma unroll
    for (int i = 0; i < 32; ++i) scr[(2 * i + (lane >> 5)) * 33 + (lane & 31)] = wv_[i];
    asm volatile("s_waitcnt lgkmcnt(0)" ::: "memory");
    const int c = lane & 7;
#pragma unroll
    for (int j = 0; j < 4; ++j) { const int n = (lane >> 3) + 8 * j; const LAS float* s = scr + (8 * c) * 33 + n;
        v4u o; o.x = pk2(s[0 * 33], s[1 * 33]); o.y = pk2(s[2 * 33], s[3 * 33]); o.z = pk2(s[4 * 33], s[5 * 33]); o.w = pk2(s[6 * 33], s[7 * 33]);
        *(v4u*)(WT + (size_t)(n0 + n) * K + k0 + 8 * c) = o; }
    asm volatile("s_waitcnt lgkmcnt(0)" ::: "memory");
}

__device__ __forceinline__ void p0_prologue(const Args& a, LAS unsigned char* lds, int tid, int lane, int wave, int G, int bid) {
    unsigned char* ws = a.ws;
    {
        LAS float* sc = (LAS float*)lds;
        LAS float* red = (LAS float*)(lds + 16384);
        const float* c = a.in[1];
        for (int i = tid; i < 4096; i += NTHR) { const float v = c[i]; sc[i] = v / (1.0f + __expf(-v)); }
        __syncthreads();
        for (int item = bid; item < 192; item += G) {
            const int s = item / 48, n0 = (item % 48) * 64;
            const float* w = a.in[2] + (size_t)s * 1024 * 3072 + n0 + lane;
            float acc0 = 0.f, acc1 = 0.f, acc2 = 0.f, acc3 = 0.f;
            const int kbeg = wave * 128;
#pragma unroll 32
            for (int k = 0; k < 128; ++k) { const float wv = w[(size_t)(kbeg + k) * 3072];
                acc0 += wv * sc[kbeg + k]; acc1 += wv * sc[1024 + kbeg + k]; acc2 += wv * sc[2048 + kbeg + k]; acc3 += wv * sc[3072 + kbeg + k]; }
            red[(wave * 4 + 0) * 64 + lane] = acc0; red[(wave * 4 + 1) * 64 + lane] = acc1; red[(wave * 4 + 2) * 64 + lane] = acc2; red[(wave * 4 + 3) * 64 + lane] = acc3;
            __syncthreads();
            if (tid < 256) { const int b = tid >> 6, l = tid & 63; float t = a.in[3][s * 3072 + n0 + l];
#pragma unroll
                for (int wv = 0; wv < 8; ++wv) t += red[(wv * 4 + b) * 64 + l];
                ((float*)(ws + WS_MOD))[(s * 4 + b) * 3072 + n0 + l] = t; }
            __syncthreads();
        }
    }
    __syncthreads();
    {
        const float invf[16] = {1.000000000e+00f, 4.403665960e-01f, 1.939227432e-01f, 8.539710194e-02f, 3.760603070e-02f, 1.656043902e-02f, 7.292664610e-03f, 3.211445874e-03f,
                                1.414213562e-03f, 6.227723788e-04f, 2.742481884e-04f, 1.207697351e-04f, 5.318296098e-05f, 2.341999971e-05f, 1.031338616e-05f, 4.541670478e-06f};
        float* cs = (float*)(ws + WS_CS);
        for (int idx = bid * NTHR + tid; idx < 8192 * 16; idx += G * NTHR) {
            const int pos = idx >> 4, i = idx & 15;
            float f = invf[0];
#pragma unroll
            for (int q = 1; q < 16; ++q) f = (i == q) ? invf[q] : f;
            const float ang = (float)pos * f;
            double t = (double)ang * 0.15915494309189535; t -= __builtin_rint(t);
            const float r = (float)t;
            cs[pos * 32 + i] = __builtin_amdgcn_cosf(r); cs[pos * 32 + 16 + i] = __builtin_amdgcn_sinf(r);
        }
    }
    { float* sp8 = (float*)(ws + WS_SP8); for (int idx = bid * NTHR + tid; idx < 2 * DRNN; idx += G * NTHR) sp8[idx] = 8.0f * log1pf(__expf(-a.in[16][idx])); }
    {
        bf16* wg = (bf16*)(ws + WS_WG);
        for (int idx = bid * NTHR + tid; idx < 2 * 16 * 2 * 96 * 96; idx += G * NTHR) {
            const int i = idx % 96, j = (idx / 96) % 96, gate = (idx / 9216) & 1, n = (idx / 18432) & 15, dir = idx / 294912;
            const float* src = gate ? a.in[14] : a.in[12];
            const float v = src[((size_t)(dir * 16 + n) * 96 + i) * 96 + j];
            wg[idx] = (bf16)(pk2(v, 0.f) & 0xffffu);
        }
    }
    {
        LAS float* scr = (LAS float*)(lds + wave * 16384);
        const int gw = bid * NWAVES + wave, NGW = G * NWAVES;
        constexpr int I_QKV = 16 * 48, I_O = 16 * 32, I_RIN = 16 * 96, I_ROUT = 24 * 32, I_1 = 16 * 128, I_2 = 64 * 32;
        constexpr int NITEMS = I_QKV + I_O + I_RIN + I_ROUT + 2 * I_1 + 2 * I_2;
        for (int it = gw; it < NITEMS; it += NGW) {
            int r = it;
            if (r < I_QKV) { p0_transpose_item(a.in[6], 1024, 1536, (bf16*)(ws + WS_WQKV), scr, r, lane); continue; } r -= I_QKV;
            if (r < I_O) { p0_transpose_item(a.in[7], 1024, 1024, (bf16*)(ws + WS_WO), scr, r, lane); continue; } r -= I_O;
            if (r < I_RIN) { p0_transpose_item(a.in[9], 1024, 3072, (bf16*)(ws + WS_WRIN), scr, r, lane); continue; } r -= I_RIN;
            if (r < I_ROUT) { p0_transpose_item(a.in[17], 1536, 1024, (bf16*)(ws + WS_WROUT), scr, r, lane); continue; } r -= I_ROUT;
            if (r < I_1) { p0_transpose_item(a.in[18], 1024, 4096, (bf16*)(ws + WS_W1), scr, r, lane); continue; } r -= I_1;
            if (r < I_1) { p0_transpose_item(a.in[18] + (size_t)1024 * 4096, 1024, 4096, (bf16*)(ws + WS_W1) + (size_t)4096 * 1024, scr, r, lane); continue; } r -= I_1;
            if (r < I_2) { p0_transpose_item(a.in[19], 4096, 1024, (bf16*)(ws + WS_W2), scr, r, lane); continue; } r -= I_2;
            p0_transpose_item(a.in[19] + (size_t)4096 * 1024, 4096, 1024, (bf16*)(ws + WS_W2) + (size_t)1024 * 4096, scr, r, lane);
        }
    }
}

template <bool DO_LN, bool IN_F32, bool OUT_F32> __device__ __forceinline__ void ln_mod_phase(const void* xin, void* xout, bf16* hout, const float* lng, const float* lnb, const float* mod, float* stat, int lane, int wave, int G, int bid) {
    const int gw = bid * NWAVES + wave, NGW = G * NWAVES;
    for (int row = gw; row < M; row += NGW) {
        f32x4 v[4];
#pragma unroll
        for (int j = 0; j < 2; ++j) { const size_t e = (size_t)row * DM + 512 * j + 8 * lane;
            if (IN_F32) { v[2 * j] = *(const f32x4*)((const float*)xin + e); v[2 * j + 1] = *(const f32x4*)((const float*)xin + e + 4); }
            else { const v4u w = *(const v4u*)((const bf16*)xin + e);
                v[2 * j] = (f32x4){__uint_as_float(w.x << 16), __uint_as_float(w.x & 0xffff0000u), __uint_as_float(w.y << 16), __uint_as_float(w.y & 0xffff0000u)};
                v[2 * j + 1] = (f32x4){__uint_as_float(w.z << 16), __uint_as_float(w.z & 0xffff0000u), __uint_as_float(w.w << 16), __uint_as_float(w.w & 0xffff0000u)}; } }
        if (DO_LN) {
            float s = 0.f;
#pragma unroll
            for (int j = 0; j < 4; ++j) s += (v[j].x + v[j].y) + (v[j].z + v[j].w);
            const float mean = wave_sum(s) * (1.f / DM); float s2 = 0.f;
#pragma unroll
            for (int j = 0; j < 4; ++j) { v[j] = v[j] - mean; s2 += (v[j].x * v[j].x + v[j].y * v[j].y) + (v[j].z * v[j].z + v[j].w * v[j].w); }
            const float rstd = __builtin_amdgcn_rsqf(wave_sum(s2) * (1.f / DM) + LN_EPS);
            if (stat && lane == 0) { stat[2 * row] = mean; stat[2 * row + 1] = rstd; }
#pragma unroll
            for (int j = 0; j < 4; ++j) { const int c = 512 * (j >> 1) + 8 * lane + 4 * (j & 1); const f32x4 g = *(const f32x4*)(lng + c), bb = *(const f32x4*)(lnb + c); v[j] = v[j] * rstd * g + bb; }
        }
        if (xout) {
#pragma unroll
            for (int j = 0; j < 2; ++j) { const size_t e = (size_t)row * DM + 512 * j + 8 * lane;
                if (OUT_F32) { *(f32x4*)((float*)xout + e) = v[2 * j]; *(f32x4*)((float*)xout + e + 4) = v[2 * j + 1]; }
                else { v4u w; w.x = pk2(v[2 * j].x, v[2 * j].y); w.y = pk2(v[2 * j].z, v[2 * j].w); w.z = pk2(v[2 * j + 1].x, v[2 * j + 1].y); w.w = pk2(v[2 * j + 1].z, v[2 * j + 1].w); *(v4u*)((bf16*)xout + e) = w; } } }
        if (hout) { const int b = row >> 13; const float* sh = mod + b * 3072; const float* scl = mod + b * 3072 + 1024;
#pragma unroll
            for (int j = 0; j < 2; ++j) { const int c = 512 * j + 8 * lane;
                const f32x4 h0 = v[2 * j] * (*(const f32x4*)(scl + c) + 1.0f) + *(const f32x4*)(sh + c), h1 = v[2 * j + 1] * (*(const f32x4*)(scl + c + 4) + 1.0f) + *(const f32x4*)(sh + c + 4);
                v4u w; w.x = pk2(h0.x, h0.y); w.y = pk2(h0.z, h0.w); w.z = pk2(h1.x, h1.y); w.w = pk2(h1.z, h1.w); *(v4u*)(hout + (size_t)row * DM + c) = w; } }
    }
}

__device__ __forceinline__ unsigned off_b(unsigned row, unsigned ch) { return 256u * row + 16u * (ch ^ (((row & 3) << 2) | ((row >> 2) & 3))); }
__device__ __forceinline__ s16x4 vtr(const LAS unsigned char* p) { typedef short v4i16_t __attribute__((ext_vector_type(4))); return __builtin_bit_cast(s16x4, __builtin_amdgcn_ds_read_tr16_b64_v4i16((LAS v4i16_t*)p)); }
__device__ __forceinline__ void attn_phase(LAS unsigned char* lds, const bf16* Q, const bf16* K, const bf16* V, bf16* O, const float* sinks, int tid, int lane, int wave, int G, int bid) {
    const int r32 = lane & 31, h = lane >> 5;
    const int blk = (lane >> 4) & 1, q4 = (lane & 15) >> 2, p4 = lane & 3;
    unsigned kofs[8], vofs[4][2];
    { const unsigned swzk = ((r32 & 3) << 2) | ((r32 >> 2) & 3);
#pragma unroll
      for (int s_ = 0; s_ < 8; ++s_) kofs[s_] = 256u * r32 + 16u * ((2u * s_ + h) ^ swzk);
#pragma unroll
      for (int c = 0; c < 4; ++c)
#pragma unroll
          for (int t_ = 0; t_ < 2; ++t_) { const unsigned xr = ((unsigned)q4 << 2) | ((h + 2u * t_) & 3u); vofs[c][t_] = 256u * (4u * h + q4) + 16u * ((4u * c + 2u * blk + (p4 >> 1)) ^ xr) + 8u * (p4 & 1); } }
    const int vbid = ((G & 7) == 0) ? (bid & 7) * (G >> 3) + (bid >> 3) : bid;
    for (int unit = vbid; unit < 1024; unit += G) {
        const int u = unit & 127, kvh = (unit >> 7) & 1, b = unit >> 8;
        const int head = kvh * 4 + (wave >> 1); const int qpos = 64 * u + 32 * (wave & 1) + r32;
        const size_t tokbase = (size_t)b * SEQ;
        bf16x8 qf[8];
        { const bf16* qp = Q + (tokbase + qpos) * 1024 + head * 128 + 8 * h;
#pragma unroll
          for (int s = 0; s < 8; ++s) qf[s] = *(const bf16x8*)(qp + 16 * s); }
        float mrun = sinks[head] * LOG2E; float lrun = (h == 0) ? 1.f : 0.f;
        f32x16 o[4];
#pragma unroll
        for (int c = 0; c < 4; ++c)
#pragma unroll
            for (int i = 0; i < 16; ++i) o[c][i] = 0.f;
        const int c_lo = (u < 2) ? 2 - u : 0, c_hi = (u > 125) ? 129 - u : 4;
        const int lrow0 = tid >> 4, lch = tid & 15;
        v4u kreg[2], vreg[2];
        __syncthreads();
        { const int kc = u - 2 + c_lo;
#pragma unroll
          for (int i = 0; i < 2; ++i) { const size_t g = (tokbase + 64 * kc + lrow0 + 32 * i) * 256 + kvh * 128 + lch * 8; kreg[i] = *(const v4u*)(K + g); vreg[i] = *(const v4u*)(V + g); }
#pragma unroll
          for (int i = 0; i < 2; ++i) { const unsigned ob = off_b(lrow0 + 32 * i, lch); *(LAS v4u*)(lds + ob) = kreg[i]; *(LAS v4u*)(lds + 32768 + ob) = vreg[i]; } }
        __syncthreads();
        for (int ci = c_lo; ci <= c_hi; ++ci) {
            const int buf = (ci - c_lo) & 1; const int kc = u - 2 + ci;
            const bool more = ci < c_hi;
            if (more) {
#pragma unroll
                for (int i = 0; i < 2; ++i) { const size_t g = (tokbase + 64 * (kc + 1) + lrow0 + 32 * i) * 256 + kvh * 128 + lch * 8; kreg[i] = *(const v4u*)(K + g); vreg[i] = *(const v4u*)(V + g); } }
            const LAS unsigned char* Kb = lds + buf * 16384; const LAS unsigned char* Vb = lds + 32768 + buf * 16384;
            f32x16 sa[2];
#pragma unroll
            for (int kt = 0; kt < 2; ++kt) {
#pragma unroll
                for (int i = 0; i < 16; ++i) sa[kt][i] = 0.f;
#pragma unroll
                for (int s = 0; s < 8; ++s) { const bf16x8 kf = *(const LAS bf16x8*)(Kb + kofs[s] + 8192 * kt); sa[kt] = __builtin_amdgcn_mfma_f32_32x32x16_bf16(kf, qf[s], sa[kt], 0, 0, 0); }
            }
            float mx = -INFINITY;
            if (ci == 0 || ci == 4) {
#pragma unroll
                for (int kt = 0; kt < 2; ++kt)
#pragma unroll
                    for (int i = 0; i < 16; ++i) { const int kp = 64 * kc + 32 * kt + (i & 3) + 8 * (i >> 2) + 4 * h; const int d = qpos - kp; if (d > 128 || d < -128) sa[kt][i] = -INFINITY; }
            }
#pragma unroll
            for (int kt = 0; kt < 2; ++kt)
#pragma unroll
                for (int i = 0; i < 16; ++i) mx = fmaxf(mx, sa[kt][i]);
            mx = fmaxf(mx, __shfl_xor(mx, 32));
            const bool need = __any(mx > mrun + 8.0f);
            const float mnew = need ? fmaxf(mrun, mx) : mrun; const float alpha = __builtin_amdgcn_exp2f(mrun - mnew); mrun = mnew;
            float ls = 0.f;
#pragma unroll
            for (int kt = 0; kt < 2; ++kt) {
                sa[kt] = sa[kt] - mnew;
#pragma unroll
                for (int i = 0; i < 16; ++i) sa[kt][i] = __builtin_amdgcn_exp2f(sa[kt][i]);
                f32x4 q4s = (f32x4){sa[kt][0], sa[kt][1], sa[kt][2], sa[kt][3]} + (f32x4){sa[kt][4], sa[kt][5], sa[kt][6], sa[kt][7]} + (f32x4){sa[kt][8], sa[kt][9], sa[kt][10], sa[kt][11]} + (f32x4){sa[kt][12], sa[kt][13], sa[kt][14], sa[kt][15]};
                ls += (q4s.x + q4s.y) + (q4s.z + q4s.w);
            }
            lrun = lrun * alpha + ls;
            if (need) {
#pragma unroll
                for (int c = 0; c < 4; ++c) o[c] = o[c] * alpha;
            }
#pragma unroll
            for (int kt = 0; kt < 2; ++kt)
#pragma unroll
                for (int s2 = 0; s2 < 2; ++s2) {
                    v4u pw; pw.x = pk2(sa[kt][8 * s2 + 0], sa[kt][8 * s2 + 1]); pw.y = pk2(sa[kt][8 * s2 + 2], sa[kt][8 * s2 + 3]); pw.z = pk2(sa[kt][8 * s2 + 4], sa[kt][8 * s2 + 5]); pw.w = pk2(sa[kt][8 * s2 + 6], sa[kt][8 * s2 + 7]);
                    const bf16x8 pf = __builtin_bit_cast(bf16x8, pw);
#pragma unroll
                    for (int c = 0; c < 4; ++c) {
                        const s16x4 lo = vtr(Vb + vofs[c][0] + (8192 * kt + 4096 * s2));
                        const s16x4 hi = vtr(Vb + vofs[c][1] + (8192 * kt + 4096 * s2 + 2048));
                        const bf16x8 vf = __builtin_shufflevector(lo, hi, 0, 1, 2, 3, 4, 5, 6, 7);
                        o[c] = __builtin_amdgcn_mfma_f32_32x32x16_bf16(vf, pf, o[c], 0, 0, 0);
                    }
                }
            if (more) {
#pragma unroll
                for (int i = 0; i < 2; ++i) { const unsigned ob = off_b(lrow0 + 32 * i, lch); *(LAS v4u*)(lds + (buf ^ 1) * 16384 + ob) = kreg[i]; *(LAS v4u*)(lds + 32768 + (buf ^ 1) * 16384 + ob) = vreg[i]; } }
            __syncthreads();
        }
        lrun += __shfl_xor(lrun, 32);
        const float rl = 1.0f / lrun;
        bf16* op = O + (tokbase + qpos) * 1024 + head * 128 + 4 * h;
#pragma unroll
        for (int c = 0; c < 4; ++c)
#pragma unroll
            for (int g = 0; g < 4; ++g) { v2u w; w.x = pk2(o[c][4 * g] * rl, o[c][4 * g + 1] * rl); w.y = pk2(o[c][4 * g + 2] * rl, o[c][4 * g + 3] * rl); *(v2u*)(op + 32 * c + 8 * g) = w; }
    }
}

constexpr int RL_XCB = 0, RL_XCT = 13312, RL_XRS = 27136, RL_T = 40000, RL_YO = 46144, RL_YOSZ = 26624, RL_PAR = 99392;
template <bool FINAL> __device__ __forceinline__ void rnn_phase(LAS unsigned char* lds, const bf16* XR, bf16* GG, const float* conv_w, const float* conv_b, const bf16* Wg,
        const float* b_a, const float* b_x, const float* sp8t, f32x2* agg, const float* cin, int tid, int lane, int wave, int G, int bid) {
    LAS unsigned short* XCB = (LAS unsigned short*)(lds + RL_XCB); LAS unsigned short* XCT = (LAS unsigned short*)(lds + RL_XCT); LAS unsigned short* XRS = (LAS unsigned short*)(lds + RL_XRS);
    LAS f32x2* T = (LAS f32x2*)(lds + RL_T); LAS float* YO = (LAS float*)(lds + RL_YO); LAS float* PAR = (LAS float*)(lds + RL_PAR);
    const int n = bid & 15, slot = bid >> 4, nslots = (G + 15 - n) >> 4;
    const int xr_r0 = tid / 12, xr_c0 = tid % 12, xr_r1 = (tid + 512) / 12, xr_c1 = (tid + 512) % 12; const bool xr_v1 = (tid + 512) < 67 * 12;
    const int cc = tid % 96, ctq = tid / 96; const int ccg = 96 * n + cc;
    float cw0 = 0.f, cw1 = 0.f, cw2 = 0.f, cw3 = 0.f, cbb = 0.f;
    if (tid < 384) { cw0 = conv_w[ccg]; cw1 = conv_w[DRNN + ccg]; cw2 = conv_w[2 * DRNN + ccg]; cw3 = conv_w[3 * DRNN + ccg]; cbb = conv_b[ccg]; }
    const int rtp = wave & 1, dir = wave >> 2, cth = (wave >> 1) & 1, l15 = lane & 15, l4 = lane >> 4; const bool fwd = (dir == 0);
    const bf16* wlane = Wg + ((size_t)((dir * 16 + n) * 2) * 96 + l15) * 96 + 8 * l4;
    __syncthreads();
    for (int i = tid; i < 576; i += NTHR) { const int d_ = i / 288, w_ = (i / 96) % 3, c_ = i % 96; const float* src = (w_ == 0) ? b_a : (w_ == 1) ? b_x : sp8t; PAR[i] = src[d_ * DRNN + 96 * n + c_]; }
    v4u xq0 = {0u, 0u, 0u, 0u}, xq1 = {0u, 0u, 0u, 0u};
#define RNN_LOAD_XR(pair) do { const int b_ = (pair) >> 7, ch_ = (pair) & 127; const size_t tb_ = (size_t)b_ * SEQ; const int tk0 = 64 * ch_ - 2 + xr_r0, tk1 = 64 * ch_ - 2 + xr_r1; \
        xq0 = (v4u){0u, 0u, 0u, 0u}; xq1 = xq0; \
        if (tk0 >= 0 && tk0 < SEQ) xq0 = *(const v4u*)(XR + (tb_ + tk0) * DRNN + 96 * n + 8 * xr_c0); \
        if (xr_v1 && tk1 >= 0 && tk1 < SEQ) xq1 = *(const v4u*)(XR + (tb_ + tk1) * DRNN + 96 * n + 8 * xr_c1); } while (0)
    bf16x8 wa[3][3], wx[3][3];
#pragma unroll
    for (int i = 0; i < 3; ++i)
#pragma unroll
        for (int ks = 0; ks < 3; ++ks) { wa[i][ks] = *(const bf16x8*)(wlane + (size_t)(16 * (3 * cth + i)) * 96 + 32 * ks); wx[i][ks] = *(const bf16x8*)(wlane + (size_t)(96 + 16 * (3 * cth + i)) * 96 + 32 * ks); }
    int pair = slot;
    if (pair < 512) RNN_LOAD_XR(pair);
    for (; pair < 512; pair += nslots) {
        const int b = pair >> 7, chunk = pair & 127; const size_t tokbase = (size_t)b * SEQ; const int t0 = 64 * chunk;
        *(LAS v4u*)(XRS + xr_r0 * 96 + xr_c0 * 8) = xq0; if (xr_v1) *(LAS v4u*)(XRS + xr_r1 * 96 + xr_c1 * 8) = xq1;
        __syncthreads();
        if (pair + nslots < 512) RNN_LOAD_XR(pair + nslots);
        v4u gq0 = {0u, 0u, 0u, 0u}, gq1 = gq0; float cinr[3] = {0.f, 0.f, 0.f};
        if (FINAL) {
            gq0 = *(const v4u*)(GG + (tokbase + t0 + tid / 12) * DRNN + 96 * n + 8 * (tid % 12));
            if (tid < 256) gq1 = *(const v4u*)(GG + (tokbase + t0 + (tid + 512) / 12) * DRNN + 96 * n + 8 * ((tid + 512) % 12));
#pragma unroll
            for (int i = 0; i < 3; ++i) cinr[i] = cin[((size_t)(b * 128 + chunk) * 2 + dir) * DRNN + 96 * n + 16 * (3 * cth + i) + l15];
        }
        if (tid < 384) {
            float x0 = bf2f(XRS[(16 * ctq + 0) * 96 + cc]), x1 = bf2f(XRS[(16 * ctq + 1) * 96 + cc]), x2 = bf2f(XRS[(16 * ctq + 2) * 96 + cc]);
#pragma unroll
            for (int k = 0; k < 16; ++k) { const int t = 16 * ctq + k; const float x3 = bf2f(XRS[(t + 3) * 96 + cc]);
                const float v = cbb + x0 * cw0 + x1 * cw1 + x2 * cw2 + x3 * cw3;
                const unsigned short vb = (unsigned short)(pk2(v, 0.f) & 0xffffu);
                XCB[t * 104 + cc] = vb; XCT[cc * 72 + t] = vb;
                x0 = x1; x1 = x2; x2 = x3; } }
        __syncthreads();
        float ar[6][4], ur[6][4], Ae[6], He[6];
#pragma unroll
        for (int tt = 0; tt < 2; ++tt) {
            const int rt = 2 * rtp + tt;
            bf16x8 xa[3];
#pragma unroll
            for (int ks = 0; ks < 3; ++ks) xa[ks] = *(const LAS bf16x8*)(XCB + (16 * rt + l15) * 104 + 32 * ks + 8 * l4);
#pragma unroll
            for (int i = 0; i < 3; ++i) {
                const int it = tt * 3 + i;
                f32x4 ga = {0.f, 0.f, 0.f, 0.f}, gx = {0.f, 0.f, 0.f, 0.f};
#pragma unroll
                for (int ks = 0; ks < 3; ++ks) {
                    ga = __builtin_amdgcn_mfma_f32_16x16x32_bf16(xa[ks], wa[i][ks], ga, 0, 0, 0);
                    gx = __builtin_amdgcn_mfma_f32_16x16x32_bf16(xa[ks], wx[i][ks], gx, 0, 0, 0);
                }
                const int c = 16 * (3 * cth + i) + l15;
                const float ba = PAR[dir * 288 + c], bx = PAR[dir * 288 + 96 + c], lm = PAR[dir * 288 + 192 + c];
                const v2u xcw = *(const LAS v2u*)(XCT + c * 72 + 16 * rt + 4 * l4);
                const float xc[4] = {__uint_as_float(xcw.x << 16), __uint_as_float(xcw.x & 0xffff0000u), __uint_as_float(xcw.y << 16), __uint_as_float(xcw.y & 0xffff0000u)};
#pragma unroll
                for (int p2 = 0; p2 < 2; ++p2) {
                    const f32x2 za = (f32x2){ga[2 * p2], ga[2 * p2 + 1]} + ba, zx = (f32x2){gx[2 * p2], gx[2 * p2 + 1]} + bx;
                    const f32x2 ta = za * (-1.4426950408889634f), tx = zx * (-1.4426950408889634f);
                    const f32x2 da = (f32x2){__builtin_amdgcn_exp2f(ta.x), __builtin_amdgcn_exp2f(ta.y)} + 1.0f, dx = (f32x2){__builtin_amdgcn_exp2f(tx.x), __builtin_amdgcn_exp2f(tx.y)} + 1.0f;
                    const f32x2 ra = {__builtin_amdgcn_rcpf(da.x), __builtin_amdgcn_rcpf(da.y)}, ii = {__builtin_amdgcn_rcpf(dx.x), __builtin_amdgcn_rcpf(dx.y)};
                    const f32x2 la = ra * (-lm);
                    const f32x2 tl = la * 1.4426950408889634f;
                    const f32x2 av2 = {__builtin_amdgcn_exp2f(tl.x), __builtin_amdgcn_exp2f(tl.y)};
                    const f32x2 m2 = (1.0f - av2) * (1.0f + av2);
                    const f32x2 w2 = ii * (f32x2){xc[2 * p2], xc[2 * p2 + 1]};
                    const f32x2 uu = (f32x2){__builtin_amdgcn_sqrtf(m2.x), __builtin_amdgcn_sqrtf(m2.y)} * w2;
                    ar[it][2 * p2] = av2.x; ar[it][2 * p2 + 1] = av2.y;
                    ur[it][2 * p2] = uu.x; ur[it][2 * p2 + 1] = uu.y;
                }
                float A = 1.f, H = 0.f;
#pragma unroll
                for (int k = 0; k < 4; ++k) { const int r = fwd ? k : 3 - k; H = ar[it][r] * H + ur[it][r]; A *= ar[it][r]; }
                const int p = fwd ? l4 : 3 - l4;
#pragma unroll
                for (int d = 1; d <= 2; d <<= 1) {
                    const int src = fwd ? lane - 16 * d : lane + 16 * d;
                    const float Ap = __shfl(A, src & 63), Hp = __shfl(H, src & 63);
                    if (p >= d) { H = A * Hp + H; A = Ap * A; }
                }
                { const int src = fwd ? lane - 16 : lane + 16;
                  const float Ap = __shfl(A, src & 63), Hp = __shfl(H, src & 63);
                  Ae[it] = (p >= 1) ? Ap : 1.f; He[it] = (p >= 1) ? Hp : 0.f; }
                if (p == 3) T[(dir * 4 + rt) * 96 + c] = (f32x2){A, H};
            }
        }
        __syncthreads();
        if (!FINAL) {
            if (rtp == 0 && l4 == 0) {
#pragma unroll
                for (int i = 0; i < 3; ++i) { const int c = 16 * (3 * cth + i) + l15; float A = 1.f, H = 0.f;
#pragma unroll
                    for (int k = 0; k < 4; ++k) { const f32x2 tv = T[(dir * 4 + (fwd ? k : 3 - k)) * 96 + c]; H = tv.x * H + tv.y; A *= tv.x; }
                    agg[((size_t)(b * 128 + chunk) * 2 + dir) * DRNN + 96 * n + c] = (f32x2){A, H}; }
            }
        } else {
            LAS float* YOd = YO + dir * (RL_YOSZ / 4);
#pragma unroll
            for (int tt = 0; tt < 2; ++tt) {
                const int rt = 2 * rtp + tt;
#pragma unroll
                for (int i = 0; i < 3; ++i) { const int it = tt * 3 + i; const int c = 16 * (3 * cth + i) + l15;
                    float Hc = cinr[i];
#pragma unroll
                    for (int k = 0; k < 3; ++k) { const int tq = fwd ? k : 3 - k; const bool before = fwd ? (tq < rt) : (tq > rt); const f32x2 tv = T[(dir * 4 + tq) * 96 + c]; if (before) Hc = tv.x * Hc + tv.y; }
                    float h = Ae[it] * Hc + He[it];
#pragma unroll
                    for (int k = 0; k < 4; ++k) { const int r = fwd ? k : 3 - k; h = ar[it][r] * h + ur[it][r]; YOd[(16 * rt + 4 * l4 + r) * 104 + c] = h; }
                }
            }
            __syncthreads();
#pragma unroll
            for (int it2 = 0; it2 < 2; ++it2) { const int idx = tid + 512 * it2; if (it2 == 1 && tid >= 256) break; const int t = idx / 12, ch = idx % 12;
                const v4u gv = it2 ? gq1 : gq0;
                const f32x4 f0 = *(const LAS f32x4*)(YO + t * 104 + 8 * ch), f1 = *(const LAS f32x4*)(YO + t * 104 + 8 * ch + 4);
                const f32x4 r0 = *(const LAS f32x4*)(YO + (RL_YOSZ / 4) + t * 104 + 8 * ch), r1 = *(const LAS f32x4*)(YO + (RL_YOSZ / 4) + t * 104 + 8 * ch + 4);
                const f32x4 y0 = f0 + r0, y1 = f1 + r1;
                v4u ov;
                ov.x = pk2(y0[0] * __uint_as_float(gv.x << 16), y0[1] * __uint_as_float(gv.x & 0xffff0000u));
                ov.y = pk2(y0[2] * __uint_as_float(gv.y << 16), y0[3] * __uint_as_float(gv.y & 0xffff0000u));
                ov.z = pk2(y1[0] * __uint_as_float(gv.z << 16), y1[1] * __uint_as_float(gv.z & 0xffff0000u));
                ov.w = pk2(y1[2] * __uint_as_float(gv.w << 16), y1[3] * __uint_as_float(gv.w & 0xffff0000u));
                *(v4u*)(GG + (tokbase + t0 + t) * DRNN + 96 * n + 8 * ch) = ov; }
        }
    }
#undef RNN_LOAD_XR
}
__device__ __forceinline__ void rnn_carry_phase(const f32x2* __restrict__ agg, float* __restrict__ cin, int tid, int G, int bid) {
    for (int g = bid * NTHR + tid; g < BATCH * 2 * DRNN; g += G * NTHR) {
        const int ch = g % DRNN, dir = (g / DRNN) & 1, b = g / (2 * DRNN);
        float carry = 0.f;
#pragma unroll 32
        for (int k = 0; k < 128; ++k) { const int chunk = dir ? 127 - k : k; const size_t idx = ((size_t)(b * 128 + chunk) * 2 + dir) * DRNN + ch;
            const f32x2 av = agg[idx]; cin[idx] = carry; carry = av.x * carry + av.y; }
    }
}

__global__ void __launch_bounds__(NTHR, 2) fwd_megakernel(Args args) {
    extern __shared__ __attribute__((aligned(16))) unsigned char lds_raw[];
    LAS unsigned char* lds = (LAS unsigned char*)lds_raw;
    cg::grid_group grid = cg::this_grid();
    const int tid = threadIdx.x, lane = tid & 63, wave = __builtin_amdgcn_readfirstlane(tid >> 6);
    const int G = gridDim.x, bid = blockIdx.x;
    unsigned char* ws = args.ws;
    float* MOD = (float*)(ws + WS_MOD); bf16* XB = (bf16*)(ws + WS_XB); bf16* HB = (bf16*)(ws + WS_HB);
    bf16* Qb = (bf16*)(ws + WS_Q); bf16* Kb = (bf16*)(ws + WS_K); bf16* Vb = (bf16*)(ws + WS_V); bf16* Ob = (bf16*)(ws + WS_O);
    bf16* Hbig = (bf16*)(ws + WS_BIG); bf16* XR = (bf16*)(ws + WS_XR); bf16* GG = (bf16*)(ws + WS_GG);
    const float* ln_g = args.in[4]; const float* ln_b = args.in[5];
    using namespace pg8;

    volatile LAS unsigned* MISC = (volatile LAS unsigned*)(lds + LDS_BYTES - 64);
    if (tid < 2) MISC[tid] = 0u;
    if (bid == 0) { for (int i = tid; i < XCD_BAR_WORDS; i += NTHR) ((unsigned*)(ws + WS_BAR))[i] = 0u; }
    __syncthreads();
    p0_prologue(args, lds, tid, lane, wave, G, bid);
    grid.sync();
    (void)xcd_barrier_post((unsigned*)(ws + WS_BAR), MISC);
#define GRID_BAR() do { XcdBarrier b_; b_.bar = (unsigned*)(args.ws + WS_BAR); b_.x = xb_xcc_id(); b_.st = (volatile LAS unsigned*)(lds + LDS_BYTES - 64); xcd_barrier(b_); } while (0)
    ln_mod_phase<false, true, false>(args.in[0], nullptr, HB, nullptr, nullptr, MOD + 0 * 12288, nullptr, lane, wave, G, bid);
    GRID_BAR();
    { Gemm g{HB, (const bf16_t*)(ws + WS_WQKV), M, NQKV, DM}; StaticOrder S; S.init(M, NQKV, G, bid);
      EpiQKV E{Qb, Kb, Vb, (const float*)(ws + WS_CS), 0.08838834764831845f * LOG2E};
      gemm_phase<EpiQKV, StaticOrder, true, true>(lds, g, S, E); }
    GRID_BAR();
    attn_phase(lds, Qb, Kb, Vb, Ob, args.in[8], tid, lane, wave, G, bid);
    GRID_BAR();
    { Gemm g{Ob, (const bf16_t*)(ws + WS_WO), M, DM, DM}; StaticOrder S; S.init(M, DM, G, bid);
      EpiRes<true> E{ws, args.in[0], ln_g, ln_b, 0};
      gemm_phase<EpiRes<true>, StaticOrder, true, true>(lds, g, S, E); }
    GRID_BAR();
    ln_mod_phase<true, false, false>(XB, nullptr, HB, ln_g + 0 * 1024, ln_b + 0 * 1024, MOD + 1 * 12288, (float*)(ws + WS_STAT), lane, wave, G, bid);
    GRID_BAR();
    { Gemm g{HB, (const bf16_t*)(ws + WS_W1), M, DFF, DM}; StaticOrder S; S.init(M, DFF, G, bid);
      EpiAct<0> E{Hbig, nullptr, DFF};
      gemm_phase<EpiAct<0>, StaticOrder, true, true>(lds, g, S, E); }
    GRID_BAR();
    { Gemm g{Hbig, (const bf16_t*)(ws + WS_W2), M, DM, DFF}; StaticOrder S; S.init(M, DM, G, bid);
      EpiRes<false> E{ws, nullptr, ln_g, ln_b, 1};
      gemm_phase<EpiRes<false>, StaticOrder, true, true>(lds, g, S, E); }
    GRID_BAR();
    ln_mod_phase<true, false, false>(XB, nullptr, HB, ln_g + 1 * 1024, ln_b + 1 * 1024, MOD + 2 * 12288, (float*)(ws + WS_STAT), lane, wave, G, bid);
    GRID_BAR();
    { Gemm g{HB, (const bf16_t*)(ws + WS_WRIN), M, 2 * DRNN, DM}; StaticOrder S; S.init(M, 2 * DRNN, G, bid);
      EpiAct<1> E{XR, GG, DRNN};
      gemm_phase<EpiAct<1>, StaticOrder, true, true>(lds, g, S, E); }
    GRID_BAR();
    rnn_phase<false>(lds, XR, GG, args.in[10], args.in[11], (const bf16*)(ws + WS_WG), args.in[13], args.in[15], (const float*)(ws + WS_SP8), (f32x2*)(ws + WS_AGG), (const float*)(ws + WS_CIN), tid, lane, wave, G, bid);
    GRID_BAR();
    rnn_carry_phase((const f32x2*)(ws + WS_AGG), (float*)(ws + WS_CIN), tid, G, bid);
    GRID_BAR();
    rnn_phase<true>(lds, XR, GG, args.in[10], args.in[11], (const bf16*)(ws + WS_WG), args.in[13], args.in[15], (const float*)(ws + WS_SP8), (f32x2*)(ws + WS_AGG), (const float*)(ws + WS_CIN), tid, lane, wave, G, bid);
    GRID_BAR();
    { Gemm g{GG, (const bf16_t*)(ws + WS_WROUT), M, DM, DRNN}; StaticOrder S; S.init(M, DM, G, bid);
      EpiRes<false> E{ws, nullptr, ln_g, ln_b, 2};
      gemm_phase<EpiRes<false>, StaticOrder, true, true>(lds, g, S, E); }
    GRID_BAR();
    ln_mod_phase<true, false, false>(XB, nullptr, HB, ln_g + 2 * 1024, ln_b + 2 * 1024, MOD + 3 * 12288, (float*)(ws + WS_STAT), lane, wave, G, bid);
    GRID_BAR();
    { Gemm g{HB, (const bf16_t*)(ws + WS_W1) + (size_t)DFF * DM, M, DFF, DM}; StaticOrder S; S.init(M, DFF, G, bid);
      EpiAct<0> E{Hbig, nullptr, DFF};
      gemm_phase<EpiAct<0>, StaticOrder, true, true>(lds, g, S, E); }
    GRID_BAR();
    { Gemm g{Hbig, (const bf16_t*)(ws + WS_W2) + (size_t)DM * DFF, M, DM, DFF}; StaticOrder S; S.init(M, DM, G, bid);
      EpiRes<false> E{ws, nullptr, ln_g, ln_b, 3};
      gemm_phase<EpiRes<false>, StaticOrder, true, true>(lds, g, S, E); }
    GRID_BAR();
    ln_mod_phase<true, false, true>(XB, args.out, nullptr, ln_g + 3 * 1024, ln_b + 3 * 1024, nullptr, nullptr, lane, wave, G, bid);
}

extern "C" void kernel_launch(void* const* d_in, const int* in_sizes, int n_in, void* d_out, int out_size, void* d_ws, size_t ws_size, hipStream_t stream) {
    static int grid = 0;
    if (grid == 0) {
        if (n_in != 20 || out_size != M * DM || ws_size < WS_END) { fprintf(stderr, "kernel_launch: unexpected problem (n_in %d, out %d, ws %zu)\n", n_in, out_size, ws_size); grid = -1; return; }
        int dev = 0, cus = 0, per_cu = 0;
        (void)hipGetDevice(&dev); (void)hipDeviceGetAttribute(&cus, hipDeviceAttributeMultiprocessorCount, dev);
        if (hipFuncSetAttribute((const void*)fwd_megakernel, hipFuncAttributeMaxDynamicSharedMemorySize, LDS_BYTES) != hipSuccess) { fprintf(stderr, "kernel_launch: hipFuncSetAttribute failed\n"); grid = -1; return; }
        if (hipOccupancyMaxActiveBlocksPerMultiprocessor(&per_cu, (const void*)fwd_megakernel, NTHR, LDS_BYTES) != hipSuccess || per_cu < 1) { fprintf(stderr, "kernel_launch: occupancy query gave %d\n", per_cu); per_cu = 1; }
        (void)hipGetLastError();
        grid = cus * 1;
    }
    if (grid < 0) return;
    Args a{};
    for (int i = 0; i < 20; ++i) a.in[i] = (const float*)d_in[i];
    a.out = (float*)d_out; a.ws = (unsigned char*)d_ws;
    void* kargs[] = {&a};
    hipError_t e = hipLaunchCooperativeKernel((const void*)fwd_megakernel, dim3(grid), dim3(NTHR), kargs, LDS_BYTES, stream);
    if (e != hipSuccess) fprintf(stderr, "cooperative launch failed: %s (grid %d)\n", hipGetErrorString(e), grid);
}
```

```cpp
#include <hip/hip_runtime.h>
#include <hip/hip_cooperative_groups.h>
#include <cstdio>
#include <cstdint>
namespace cg = cooperative_groups;
constexpr int NWAVES = 8, NTHR = 512;
constexpr int BATCH = 4, SEQ = 8192, DM = 1024, M = BATCH * SEQ, DFF = 4096, DRNN = 1536, NQKV = 1536;
constexpr float LN_EPS = 1e-5f, DN_ALPHA = 1.4142135623730951f, LOG2E = 1.4426950408889634f;
constexpr int LDS_BYTES = 147456;
constexpr size_t MiB = 1u << 20;
constexpr size_t WS_MOD = 0;
constexpr size_t WS_BAR = 768 * 1024;
constexpr size_t WS_STAT = 256 * 1024;
constexpr size_t WS_SP8 = 512 * 1024;
constexpr size_t WS_CS = 1 * MiB;
constexpr size_t WS_WG = 2 * MiB;
constexpr size_t WS_WQKV = 4 * MiB;
constexpr size_t WS_WO = 7 * MiB;
constexpr size_t WS_WRIN = 9 * MiB;
constexpr size_t WS_WROUT = 15 * MiB;
constexpr size_t WS_W1 = 18 * MiB;
constexpr size_t WS_W2 = 34 * MiB;
constexpr size_t WS_XB = 50 * MiB;
constexpr size_t WS_HB = 178 * MiB;
constexpr size_t WS_BIG = 242 * MiB;
constexpr size_t WS_Q = WS_BIG, WS_K = WS_BIG + 64 * MiB, WS_V = WS_BIG + 80 * MiB, WS_O = WS_BIG + 96 * MiB;
constexpr size_t WS_XR = WS_BIG, WS_GG = WS_BIG + 96 * MiB;
constexpr size_t WS_AGG = WS_BIG + 192 * MiB;
constexpr size_t WS_CIN = WS_BIG + 208 * MiB;
constexpr size_t WS_END = WS_BIG + 256 * MiB;

namespace pg8 {
#define PG8_LAS __attribute__((address_space(3)))
typedef unsigned short bf16_t;
typedef short bf16x8 __attribute__((ext_vector_type(8)));
typedef float f32x4 __attribute__((ext_vector_type(4)));
typedef unsigned u32x4 __attribute__((ext_vector_type(4)));
constexpr int BM = 256, BK = 64, HALF = 128, HTB = HALF * BK * 2  , STAGE_BYTES = 8 * HTB, NXCD = 8, WGM = 4;

__host__ __device__ __forceinline__ int lds_byte(int r, int c) { const int st = (r >> 4) * 2 + (c >> 5), rr = r & 15, cc = c & 31, ob = rr * 64 + cc * 2; return st * 1024 + (ob ^ (((ob >> 9) & 1) << 5)); }
__host__ __device__ __forceinline__ void stage_rc(int b, int& R, int& C) { const int st = b / 1024, sb = b % 1024, swz = sb ^ (((sb >> 9) & 1) << 5); R = (st >> 1) * 16 + swz / 64; C = (st & 1) * 32 + (swz % 64) / 2; }
__host__ __device__ __forceinline__ int perm32(int rho) { const int n = rho >> 4, i = rho & 15; return 8 * (i >> 2) + 4 * n + (i & 3); }

struct Unit { int pm, pn; };
struct Gemm { const bf16_t* A; const bf16_t* Bt; int M, N, K; };

struct StaticOrder {
    int nM, nN, nwg, G, c;
    __host__ __device__ void init(int M, int N, int G_, int c_) { nM = M / BM; nN = N / BM; nwg = nM * nN; G = G_; c = c_; }
    __host__ __device__ bool next(int i, Unit& u) const {
        const long L = (long)i * G + c; if (L >= nwg) return false;
        int wgid = (int)L; { const int q = nwg / NXCD, r = nwg % NXCD, xcd = wgid % NXCD, off = wgid / NXCD; wgid = (xcd < r ? xcd * (q + 1) : r * (q + 1) + (xcd - r) * q) + off; }
        const int nig = WGM * nN, gid = wgid / nig, fm = gid * WGM, gsz = (nM - fm) < WGM ? (nM - fm) : WGM;
        u.pm = fm + ((wgid % nig) % gsz); u.pn = (wgid % nig) / gsz; return true;
    }
    __device__ __forceinline__ void a_ready(const Unit&) const {}
    __device__ __forceinline__ void done(const Unit&) const {}
};

__device__ __forceinline__ unsigned cvt_pk_bf16(float lo, float hi) { unsigned r; asm volatile("v_cvt_pk_bf16_f32 %0, %1, %2" : "=v"(r) : "v"(lo), "v"(hi)); return r; }
__device__ __forceinline__ u32x4 pack8(const f32x4 v0, const f32x4 v1) { u32x4 w; w.x = cvt_pk_bf16(v0[0], v0[1]); w.y = cvt_pk_bf16(v0[2], v0[3]); w.z = cvt_pk_bf16(v1[0], v1[1]); w.w = cvt_pk_bf16(v1[2], v1[3]); return w; }
struct EpiQKV {
    static constexpr bool PERM = true, AFTER_DRAIN = false;
    bf16_t* Q; bf16_t* K; bf16_t* V; const float* cs; float qscale;
    __device__ __forceinline__ void operator()(const f32x4 (&acc)[2][2][4][2], const Unit& u, int wr, int wc, int fr, int fq) const {
        const int row0 = u.pm * BM + wr * 64 + fr;
        bf16_t* base; int ld, colt; float sc = 1.f; bool rope = true;
        if (u.pn < 4) { base = Q; ld = 1024; colt = u.pn * BM; sc = qscale; }
        else if (u.pn == 4) { base = K; ld = 256; colt = 0; }
        else { base = V; ld = 256; colt = 0; rope = false; }
        const int col0 = colt + wc * 32 + 8 * fq;
        const bool dorope = rope && (wc == 0);
#pragma unroll
        for (int ai = 0; ai < 2; ++ai)
#pragma unroll
            for (int m = 0; m < 4; ++m) {
                const int row = row0 + ai * HALF + m * 16; const int pos = row & 8191;
                f32x4 c0 = {1.f, 1.f, 1.f, 1.f}, c1 = c0, s0 = {0.f, 0.f, 0.f, 0.f}, s1 = s0;
                if (dorope) { const float* t = cs + (size_t)pos * 32 + 8 * (fq & 1); c0 = *(const f32x4*)t; c1 = *(const f32x4*)(t + 4); s0 = *(const f32x4*)(t + 16); s1 = *(const f32x4*)(t + 20);
                    if (fq < 2) { s0 = -s0; s1 = -s1; } }
#pragma unroll
                for (int bj = 0; bj < 2; ++bj) {
                    f32x4 v0 = acc[ai][bj][m][0], v1 = acc[ai][bj][m][1];
                    if (dorope) { f32x4 p0, p1;
#pragma unroll
                        for (int j = 0; j < 4; ++j) { p0[j] = __shfl_xor(v0[j], 32); p1[j] = __shfl_xor(v1[j], 32); }
                        v0 = v0 * c0 + p0 * s0; v1 = v1 * c1 + p1 * s1; }
                    v0 = v0 * sc; v1 = v1 * sc;
                    *(u32x4*)(base + (size_t)row * ld + col0 + bj * HALF) = pack8(v0, v1);
                }
            }
    }
};
template <bool XF32> struct EpiRes {
    static constexpr bool PERM = true, AFTER_DRAIN = false;
    unsigned char* ws; const float* xin; const float* lng_all; const float* lnb_all; int k;
    __device__ __forceinline__ void operator()(const f32x4 (&acc)[2][2][4][2], const Unit& u, int wr, int wc, int fr, int fq) const {
        const int row0 = u.pm * BM + wr * 64 + fr, col0 = u.pn * BM + wc * 32 + 8 * fq;
        const int b = (u.pm * BM) >> 13;
        const void* xres = XF32 ? (const void*)xin : (const void*)(ws + WS_XB); bf16_t* out = (bf16_t*)(ws + WS_XB); constexpr float alpha = DN_ALPHA;
        const float* gate = (const float*)(ws + WS_MOD) + k * 12288 + 2048; const float* stat = (const float*)(ws + WS_STAT);
        const float* lng = lng_all + (k - 1) * 1024; const float* lnb = lnb_all + (k - 1) * 1024;
#pragma unroll
        for (int bj = 0; bj < 2; ++bj) {
            const f32x4 g0 = *(const f32x4*)(gate + b * 3072 + col0 + bj * HALF) + 1.0f, g1 = *(const f32x4*)(gate + b * 3072 + col0 + bj * HALF + 4) + 1.0f;
            f32x4 G0, G1, B0, B1;
            if (!XF32) { G0 = *(const f32x4*)(lng + col0 + bj * HALF); G1 = *(const f32x4*)(lng + col0 + bj * HALF + 4); B0 = *(const f32x4*)(lnb + col0 + bj * HALF); B1 = *(const f32x4*)(lnb + col0 + bj * HALF + 4); }
            typedef float f32x2e __attribute__((ext_vector_type(2)));
#pragma unroll
            for (int ai = 0; ai < 2; ++ai) {
                u32x4 xw[4]; f32x2e srs[4];
                if (!XF32) {
#pragma unroll
                    for (int m = 0; m < 4; ++m) { const int r_ = row0 + ai * HALF + m * 16; xw[m] = *(const u32x4*)((const bf16_t*)xres + (size_t)r_ * 1024 + col0 + bj * HALF); srs[m] = *(const f32x2e*)(stat + 2 * r_); }
                    asm volatile("" ::: "memory");
                }
#pragma unroll
                for (int m = 0; m < 4; ++m) { const size_t off = (size_t)(row0 + ai * HALF + m * 16) * 1024 + col0 + bj * HALF;
                    f32x4 x0, x1;
                    if (XF32) { x0 = *(const f32x4*)((const float*)xres + off); x1 = *(const f32x4*)((const float*)xres + off + 4); }
                    else { const u32x4 w = xw[m]; const f32x2e sr = srs[m];
                        x0 = (f32x4){__uint_as_float(w.x << 16), __uint_as_float(w.x & 0xffff0000u), __uint_as_float(w.y << 16), __uint_as_float(w.y & 0xffff0000u)};
                        x1 = (f32x4){__uint_as_float(w.z << 16), __uint_as_float(w.z & 0xffff0000u), __uint_as_float(w.w << 16), __uint_as_float(w.w & 0xffff0000u)};
                        x0 = (x0 - sr.x) * sr.y * G0 + B0; x1 = (x1 - sr.x) * sr.y * G1 + B1; }
                    *(u32x4*)(out + off) = pack8(x0 * alpha + g0 * acc[ai][bj][m][0], x1 * alpha + g1 * acc[ai][bj][m][1]);
                    if (XF32 && (m & 1)) asm volatile("" ::: "memory"); }
                asm volatile("" ::: "memory");
            }
        }
    }
};
__device__ __forceinline__ float gelu_tanh(float x) { const float t = x * x * 0.044715f + 1.0f; const float e = __builtin_amdgcn_exp2f(-2.302208198f * (x * t)); return x * __builtin_amdgcn_rcpf(1.0f + e); }
template <int MODE> struct EpiAct {
    static constexpr bool PERM = true, AFTER_DRAIN = false;
    bf16_t* O; bf16_t* O2; int ldc;
    __device__ __forceinline__ void operator()(const f32x4 (&acc)[2][2][4][2], const Unit& u, int wr, int wc, int fr, int fq) const {
        const int row0 = u.pm * BM + wr * 64 + fr; int colt = u.pn * BM; bf16_t* base = O; bool act = (MODE == 0);
        if (MODE == 1 && u.pn >= 6) { base = O2; colt -= 1536; act = true; }
        const int col0 = colt + wc * 32 + 8 * fq;
#pragma unroll
        for (int ai = 0; ai < 2; ++ai)
#pragma unroll
            for (int m = 0; m < 4; ++m) { bf16_t* rowp = base + (size_t)(row0 + ai * HALF + m * 16) * ldc + col0;
#pragma unroll
                for (int bj = 0; bj < 2; ++bj) { f32x4 v0 = acc[ai][bj][m][0], v1 = acc[ai][bj][m][1];
                    if (act) {
#pragma unroll
                        for (int j = 0; j < 4; ++j) {
                            if (MODE == 0) { const float a = fmaxf(v0[j], 0.f), b = fmaxf(v1[j], 0.f); v0[j] = a * a; v1[j] = b * b; }
                            else { v0[j] = gelu_tanh(v0[j]); v1[j] = gelu_tanh(v1[j]); } } }
                    *(u32x4*)(rowp + bj * HALF) = pack8(v0, v1); } }
    }
};
template <class Epi, class Sched, bool ALIGN_EPI = false, bool SP2 = false>
__device__ __forceinline__ void gemm_phase(PG8_LAS unsigned char* lds, const Gemm g, const Sched& S, const Epi& E) {
    int tid_ = threadIdx.x; asm volatile("" : "+v"(tid_));
    const int tid = tid_, wid = __builtin_amdgcn_readfirstlane(tid >> 6), lane = tid & 63, wr = wid >> 2, wc = wid & 3, fr = lane & 15, fq = lane >> 4;
    const int K = g.K, nt = K / BK;
    unsigned voffA[2], voffB[2];
#pragma unroll
    for (int i = 0; i < 2; ++i) { int R, C; stage_rc(tid * 16 + i * 8192, R, C); const int Rb = Epi::PERM ? ((R & ~31) + perm32(R & 31)) : R;
        voffA[i] = (unsigned)(R * K + C) * 2u; voffB[i] = (unsigned)(Rb * K + C) * 2u; }
    const size_t kstep = (size_t)(BK * 2);
    const size_t hstep = (size_t)HALF * K * 2;
    const size_t tstep = 2 * hstep;
    const unsigned ldsw = (unsigned)wid * 1024u;
    const int aoff = lds_byte(wr * 64 + fr, fq * 8), boff = lds_byte(wc * 32 + fr, fq * 8);
#define PG8_SA(b, h) (((b) * 2 + (h)) * HTB)
#define PG8_SB(b, h) ((4 + (b) * 2 + (h)) * HTB)
#define PG8_STAGE(bufoff, gbase, voff) do { _Pragma("unroll") for (int _i = 0; _i < 2; ++_i) \
        __builtin_amdgcn_global_load_lds((const unsigned*)((const char*)(gbase) + (voff)[_i]), (PG8_LAS unsigned*)(lds + (bufoff) + ldsw + _i * 8192), 16, 0, 0); } while (0)
#define PG8_LDA(dst, b, h) do { _Pragma("unroll") for (int m = 0; m < 4; ++m) _Pragma("unroll") for (int k = 0; k < 2; ++k) dst[m][k] = *(const PG8_LAS bf16x8*)(lds + PG8_SA(b, h) + aoff + m * 2048 + k * 1024); } while (0)
#define PG8_LDB(dst, b, h) do { _Pragma("unroll") for (int n = 0; n < 2; ++n) _Pragma("unroll") for (int k = 0; k < 2; ++k) dst[n][k] = *(const PG8_LAS bf16x8*)(lds + PG8_SB(b, h) + boff + n * 2048 + k * 1024); } while (0)
#define PG8_MMA(ai, bj, At, Bt) do { __builtin_amdgcn_s_setprio(1); _Pragma("unroll") for (int m = 0; m < 4; ++m) _Pragma("unroll") for (int n = 0; n < 2; ++n) _Pragma("unroll") for (int k = 0; k < 2; ++k) \
        acc[ai][bj][m][n] = __builtin_amdgcn_mfma_f32_16x16x32_bf16(Bt[n][k], At[m][k], acc[ai][bj][m][n], 0, 0, 0); __builtin_amdgcn_s_setprio(0); } while (0)
#define PG8_WAIT_V(n) asm volatile("s_waitcnt vmcnt(" #n ")" ::: "memory")
#define PG8_WAIT_L(n) asm volatile("s_waitcnt lgkmcnt(" #n ")" ::: "memory")
#define PG8_BAR __builtin_amdgcn_s_barrier()
#define PG8_SCHED __builtin_amdgcn_sched_barrier(0)
    Unit cur, nxt; int ui = 0;
    if (!S.next(0, cur)) return;
    f32x4 acc[2][2][4][2];
#pragma unroll
    for (int a = 0; a < 2; ++a)
#pragma unroll
        for (int b = 0; b < 2; ++b)
#pragma unroll
            for (int m = 0; m < 4; ++m)
#pragma unroll
                for (int n = 0; n < 2; ++n) acc[a][b][m][n] = (f32x4){0.f, 0.f, 0.f, 0.f};
    bf16x8 At[4][2], B0[2][2], B1[2][2];
    const char* cA = (const char*)g.A + (size_t)cur.pm * tstep; const char* cB = (const char*)g.Bt + (size_t)cur.pn * tstep;
    S.a_ready(cur);
    if constexpr (SP2) {
        PG8_STAGE(PG8_SB(0, 0), cB, voffB); PG8_STAGE(PG8_SB(0, 1), cB + hstep, voffB); PG8_STAGE(PG8_SA(0, 0), cA, voffA); PG8_STAGE(PG8_SA(0, 1), cA + hstep, voffA);
        if (wr == 1) PG8_BAR;
        PG8_WAIT_V(2); PG8_BAR;
        PG8_STAGE(PG8_SB(1, 0), cB + kstep, voffB); PG8_STAGE(PG8_SA(1, 0), cA + kstep, voffA); PG8_STAGE(PG8_SB(1, 1), cB + hstep + kstep, voffB);
        PG8_WAIT_V(6); PG8_BAR;
    } else {
        PG8_STAGE(PG8_SB(0, 0), cB, voffB); PG8_STAGE(PG8_SA(0, 0), cA, voffA); PG8_STAGE(PG8_SB(0, 1), cB + hstep, voffB); PG8_STAGE(PG8_SA(0, 1), cA + hstep, voffA);
        if (wr == 1) PG8_BAR;
        PG8_WAIT_V(4); PG8_BAR;
        PG8_STAGE(PG8_SB(1, 0), cB + kstep, voffB); PG8_STAGE(PG8_SA(1, 0), cA + kstep, voffA); PG8_STAGE(PG8_SB(1, 1), cB + hstep + kstep, voffB);
        PG8_WAIT_V(6); PG8_BAR;
    }
    for (;;) {
        const bool has_next = S.next(ui + 1, nxt);
        const char* nA = has_next ? (const char*)g.A + (size_t)nxt.pm * tstep : cA; const char* nB = has_next ? (const char*)g.Bt + (size_t)nxt.pn * tstep : cB;
        asm volatile(".p2align 8");
        for (int t = 0; t < nt; t += 2) {
            const bool last = (t == nt - 2);
            const char* a1 = cA + (size_t)(t + 1) * kstep;
            const char* a2 = last ? nA : cA + (size_t)(t + 2) * kstep; const char* b2 = last ? nB : cB + (size_t)(t + 2) * kstep;
            const char* a3 = a2 + kstep; const char* b3 = b2 + kstep;
            if (last && has_next) S.a_ready(nxt);
            if constexpr (SP2) {
            PG8_LDB(B0, 0, 0); PG8_LDB(B1, 0, 1); PG8_SCHED; PG8_LDA(At, 0, 0); PG8_STAGE(PG8_SA(1, 1), a1 + hstep, voffA);
            PG8_WAIT_V(8); PG8_WAIT_L(0); PG8_BAR; PG8_MMA(0, 0, At, B0); PG8_MMA(0, 1, At, B1); PG8_BAR; PG8_SCHED;
            PG8_LDA(At, 0, 1); PG8_STAGE(PG8_SB(0, 0), b2, voffB); PG8_STAGE(PG8_SB(0, 1), b2 + hstep, voffB); PG8_STAGE(PG8_SA(0, 0), a2, voffA);
            PG8_WAIT_V(8); PG8_WAIT_L(0); PG8_BAR; PG8_MMA(1, 0, At, B0); PG8_MMA(1, 1, At, B1); PG8_BAR; PG8_SCHED;
            PG8_LDB(B0, 1, 0); PG8_LDB(B1, 1, 1); PG8_SCHED; PG8_LDA(At, 1, 0); PG8_STAGE(PG8_SA(0, 1), a2 + hstep, voffA);
            PG8_WAIT_V(8); PG8_WAIT_L(0); PG8_BAR; PG8_MMA(0, 0, At, B0); PG8_MMA(0, 1, At, B1); PG8_BAR; PG8_SCHED;
            PG8_LDA(At, 1, 1); PG8_STAGE(PG8_SB(1, 0), b3, voffB); PG8_STAGE(PG8_SB(1, 1), b3 + hstep, voffB); PG8_STAGE(PG8_SA(1, 0), a3, voffA);
            PG8_WAIT_V(8); PG8_WAIT_L(0); PG8_BAR; PG8_MMA(1, 0, At, B0); PG8_MMA(1, 1, At, B1); PG8_BAR; PG8_SCHED;
            } else {
            PG8_LDB(B0, 0, 0); PG8_SCHED; PG8_LDA(At, 0, 0); PG8_STAGE(PG8_SA(1, 1), a1 + hstep, voffA);
            PG8_WAIT_L(8); PG8_BAR; PG8_WAIT_L(0); PG8_MMA(0, 0, At, B0); PG8_BAR; PG8_SCHED;
            PG8_LDB(B1, 0, 1); PG8_STAGE(PG8_SB(0, 0), b2, voffB);
            PG8_BAR; PG8_WAIT_L(0); PG8_MMA(0, 1, At, B1); PG8_BAR;
            PG8_LDA(At, 0, 1); PG8_STAGE(PG8_SA(0, 0), a2, voffA);
            PG8_BAR; PG8_WAIT_L(0); PG8_MMA(1, 0, At, B0); PG8_BAR; PG8_SCHED;
            PG8_STAGE(PG8_SB(0, 1), b2 + hstep, voffB);
            PG8_WAIT_V(6); PG8_BAR; PG8_MMA(1, 1, At, B1); PG8_BAR;
            PG8_LDB(B0, 1, 0); PG8_SCHED; PG8_LDA(At, 1, 0); PG8_STAGE(PG8_SA(0, 1), a2 + hstep, voffA);
            PG8_WAIT_L(8); PG8_BAR; PG8_WAIT_L(0); PG8_MMA(0, 0, At, B0); PG8_BAR; PG8_SCHED;
            PG8_LDB(B1, 1, 1); PG8_STAGE(PG8_SB(1, 0), b3, voffB);
            PG8_BAR; PG8_WAIT_L(0); PG8_MMA(0, 1, At, B1); PG8_BAR;
            PG8_LDA(At, 1, 1); PG8_STAGE(PG8_SA(1, 0), a3, voffA);
            PG8_BAR; PG8_WAIT_L(0); PG8_MMA(1, 0, At, B0); PG8_BAR; PG8_SCHED;
            PG8_STAGE(PG8_SB(1, 1), b3 + hstep, voffB);
            PG8_WAIT_V(6); PG8_BAR; PG8_MMA(1, 1, At, B1); PG8_BAR;
            }
        }
        if constexpr (ALIGN_EPI) { if (wr == 0) PG8_BAR; }
        if constexpr (!Epi::AFTER_DRAIN) { E(acc, cur, wr, wc, fr, fq); S.done(cur); }
        if (!has_next) break;
#pragma unroll
        for (int a = 0; a < 2; ++a)
#pragma unroll
            for (int b = 0; b < 2; ++b)
#pragma unroll
                for (int m = 0; m < 4; ++m)
#pragma unroll
                    for (int n = 0; n < 2; ++n) acc[a][b][m][n] = (f32x4){0.f, 0.f, 0.f, 0.f};
        cur = nxt; cA = nA; cB = nB; ++ui;
        if constexpr (ALIGN_EPI) { if (wr == 1) PG8_BAR; }
    }
    PG8_WAIT_V(0);
    if constexpr (!ALIGN_EPI) { if (wr == 0) PG8_BAR; }
    PG8_BAR;
    if constexpr (Epi::AFTER_DRAIN) { E.fused(acc, cur, wr, wc, fr, fq, lds, wid, lane); S.done(cur); }
#undef PG8_SA
#undef PG8_SB
#undef PG8_STAGE
#undef PG8_LDA
#undef PG8_LDB
#undef PG8_MMA
#undef PG8_WAIT_V
#undef PG8_WAIT_L
#undef PG8_BAR
#undef PG8_SCHED
}
}

#define LAS __attribute__((address_space(3)))
typedef unsigned short bf16;
typedef unsigned v4u __attribute__((ext_vector_type(4)));
typedef unsigned v2u __attribute__((ext_vector_type(2)));
typedef float f32x4 __attribute__((ext_vector_type(4)));
typedef float f32x2 __attribute__((ext_vector_type(2)));
typedef float f32x16 __attribute__((ext_vector_type(16)));
typedef short bf16x8 __attribute__((ext_vector_type(8)));
typedef short s16x4 __attribute__((ext_vector_type(4)));
typedef __bf16 bf16x2_t __attribute__((ext_vector_type(2)));
__device__ __forceinline__ unsigned pk2(float lo, float hi) { f32x2 v = {lo, hi}; bf16x2_t b = __builtin_convertvector(v, bf16x2_t); return __builtin_bit_cast(unsigned, b); }
__device__ __forceinline__ float bf2f(unsigned short h) { return __uint_as_float((unsigned)h << 16); }
__device__ __forceinline__ float wave_sum(float v) {
#pragma unroll
    for (int o = 1; o < 64; o <<= 1) v += __shfl_xor(v, o);
    return v;
}
__device__ __forceinline__ float sigmoidf_(float x) { return __builtin_amdgcn_rcpf(1.0f + __builtin_amdgcn_exp2f(-1.4426950408889634f * x)); }

struct Args { const float* in[20]; float* out; unsigned char* ws; };


#define GAS __attribute__((address_space(1)))
#define XB_TMO      128
#define XB_XCNT(j)  (256  + 64 * (j))
#define XB_XSUB(j)  (1280 + 64 * (j))
#define XB_XGEN(j)  (2304 + 64 * (j))
#define XB_TOP      3328
#define XB_TOPGEN   3392
#define XCD_BAR_WORDS 3456
#define XB_SPIN_CAP (1u << 18)

__device__ __forceinline__ unsigned xb_ld(unsigned* p)              { return __hip_atomic_load(p, __ATOMIC_RELAXED, __HIP_MEMORY_SCOPE_AGENT); }
__device__ __forceinline__ unsigned xb_add(unsigned* p, unsigned v) { return __hip_atomic_fetch_add(p, v, __ATOMIC_RELAXED, __HIP_MEMORY_SCOPE_AGENT); }
__device__ __forceinline__ unsigned xb_xcc_id() { return (unsigned)__builtin_amdgcn_s_getreg((3 << 11) | 20) & 0xFu; }
#define XB_SPIN(cond, bar) do { unsigned _sp = 0; while (cond) { __builtin_amdgcn_s_sleep(1); \
    if ((++_sp & 255u) == 0u) { if (xb_ld(&(bar)[XB_TMO])) break; if (_sp > XB_SPIN_CAP) { atomicAdd(&(bar)[XB_TMO], 1u); break; } } } } while (0)

struct XcdBarrier {
    unsigned* bar; unsigned x;
    volatile LAS unsigned* st;
};

__device__ __forceinline__ XcdBarrier xcd_barrier_post(unsigned* bar, volatile LAS unsigned* st) {
    XcdBarrier b; b.bar = bar; b.x = xb_xcc_id(); b.st = st;
    if (threadIdx.x == 0) (void)xb_add(&bar[XB_XCNT(b.x)], 1u);
    return b;
}
__device__ __forceinline__ void xcd_barrier_complete(unsigned* bar, unsigned x, unsigned& nloc, unsigned& nx) {
    const unsigned G = gridDim.x * gridDim.y * gridDim.z;
    unsigned sum, cnt, mine, sp = 0u;
    for (;;) {
        sum = 0u; cnt = 0u; mine = 0u;
#pragma unroll
        for (unsigned j = 0; j < 16; ++j) { const unsigned c = xb_ld(&bar[XB_XCNT(j)]); sum += c; cnt += (c > 0u) ? 1u : 0u; mine = (j == x) ? c : mine; }
        if (sum == G) break;
        __builtin_amdgcn_s_sleep(1);
        if ((++sp & 255u) == 0u) { if (xb_ld(&bar[XB_TMO])) break; if (sp > XB_SPIN_CAP) { atomicAdd(&bar[XB_TMO], 1u); break; } }
    }
    nloc = mine > 0u ? mine : 1u; nx = cnt > 0u ? cnt : 1u;
}

__device__ __forceinline__ void xcd_barrier(const XcdBarrier& b) {
    asm volatile("s_waitcnt vmcnt(0)" ::: "memory");
    __syncthreads();
    if (threadIdx.x == 0) {
        unsigned* bar = b.bar;
        __builtin_amdgcn_s_waitcnt(0);
        unsigned nloc = b.st[0], nx = b.st[1];
        if (nloc == 0u) { xcd_barrier_complete(bar, b.x, nloc, nx); b.st[0] = nloc; b.st[1] = nx; }
        const unsigned old = xb_add(&bar[XB_XSUB(b.x)], 1u);
        const unsigned gen = old / nloc;
        if (old + 1u == (gen + 1u) * nloc) {
            __builtin_amdgcn_fence(__ATOMIC_RELEASE, "agent");
            asm volatile("s_waitcnt vmcnt(0)" ::: "memory");
            const unsigned og = xb_add(&bar[XB_TOP], 1u);
            const unsigned tg = og / nx;
            if (og + 1u == (tg + 1u) * nx) xb_add(&bar[XB_TOPGEN], 1u);
            else XB_SPIN(xb_ld(&bar[XB_TOPGEN]) == tg, bar);
            __builtin_amdgcn_fence(__ATOMIC_ACQUIRE, "agent");
            xb_add(&bar[XB_XGEN(b.x)], 1u);
            asm volatile("s_waitcnt vmcnt(0)" ::: "memory");
        } else {
            XB_SPIN(xb_ld(&bar[XB_XGEN(b.x)]) == gen, bar);
            __builtin_amdgcn_fence(__ATOMIC_ACQUIRE, "agent");
            asm volatile("s_waitcnt vmcnt(0)" ::: "memory");
        }
    }
    __syncthreads();
}

__device__ __forceinline__ void p0_transpose_item(const float* W, int K, int N, bf16* WT, LAS float* scr, int item, int lane) {
    const int nblk = N / 32, kb = item / nblk, nb = item % nblk, k0 = 64 * kb, n0 = 32 * nb;
    float wv_[32];
#pragma unroll
    for (int i = 0; i < 32; ++i) wv_[i] = W[(size_t)(k0 + 2 * i + (lane >> 5)) * N + n0 + (lane & 31)];
#pragma unroll
    for (int i = 0; i < 32; ++i) scr[(2 * i + (lane >> 5)) * 33 + (lane & 31)] = wv_[i];
    asm volatile("s_waitcnt lgkmcnt(0)" ::: "memory");
    const int c = lane & 7;
#pragma unroll
    for (int j = 0; j < 4; ++j) { const int n = (lane >> 3) + 8 * j; const LAS float* s = scr + (8 * c) * 33 + n;
        v4u o; o.x = pk2(s[0 * 33], s[1 * 33]); o.y = pk2(s[2 * 33], s[3 * 33]); o.z = pk2(s[4 * 33], s[5 * 33]); o.w = pk2(s[6 * 33], s[7 * 33]);
        *(v4u*)(WT + (size_t)(n0 + n) * K + k0 + 8 * c) = o; }
    asm volatile("s_waitcnt lgkmcnt(0)" ::: "memory");
}

__device__ __forceinline__ void p0_prologue(const Args& a, LAS unsigned char* lds, int tid, int lane, int wave, int G, int bid) {
    unsigned char* ws = a.ws;
    {
        LAS float* sc = (LAS float*)lds;
        LAS float* red = (LAS float*)(lds + 16384);
        const float* c = a.in[1];
        for (int i = tid; i < 4096; i += NTHR) { const float v = c[i]; sc[i] = v / (1.0f + __expf(-v)); }
        __syncthreads();
        for (int item = bid; item < 192; item += G) {
            const int s = item / 48, n0 = (item % 48) * 64;
            const float* w = a.in[2] + (size_t)s * 1024 * 3072 + n0 + lane;
            float acc0 = 0.f, acc1 = 0.f, acc2 = 0.f, acc3 = 0.f;
            const int kbeg = wave * 128;
#pragma unroll 16
            for (int k = 0; k < 128; ++k) { const float wv = w[(size_t)(kbeg + k) * 3072];
                acc0 += wv * sc[kbeg + k]; acc1 += wv * sc[1024 + kbeg + k]; acc2 += wv * sc[2048 + kbeg + k]; acc3 += wv * sc[3072 + kbeg + k]; }
            red[(wave * 4 + 0) * 64 + lane] = acc0; red[(wave * 4 + 1) * 64 + lane] = acc1; red[(wave * 4 + 2) * 64 + lane] = acc2; red[(wave * 4 + 3) * 64 + lane] = acc3;
            __syncthreads();
            if (tid < 256) { const int b = tid >> 6, l = tid & 63; float t = a.in[3][s * 3072 + n0 + l];
#pragma unroll
                for (int wv = 0; wv < 8; ++wv) t += red[(wv * 4 + b) * 64 + l];
                ((float*)(ws + WS_MOD))[(s * 4 + b) * 3072 + n0 + l] = t; }
            __syncthreads();
        }
    }
    __syncthreads();
    {
        const float invf[16] = {1.000000000e+00f, 4.403665960e-01f, 1.939227432e-01f, 8.539710194e-02f, 3.760603070e-02f, 1.656043902e-02f, 7.292664610e-03f, 3.211445874e-03f,
                                1.414213562e-03f, 6.227723788e-04f, 2.742481884e-04f, 1.207697351e-04f, 5.318296098e-05f, 2.341999971e-05f, 1.031338616e-05f, 4.541670478e-06f};
        float* cs = (float*)(ws + WS_CS);
        for (int idx = bid * NTHR + tid; idx < 8192 * 16; idx += G * NTHR) {
            const int pos = idx >> 4, i = idx & 15;
            float f = invf[0];
#pragma unroll
            for (int q = 1; q < 16; ++q) f = (i == q) ? invf[q] : f;
            const float ang = (float)pos * f;
            double t = (double)ang * 0.15915494309189535; t -= __builtin_rint(t);
            const float r = (float)t;
            cs[pos * 32 + i] = __builtin_amdgcn_cosf(r); cs[pos * 32 + 16 + i] = __builtin_amdgcn_sinf(r);
        }
    }
    { float* sp8 = (float*)(ws + WS_SP8); for (int idx = bid * NTHR + tid; idx < 2 * DRNN; idx += G * NTHR) sp8[idx] = 8.0f * log1pf(__expf(-a.in[16][idx])); }
    {
        bf16* wg = (bf16*)(ws + WS_WG);
        for (int idx = bid * NTHR + tid; idx < 2 * 16 * 2 * 96 * 96; idx += G * NTHR) {
            const int i = idx % 96, j = (idx / 96) % 96, gate = (idx / 9216) & 1, n = (idx / 18432) & 15, dir = idx / 294912;
            const float* src = gate ? a.in[14] : a.in[12];
            const float v = src[((size_t)(dir * 16 + n) * 96 + i) * 96 + j];
            wg[idx] = (bf16)(pk2(v, 0.f) & 0xffffu);
        }
    }
    {
        LAS float* scr = (LAS float*)(lds + wave * 16384);
        const int gw = bid * NWAVES + wave, NGW = G * NWAVES;
        constexpr int I_QKV = 16 * 48, I_O = 16 * 32, I_RIN = 16 * 96, I_ROUT = 24 * 32, I_1 = 16 * 128, I_2 = 64 * 32;
        constexpr int NITEMS = I_QKV + I_O + I_RIN + I_ROUT + 2 * I_1 + 2 * I_2;
        for (int it = gw; it < NITEMS; it += NGW) {
            int r = it;
            if (r < I_QKV) { p0_transpose_item(a.in[6], 1024, 1536, (bf16*)(ws + WS_WQKV), scr, r, lane); continue; } r -= I_QKV;
            if (r < I_O) { p0_transpose_item(a.in[7], 1024, 1024, (bf16*)(ws + WS_WO), scr, r, lane); continue; } r -= I_O;
            if (r < I_RIN) { p0_transpose_item(a.in[9], 1024, 3072, (bf16*)(ws + WS_WRIN), scr, r, lane); continue; } r -= I_RIN;
            if (r < I_ROUT) { p0_transpose_item(a.in[17], 1536, 1024, (bf16*)(ws + WS_WROUT), scr, r, lane); continue; } r -= I_ROUT;
            if (r < I_1) { p0_transpose_item(a.in[18], 1024, 4096, (bf16*)(ws + WS_W1), scr, r, lane); continue; } r -= I_1;
            if (r < I_1) { p0_transpose_item(a.in[18] + (size_t)1024 * 4096, 1024, 4096, (bf16*)(ws + WS_W1) + (size_t)4096 * 1024, scr, r, lane); continue; } r -= I_1;
            if (r < I_2) { p0_transpose_item(a.in[19], 4096, 1024, (bf16*)(ws + WS_W2), scr, r, lane); continue; } r -= I_2;
            p0_transpose_item(a.in[19] + (size_t)4096 * 1024, 4096, 1024, (bf16*)(ws + WS_W2) + (size_t)1024 * 4096, scr, r, lane);
        }
    }
}

template <bool DO_LN, bool IN_F32, bool OUT_F32> __device__ __forceinline__ void ln_mod_phase(const void* xin, void* xout, bf16* hout, const float* lng, const float* lnb, const float* mod, float* stat, int lane, int wave, int G, int bid) {
    const int gw = bid * NWAVES + wave, NGW = G * NWAVES;
    for (int row = gw; row < M; row += NGW) {
        f32x4 v[4];
#pragma unroll
        for (int j = 0; j < 2; ++j) { const size_t e = (size_t)row * DM + 512 * j + 8 * lane;
            if (IN_F32) { v[2 * j] = *(const f32x4*)((const float*)xin + e); v[2 * j + 1] = *(const f32x4*)((const float*)xin + e + 4); }
            else { const v4u w = *(const v4u*)((const bf16*)xin + e);
                v[2 * j] = (f32x4){__uint_as_float(w.x << 16), __uint_as_float(w.x & 0xffff0000u), __uint_as_float(w.y << 16), __uint_as_float(w.y & 0xffff0000u)};
                v[2 * j + 1] = (f32x4){__uint_as_float(w.z << 16), __uint_as_float(w.z & 0xffff0000u), __uint_as_float(w.w << 16), __uint_as_float(w.w & 0xffff0000u)}; } }
        if (DO_LN) {
            float s = 0.f;
#pragma unroll
            for (int j = 0; j < 4; ++j) s += (v[j].x + v[j].y) + (v[j].z + v[j].w);
            const float mean = wave_sum(s) * (1.f / DM); float s2 = 0.f;
#pragma unroll
            for (int j = 0; j < 4; ++j) { v[j] = v[j] - mean; s2 += (v[j].x * v[j].x + v[j].y * v[j].y) + (v[j].z * v[j].z + v[j].w * v[j].w); }
            const float rstd = __builtin_amdgcn_rsqf(wave_sum(s2) * (1.f / DM) + LN_EPS);
            if (stat && lane == 0) { stat[2 * row] = mean; stat[2 * row + 1] = rstd; }
#pragma unroll
            for (int j = 0; j < 4; ++j) { const int c = 512 * (j >> 1) + 8 * lane + 4 * (j & 1); const f32x4 g = *(const f32x4*)(lng + c), bb = *(const f32x4*)(lnb + c); v[j] = v[j] * rstd * g + bb; }
        }
        if (xout) {
#pragma unroll
            for (int j = 0; j < 2; ++j) { const size_t e = (size_t)row * DM + 512 * j + 8 * lane;
                if (OUT_F32) { *(f32x4*)((float*)xout + e) = v[2 * j]; *(f32x4*)((float*)xout + e + 4) = v[2 * j + 1]; }
                else { v4u w; w.x = pk2(v[2 * j].x, v[2 * j].y); w.y = pk2(v[2 * j].z, v[2 * j].w); w.z = pk2(v[2 * j + 1].x, v[2 * j + 1].y); w.w = pk2(v[2 * j + 1].z, v[2 * j + 1].w); *(v4u*)((bf16*)xout + e) = w; } } }
        if (hout) { const int b = row >> 13; const float* sh = mod + b * 3072; const float* scl = mod + b * 3072 + 1024;
#pragma unroll
            for (int j = 0; j < 2; ++j) { const int c = 512 * j + 8 * lane;
                const f32x4 h0 = v[2 * j] * (*(const f32x4*)(scl + c) + 1.0f) + *(const f32x4*)(sh + c), h1 = v[2 * j + 1] * (*(const f32x4*)(scl + c + 4) + 1.0f) + *(const f32x4*)(sh + c + 4);
                v4u w; w.x = pk2(h0.x, h0.y); w.y = pk2(h0.z, h0.w); w.z = pk2(h1.x, h1.y); w.w = pk2(h1.z, h1.w); *(v4u*)(hout + (size_t)row * DM + c) = w; } }
    }
}

__device__ __forceinline__ unsigned off_b(unsigned row, unsigned ch) { return 256u * row + 16u * (ch ^ (((row & 3) << 2) | ((row >> 2) & 3))); }
__device__ __forceinline__ s16x4 vtr(const LAS unsigned char* p) { typedef short v4i16_t __attribute__((ext_vector_type(4))); return __builtin_bit_cast(s16x4, __builtin_amdgcn_ds_read_tr16_b64_v4i16((LAS v4i16_t*)p)); }
__device__ __forceinline__ void attn_phase(LAS unsigned char* lds, const bf16* Q, const bf16* K, const bf16* V, bf16* O, const float* sinks, int tid, int lane, int wave, int G, int bid) {
    const int r32 = lane & 31, h = lane >> 5;
    const int blk = (lane >> 4) & 1, q4 = (lane & 15) >> 2, p4 = lane & 3;
    unsigned kofs[8], vofs[4][2];
    { const unsigned swzk = ((r32 & 3) << 2) | ((r32 >> 2) & 3);
#pragma unroll
      for (int s_ = 0; s_ < 8; ++s_) kofs[s_] = 256u * r32 + 16u * ((2u * s_ + h) ^ swzk);
#pragma unroll
      for (int c = 0; c < 4; ++c)
#pragma unroll
          for (int t_ = 0; t_ < 2; ++t_) { const unsigned xr = ((unsigned)q4 << 2) | ((h + 2u * t_) & 3u); vofs[c][t_] = 256u * (4u * h + q4) + 16u * ((4u * c + 2u * blk + (p4 >> 1)) ^ xr) + 8u * (p4 & 1); } }
    const int vbid = ((G & 7) == 0) ? (bid & 7) * (G >> 3) + (bid >> 3) : bid;
    for (int unit = vbid; unit < 1024; unit += G) {
        const int u = unit & 127, kvh = (unit >> 7) & 1, b = unit >> 8;
        const int head = kvh * 4 + (wave >> 1); const int qpos = 64 * u + 32 * (wave & 1) + r32;
        const size_t tokbase = (size_t)b * SEQ;
        bf16x8 qf[8];
        { const bf16* qp = Q + (tokbase + qpos) * 1024 + head * 128 + 8 * h;
#pragma unroll
          for (int s = 0; s < 8; ++s) qf[s] = *(const bf16x8*)(qp + 16 * s); }
        float mrun = sinks[head] * LOG2E; float lrun = (h == 0) ? 1.f : 0.f;
        f32x16 o[4];
#pragma unroll
        for (int c = 0; c < 4; ++c)
#pragma unroll
            for (int i = 0; i < 16; ++i) o[c][i] = 0.f;
        const int c_lo = (u < 2) ? 2 - u : 0, c_hi = (u > 125) ? 129 - u : 4;
        const int lrow0 = tid >> 4, lch = tid & 15;
        v4u kreg[2], vreg[2];
        __syncthreads();
        { const int kc = u - 2 + c_lo;
#pragma unroll
          for (int i = 0; i < 2; ++i) { const size_t g = (tokbase + 64 * kc + lrow0 + 32 * i) * 256 + kvh * 128 + lch * 8; kreg[i] = *(const v4u*)(K + g); vreg[i] = *(const v4u*)(V + g); }
#pragma unroll
          for (int i = 0; i < 2; ++i) { const unsigned ob = off_b(lrow0 + 32 * i, lch); *(LAS v4u*)(lds + ob) = kreg[i]; *(LAS v4u*)(lds + 32768 + ob) = vreg[i]; } }
        __syncthreads();
        for (int ci = c_lo; ci <= c_hi; ++ci) {
            const int buf = (ci - c_lo) & 1; const int kc = u - 2 + ci;
            const bool more = ci < c_hi;
            if (more) {
#pragma unroll
                for (int i = 0; i < 2; ++i) { const size_t g = (tokbase + 64 * (kc + 1) + lrow0 + 32 * i) * 256 + kvh * 128 + lch * 8; kreg[i] = *(const v4u*)(K + g); vreg[i] = *(const v4u*)(V + g); } }
            const LAS unsigned char* Kb = lds + buf * 16384; const LAS unsigned char* Vb = lds + 32768 + buf * 16384;
            f32x16 sa[2];
#pragma unroll
            for (int kt = 0; kt < 2; ++kt) {
#pragma unroll
                for (int i = 0; i < 16; ++i) sa[kt][i] = 0.f;
#pragma unroll
                for (int s = 0; s < 8; ++s) { const bf16x8 kf = *(const LAS bf16x8*)(Kb + kofs[s] + 8192 * kt); sa[kt] = __builtin_amdgcn_mfma_f32_32x32x16_bf16(kf, qf[s], sa[kt], 0, 0, 0); }
            }
            float mx = -INFINITY;
            if (ci == 0 || ci == 4) {
#pragma unroll
                for (int kt = 0; kt < 2; ++kt)
#pragma unroll
                    for (int i = 0; i < 16; ++i) { const int kp = 64 * kc + 32 * kt + (i & 3) + 8 * (i >> 2) + 4 * h; const int d = qpos - kp; if (d > 128 || d < -128) sa[kt][i] = -INFINITY; }
            }
#pragma unroll
            for (int kt = 0; kt < 2; ++kt)
#pragma unroll
                for (int i = 0; i < 16; ++i) mx = fmaxf(mx, sa[kt][i]);
            mx = fmaxf(mx, __shfl_xor(mx, 32));
            const bool need = __any(mx > mrun + 8.0f);
            const float mnew = need ? fmaxf(mrun, mx) : mrun; const float alpha = __builtin_amdgcn_exp2f(mrun - mnew); mrun = mnew;
            float ls = 0.f;
#pragma unroll
            for (int kt = 0; kt < 2; ++kt) {
                sa[kt] = sa[kt] - mnew;
#pragma unroll
                for (int i = 0; i < 16; ++i) sa[kt][i] = __builtin_amdgcn_exp2f(sa[kt][i]);
                f32x4 q4s = (f32x4){sa[kt][0], sa[kt][1], sa[kt][2], sa[kt][3]} + (f32x4){sa[kt][4], sa[kt][5], sa[kt][6], sa[kt][7]} + (f32x4){sa[kt][8], sa[kt][9], sa[kt][10], sa[kt][11]} + (f32x4){sa[kt][12], sa[kt][13], sa[kt][14], sa[kt][15]};
                ls += (q4s.x + q4s.y) + (q4s.z + q4s.w);
            }
            lrun = lrun * alpha + ls;
            if (need) {
#pragma unroll
                for (int c = 0; c < 4; ++c) o[c] = o[c] * alpha;
            }
#pragma unroll
            for (int kt = 0; kt < 2; ++kt)
#pragma unroll
                for (int s2 = 0; s2 < 2; ++s2) {
                    v4u pw; pw.x = pk2(sa[kt][8 * s2 + 0], sa[kt][8 * s2 + 1]); pw.y = pk2(sa[kt][8 * s2 + 2], sa[kt][8 * s2 + 3]); pw.z = pk2(sa[kt][8 * s2 + 4], sa[kt][8 * s2 + 5]); pw.w = pk2(sa[kt][8 * s2 + 6], sa[kt][8 * s2 + 7]);
                    const bf16x8 pf = __builtin_bit_cast(bf16x8, pw);
#pragma unroll
                    for (int c = 0; c < 4; ++c) {
                        const s16x4 lo = vtr(Vb + vofs[c][0] + (8192 * kt + 4096 * s2));
                        const s16x4 hi = vtr(Vb + vofs[c][1] + (8192 * kt + 4096 * s2 + 2048));
                        const bf16x8 vf = __builtin_shufflevector(lo, hi, 0, 1, 2, 3, 4, 5, 6, 7);
                        o[c] = __builtin_amdgcn_mfma_f32_32x32x16_bf16(vf, pf, o[c], 0, 0, 0);
                    }
                }
            if (more) {
#pragma unroll
                for (int i = 0; i < 2; ++i) { const unsigned ob = off_b(lrow0 + 32 * i, lch); *(LAS v4u*)(lds + (buf ^ 1) * 16384 + ob) = kreg[i]; *(LAS v4u*)(lds + 32768 + (buf ^ 1) * 16384 + ob) = vreg[i]; } }
            __syncthreads();
        }
        lrun += __shfl_xor(lrun, 32);
        const float rl = 1.0f / lrun;
        bf16* op = O + (tokbase + qpos) * 1024 + head * 128 + 4 * h;
#pragma unroll
        for (int c = 0; c < 4; ++c)
#pragma unroll
            for (int g = 0; g < 4; ++g) { v2u w; w.x = pk2(o[c][4 * g] * rl, o[c][4 * g + 1] * rl); w.y = pk2(o[c][4 * g + 2] * rl, o[c][4 * g + 3] * rl); *(v2u*)(op + 32 * c + 8 * g) = w; }
    }
}

constexpr int RL_XCB = 0, RL_XCT = 13312, RL_XRS = 27136, RL_T = 40000, RL_YO = 46144, RL_YOSZ = 26624, RL_PAR = 99392;
template <bool FINAL> __device__ __forceinline__ void rnn_phase(LAS unsigned char* lds, const bf16* XR, bf16* GG, const float* conv_w, const float* conv_b, const bf16* Wg,
        const float* b_a, const float* b_x, const float* sp8t, f32x2* agg, const float* cin, int tid, int lane, int wave, int G, int bid) {
    LAS unsigned short* XCB = (LAS unsigned short*)(lds + RL_XCB); LAS unsigned short* XCT = (LAS unsigned short*)(lds + RL_XCT); LAS unsigned short* XRS = (LAS unsigned short*)(lds + RL_XRS);
    LAS f32x2* T = (LAS f32x2*)(lds + RL_T); LAS float* YO = (LAS float*)(lds + RL_YO); LAS float* PAR = (LAS float*)(lds + RL_PAR);
    const int n = bid & 15, slot = bid >> 4, nslots = (G + 15 - n) >> 4;
    const int xr_r0 = tid / 12, xr_c0 = tid % 12, xr_r1 = (tid + 512) / 12, xr_c1 = (tid + 512) % 12; const bool xr_v1 = (tid + 512) < 67 * 12;
    const int cc = tid % 96, ctq = tid / 96; const int ccg = 96 * n + cc;
    float cw0 = 0.f, cw1 = 0.f, cw2 = 0.f, cw3 = 0.f, cbb = 0.f;
    if (tid < 384) { cw0 = conv_w[ccg]; cw1 = conv_w[DRNN + ccg]; cw2 = conv_w[2 * DRNN + ccg]; cw3 = conv_w[3 * DRNN + ccg]; cbb = conv_b[ccg]; }
    const int rtp = wave & 1, dir = wave >> 2, cth = (wave >> 1) & 1, l15 = lane & 15, l4 = lane >> 4; const bool fwd = (dir == 0);
    const bf16* wlane = Wg + ((size_t)((dir * 16 + n) * 2) * 96 + l15) * 96 + 8 * l4;
    __syncthreads();
    for (int i = tid; i < 576; i += NTHR) { const int d_ = i / 288, w_ = (i / 96) % 3, c_ = i % 96; const float* src = (w_ == 0) ? b_a : (w_ == 1) ? b_x : sp8t; PAR[i] = src[d_ * DRNN + 96 * n + c_]; }
    v4u xq0 = {0u, 0u, 0u, 0u}, xq1 = {0u, 0u, 0u, 0u};
#define RNN_LOAD_XR(pair) do { const int b_ = (pair) >> 7, ch_ = (pair) & 127; const size_t tb_ = (size_t)b_ * SEQ; const int tk0 = 64 * ch_ - 2 + xr_r0, tk1 = 64 * ch_ - 2 + xr_r1; \
        xq0 = (v4u){0u, 0u, 0u, 0u}; xq1 = xq0; \
        if (tk0 >= 0 && tk0 < SEQ) xq0 = *(const v4u*)(XR + (tb_ + tk0) * DRNN + 96 * n + 8 * xr_c0); \
        if (xr_v1 && tk1 >= 0 && tk1 < SEQ) xq1 = *(const v4u*)(XR + (tb_ + tk1) * DRNN + 96 * n + 8 * xr_c1); } while (0)
    bf16x8 wa[3][3], wx[3][3];
#pragma unroll
    for (int i = 0; i < 3; ++i)
#pragma unroll
        for (int ks = 0; ks < 3; ++ks) { wa[i][ks] = *(const bf16x8*)(wlane + (size_t)(16 * (3 * cth + i)) * 96 + 32 * ks); wx[i][ks] = *(const bf16x8*)(wlane + (size_t)(96 + 16 * (3 * cth + i)) * 96 + 32 * ks); }
    int pair = slot;
    if (pair < 512) RNN_LOAD_XR(pair);
    for (; pair < 512; pair += nslots) {
        const int b = pair >> 7, chunk = pair & 127; const size_t tokbase = (size_t)b * SEQ; const int t0 = 64 * chunk;
        *(LAS v4u*)(XRS + xr_r0 * 96 + xr_c0 * 8) = xq0; if (xr_v1) *(LAS v4u*)(XRS + xr_r1 * 96 + xr_c1 * 8) = xq1;
        __syncthreads();
        if (pair + nslots < 512) RNN_LOAD_XR(pair + nslots);
        v4u gq0 = {0u, 0u, 0u, 0u}, gq1 = gq0; float cinr[3] = {0.f, 0.f, 0.f};
        if (FINAL) {
            gq0 = *(const v4u*)(GG + (tokbase + t0 + tid / 12) * DRNN + 96 * n + 8 * (tid % 12));
            if (tid < 256) gq1 = *(const v4u*)(GG + (tokbase + t0 + (tid + 512) / 12) * DRNN + 96 * n + 8 * ((tid + 512) % 12));
#pragma unroll
            for (int i = 0; i < 3; ++i) cinr[i] = cin[((size_t)(b * 128 + chunk) * 2 + dir) * DRNN + 96 * n + 16 * (3 * cth + i) + l15];
        }
        if (tid < 384) {
            float x0 = bf2f(XRS[(16 * ctq + 0) * 96 + cc]), x1 = bf2f(XRS[(16 * ctq + 1) * 96 + cc]), x2 = bf2f(XRS[(16 * ctq + 2) * 96 + cc]);
#pragma unroll
            for (int k = 0; k < 16; ++k) { const int t = 16 * ctq + k; const float x3 = bf2f(XRS[(t + 3) * 96 + cc]);
                const float v = cbb + x0 * cw0 + x1 * cw1 + x2 * cw2 + x3 * cw3;
                const unsigned short vb = (unsigned short)(pk2(v, 0.f) & 0xffffu);
                XCB[t * 104 + cc] = vb; XCT[cc * 72 + t] = vb;
                x0 = x1; x1 = x2; x2 = x3; } }
        __syncthreads();
        float ar[6][4], ur[6][4], Ae[6], He[6];
#pragma unroll
        for (int tt = 0; tt < 2; ++tt) {
            const int rt = 2 * rtp + tt;
            bf16x8 xa[3];
#pragma unroll
            for (int ks = 0; ks < 3; ++ks) xa[ks] = *(const LAS bf16x8*)(XCB + (16 * rt + l15) * 104 + 32 * ks + 8 * l4);
#pragma unroll
            for (int i = 0; i < 3; ++i) {
                const int it = tt * 3 + i;
                f32x4 ga = {0.f, 0.f, 0.f, 0.f}, gx = {0.f, 0.f, 0.f, 0.f};
#pragma unroll
                for (int ks = 0; ks < 3; ++ks) {
                    ga = __builtin_amdgcn_mfma_f32_16x16x32_bf16(xa[ks], wa[i][ks], ga, 0, 0, 0);
                    gx = __builtin_amdgcn_mfma_f32_16x16x32_bf16(xa[ks], wx[i][ks], gx, 0, 0, 0);
                }
                const int c = 16 * (3 * cth + i) + l15;
                const float ba = PAR[dir * 288 + c], bx = PAR[dir * 288 + 96 + c], lm = PAR[dir * 288 + 192 + c];
                const v2u xcw = *(const LAS v2u*)(XCT + c * 72 + 16 * rt + 4 * l4);
                const float xc[4] = {__uint_as_float(xcw.x << 16), __uint_as_float(xcw.x & 0xffff0000u), __uint_as_float(xcw.y << 16), __uint_as_float(xcw.y & 0xffff0000u)};
#pragma unroll
                for (int p2 = 0; p2 < 2; ++p2) {
                    const f32x2 za = (f32x2){ga[2 * p2], ga[2 * p2 + 1]} + ba, zx = (f32x2){gx[2 * p2], gx[2 * p2 + 1]} + bx;
                    const f32x2 ta = za * (-1.4426950408889634f), tx = zx * (-1.4426950408889634f);
                    const f32x2 da = (f32x2){__builtin_amdgcn_exp2f(ta.x), __builtin_amdgcn_exp2f(ta.y)} + 1.0f, dx = (f32x2){__builtin_amdgcn_exp2f(tx.x), __builtin_amdgcn_exp2f(tx.y)} + 1.0f;
                    const f32x2 ra = {__builtin_amdgcn_rcpf(da.x), __builtin_amdgcn_rcpf(da.y)}, ii = {__builtin_amdgcn_rcpf(dx.x), __builtin_amdgcn_rcpf(dx.y)};
                    const f32x2 la = ra * (-lm);
                    const f32x2 tl = la * 1.4426950408889634f;
                    const f32x2 av2 = {__builtin_amdgcn_exp2f(tl.x), __builtin_amdgcn_exp2f(tl.y)};
                    const f32x2 m2 = (1.0f - av2) * (1.0f + av2);
                    const f32x2 w2 = ii * (f32x2){xc[2 * p2], xc[2 * p2 + 1]};
                    const f32x2 uu = (f32x2){__builtin_amdgcn_sqrtf(m2.x), __builtin_amdgcn_sqrtf(m2.y)} * w2;
                    ar[it][2 * p2] = av2.x; ar[it][2 * p2 + 1] = av2.y;
                    ur[it][2 * p2] = uu.x; ur[it][2 * p2 + 1] = uu.y;
                }
                float A = 1.f, H = 0.f;
#pragma unroll
                for (int k = 0; k < 4; ++k) { const int r = fwd ? k : 3 - k; H = ar[it][r] * H + ur[it][r]; A *= ar[it][r]; }
                const int p = fwd ? l4 : 3 - l4;
#pragma unroll
                for (int d = 1; d <= 2; d <<= 1) {
                    const int src = fwd ? lane - 16 * d : lane + 16 * d;
                    const float Ap = __shfl(A, src & 63), Hp = __shfl(H, src & 63);
                    if (p >= d) { H = A * Hp + H; A = Ap * A; }
                }
                { const int src = fwd ? lane - 16 : lane + 16;
                  const float Ap = __shfl(A, src & 63), Hp = __shfl(H, src & 63);
                  Ae[it] = (p >= 1) ? Ap : 1.f; He[it] = (p >= 1) ? Hp : 0.f; }
                if (p == 3) T[(dir * 4 + rt) * 96 + c] = (f32x2){A, H};
            }
        }
        __syncthreads();
        if (!FINAL) {
            if (rtp == 0 && l4 == 0) {
#pragma unroll
                for (int i = 0; i < 3; ++i) { const int c = 16 * (3 * cth + i) + l15; float A = 1.f, H = 0.f;
#pragma unroll
                    for (int k = 0; k < 4; ++k) { const f32x2 tv = T[(dir * 4 + (fwd ? k : 3 - k)) * 96 + c]; H = tv.x * H + tv.y; A *= tv.x; }
                    agg[((size_t)(b * 128 + chunk) * 2 + dir) * DRNN + 96 * n + c] = (f32x2){A, H}; }
            }
        } else {
            LAS float* YOd = YO + dir * (RL_YOSZ / 4);
#pragma unroll
            for (int tt = 0; tt < 2; ++tt) {
                const int rt = 2 * rtp + tt;
#pragma unroll
                for (int i = 0; i < 3; ++i) { const int it = tt * 3 + i; const int c = 16 * (3 * cth + i) + l15;
                    float Hc = cinr[i];
#pragma unroll
                    for (int k = 0; k < 3; ++k) { const int tq = fwd ? k : 3 - k; const bool before = fwd ? (tq < rt) : (tq > rt); const f32x2 tv = T[(dir * 4 + tq) * 96 + c]; if (before) Hc = tv.x * Hc + tv.y; }
                    float h = Ae[it] * Hc + He[it];
#pragma unroll
                    for (int k = 0; k < 4; ++k) { const int r = fwd ? k : 3 - k; h = ar[it][r] * h + ur[it][r]; YOd[(16 * rt + 4 * l4 + r) * 104 + c] = h; }
                }
            }
            __syncthreads();
#pragma unroll
            for (int it2 = 0; it2 < 2; ++it2) { const int idx = tid + 512 * it2; if (it2 == 1 && tid >= 256) break; const int t = idx / 12, ch = idx % 12;
                const v4u gv = it2 ? gq1 : gq0;
                const f32x4 f0 = *(const LAS f32x4*)(YO + t * 104 + 8 * ch), f1 = *(const LAS f32x4*)(YO + t * 104 + 8 * ch + 4);
                const f32x4 r0 = *(const LAS f32x4*)(YO + (RL_YOSZ / 4) + t * 104 + 8 * ch), r1 = *(const LAS f32x4*)(YO + (RL_YOSZ / 4) + t * 104 + 8 * ch + 4);
                const f32x4 y0 = f0 + r0, y1 = f1 + r1;
                v4u ov;
                ov.x = pk2(y0[0] * __uint_as_float(gv.x << 16), y0[1] * __uint_as_float(gv.x & 0xffff0000u));
                ov.y = pk2(y0[2] * __uint_as_float(gv.y << 16), y0[3] * __uint_as_float(gv.y & 0xffff0000u));
                ov.z = pk2(y1[0] * __uint_as_float(gv.z << 16), y1[1] * __uint_as_float(gv.z & 0xffff0000u));
                ov.w = pk2(y1[2] * __uint_as_float(gv.w << 16), y1[3] * __uint_as_float(gv.w & 0xffff0000u));
                *(v4u*)(GG + (tokbase + t0 + t) * DRNN + 96 * n + 8 * ch) = ov; }
        }
    }
#undef RNN_LOAD_XR
}
__device__ __forceinline__ void rnn_carry_phase(const f32x2* agg, float* cin, int tid, int G, int bid) {
    for (int g = bid * NTHR + tid; g < BATCH * 2 * DRNN; g += G * NTHR) {
        const int ch = g % DRNN, dir = (g / DRNN) & 1, b = g / (2 * DRNN);
        float carry = 0.f;
#pragma unroll 8
        for (int k = 0; k < 128; ++k) { const int chunk = dir ? 127 - k : k; const size_t idx = ((size_t)(b * 128 + chunk) * 2 + dir) * DRNN + ch;
            const f32x2 av = agg[idx]; cin[idx] = carry; carry = av.x * carry + av.y; }
    }
}

__global__ void __launch_bounds__(NTHR, 2) fwd_megakernel(Args args) {
    extern __shared__ __attribute__((aligned(16))) unsigned char lds_raw[];
    LAS unsigned char* lds = (LAS unsigned char*)lds_raw;
    cg::grid_group grid = cg::this_grid();
    const int tid = threadIdx.x, lane = tid & 63, wave = __builtin_amdgcn_readfirstlane(tid >> 6);
    const int G = gridDim.x, bid = blockIdx.x;
    unsigned char* ws = args.ws;
    float* MOD = (float*)(ws + WS_MOD); bf16* XB = (bf16*)(ws + WS_XB); bf16* HB = (bf16*)(ws + WS_HB);
    bf16* Qb = (bf16*)(ws + WS_Q); bf16* Kb = (bf16*)(ws + WS_K); bf16* Vb = (bf16*)(ws + WS_V); bf16* Ob = (bf16*)(ws + WS_O);
    bf16* Hbig = (bf16*)(ws + WS_BIG); bf16* XR = (bf16*)(ws + WS_XR); bf16* GG = (bf16*)(ws + WS_GG);
    const float* ln_g = args.in[4]; const float* ln_b = args.in[5];
    using namespace pg8;

    volatile LAS unsigned* MISC = (volatile LAS unsigned*)(lds + LDS_BYTES - 64);
    if (tid < 2) MISC[tid] = 0u;
    if (bid == 0) { for (int i = tid; i < XCD_BAR_WORDS; i += NTHR) ((unsigned*)(ws + WS_BAR))[i] = 0u; }
    __syncthreads();
    p0_prologue(args, lds, tid, lane, wave, G, bid);
    grid.sync();
    (void)xcd_barrier_post((unsigned*)(ws + WS_BAR), MISC);
#define GRID_BAR() do { XcdBarrier b_; b_.bar = (unsigned*)(args.ws + WS_BAR); b_.x = xb_xcc_id(); b_.st = (volatile LAS unsigned*)(lds + LDS_BYTES - 64); xcd_barrier(b_); } while (0)
    ln_mod_phase<false, true, false>(args.in[0], nullptr, HB, nullptr, nullptr, MOD + 0 * 12288, nullptr, lane, wave, G, bid);
    GRID_BAR();
    { Gemm g{HB, (const bf16_t*)(ws + WS_WQKV), M, NQKV, DM}; StaticOrder S; S.init(M, NQKV, G, bid);
      EpiQKV E{Qb, Kb, Vb, (const float*)(ws + WS_CS), 0.08838834764831845f * LOG2E};
      gemm_phase<EpiQKV, StaticOrder, true, true>(lds, g, S, E); }
    GRID_BAR();
    attn_phase(lds, Qb, Kb, Vb, Ob, args.in[8], tid, lane, wave, G, bid);
    GRID_BAR();
    { Gemm g{Ob, (const bf16_t*)(ws + WS_WO), M, DM, DM}; StaticOrder S; S.init(M, DM, G, bid);
      EpiRes<true> E{ws, args.in[0], ln_g, ln_b, 0};
      gemm_phase<EpiRes<true>, StaticOrder, true, true>(lds, g, S, E); }
    GRID_BAR();
    ln_mod_phase<true, false, false>(XB, nullptr, HB, ln_g + 0 * 1024, ln_b + 0 * 1024, MOD + 1 * 12288, (float*)(ws + WS_STAT), lane, wave, G, bid);
    GRID_BAR();
    { Gemm g{HB, (const bf16_t*)(ws + WS_W1), M, DFF, DM}; StaticOrder S; S.init(M, DFF, G, bid);
      EpiAct<0> E{Hbig, nullptr, DFF};
      gemm_phase<EpiAct<0>, StaticOrder, true, true>(lds, g, S, E); }
    GRID_BAR();
    { Gemm g{Hbig, (const bf16_t*)(ws + WS_W2), M, DM, DFF}; StaticOrder S; S.init(M, DM, G, bid);
      EpiRes<false> E{ws, nullptr, ln_g, ln_b, 1};
      gemm_phase<EpiRes<false>, StaticOrder, true, true>(lds, g, S, E); }
    GRID_BAR();
    ln_mod_phase<true, false, false>(XB, nullptr, HB, ln_g + 1 * 1024, ln_b + 1 * 1024, MOD + 2 * 12288, (float*)(ws + WS_STAT), lane, wave, G, bid);
    GRID_BAR();
    { Gemm g{HB, (const bf16_t*)(ws + WS_WRIN), M, 2 * DRNN, DM}; StaticOrder S; S.init(M, 2 * DRNN, G, bid);
      EpiAct<1> E{XR, GG, DRNN};
      gemm_phase<EpiAct<1>, StaticOrder, true, true>(lds, g, S, E); }
    GRID_BAR();
    rnn_phase<false>(lds, XR, GG, args.in[10], args.in[11], (const bf16*)(ws + WS_WG), args.in[13], args.in[15], (const float*)(ws + WS_SP8), (f32x2*)(ws + WS_AGG), (const float*)(ws + WS_CIN), tid, lane, wave, G, bid);
    GRID_BAR();
    rnn_carry_phase((const f32x2*)(ws + WS_AGG), (float*)(ws + WS_CIN), tid, G, bid);
    GRID_BAR();
    rnn_phase<true>(lds, XR, GG, args.in[10], args.in[11], (const bf16*)(ws + WS_WG), args.in[13], args.in[15], (const float*)(ws + WS_SP8), (f32x2*)(ws + WS_AGG), (const float*)(ws + WS_CIN), tid, lane, wave, G, bid);
    GRID_BAR();
    { Gemm g{GG, (const bf16_t*)(ws + WS_WROUT), M, DM, DRNN}; StaticOrder S; S.init(M, DM, G, bid);
      EpiRes<false> E{ws, nullptr, ln_g, ln_b, 2};
      gemm_phase<EpiRes<false>, StaticOrder, true, true>(lds, g, S, E); }
    GRID_BAR();
    ln_mod_phase<true, false, false>(XB, nullptr, HB, ln_g + 2 * 1024, ln_b + 2 * 1024, MOD + 3 * 12288, (float*)(ws + WS_STAT), lane, wave, G, bid);
    GRID_BAR();
    { Gemm g{HB, (const bf16_t*)(ws + WS_W1) + (size_t)DFF * DM, M, DFF, DM}; StaticOrder S; S.init(M, DFF, G, bid);
      EpiAct<0> E{Hbig, nullptr, DFF};
      gemm_phase<EpiAct<0>, StaticOrder, true, true>(lds, g, S, E); }
    GRID_BAR();
    { Gemm g{Hbig, (const bf16_t*)(ws + WS_W2) + (size_t)DM * DFF, M, DM, DFF}; StaticOrder S; S.init(M, DM, G, bid);
      EpiRes<false> E{ws, nullptr, ln_g, ln_b, 3};
      gemm_phase<EpiRes<false>, StaticOrder, true, true>(lds, g, S, E); }
    GRID_BAR();
    ln_mod_phase<true, false, true>(XB, args.out, nullptr, ln_g + 3 * 1024, ln_b + 3 * 1024, nullptr, nullptr, lane, wave, G, bid);
}

extern "C" void kernel_launch(void* const* d_in, const int* in_sizes, int n_in, void* d_out, int out_size, void* d_ws, size_t ws_size, hipStream_t stream) {
    static int grid = 0;
    if (grid == 0) {
        if (n_in != 20 || out_size != M * DM || ws_size < WS_END) { fprintf(stderr, "kernel_launch: unexpected problem (n_in %d, out %d, ws %zu)\n", n_in, out_size, ws_size); grid = -1; return; }
        int dev = 0, cus = 0, per_cu = 0;
        (void)hipGetDevice(&dev); (void)hipDeviceGetAttribute(&cus, hipDeviceAttributeMultiprocessorCount, dev);
        if (hipFuncSetAttribute((const void*)fwd_megakernel, hipFuncAttributeMaxDynamicSharedMemorySize, LDS_BYTES) != hipSuccess) { fprintf(stderr, "kernel_launch: hipFuncSetAttribute failed\n"); grid = -1; return; }
        if (hipOccupancyMaxActiveBlocksPerMultiprocessor(&per_cu, (const void*)fwd_megakernel, NTHR, LDS_BYTES) != hipSuccess || per_cu < 1) { fprintf(stderr, "kernel_launch: occupancy query gave %d\n", per_cu); per_cu = 1; }
        (void)hipGetLastError();
        grid = cus * 1;
    }
    if (grid < 0) return;
    Args a{};
    for (int i = 0; i < 20; ++i) a.in[i] = (const float*)d_in[i];
    a.out = (float*)d_out; a.ws = (unsigned char*)d_ws;
    void* kargs[] = {&a};
    hipError_t e = hipLaunchCooperativeKernel((const void*)fwd_megakernel, dim3(grid), dim3(NTHR), kargs, LDS_BYTES, stream);
    if (e != hipSuccess) fprintf(stderr, "cooperative launch failed: %s (grid %d)\n", hipGetErrorString(e), grid);
}
```

```cpp
#include <hip/hip_runtime.h>
#include <hip/hip_cooperative_groups.h>
#include <cstdio>
#include <cstdint>
namespace cg = cooperative_groups;
constexpr int NWAVES = 8, NTHR = 512;
constexpr int BATCH = 4, SEQ = 8192, DM = 1024, M = BATCH * SEQ, DFF = 4096, DRNN = 1536, NQKV = 1536;
constexpr float LN_EPS = 1e-5f, DN_ALPHA = 1.4142135623730951f, LOG2E = 1.4426950408889634f;
constexpr int LDS_BYTES = 147456;
constexpr size_t MiB = 1u << 20;
constexpr size_t WS_MOD = 0;
constexpr size_t WS_BAR = 768 * 1024;
constexpr size_t WS_STAT = 256 * 1024;
constexpr size_t WS_SP8 = 512 * 1024;
constexpr size_t WS_CS = 1 * MiB;
constexpr size_t WS_WG = 2 * MiB;
constexpr size_t WS_WQKV = 4 * MiB;
constexpr size_t WS_WO = 7 * MiB;
constexpr size_t WS_WRIN = 9 * MiB;
constexpr size_t WS_WROUT = 15 * MiB;
constexpr size_t WS_W1 = 18 * MiB;
constexpr size_t WS_W2 = 34 * MiB;
constexpr size_t WS_XB = 50 * MiB;
constexpr size_t WS_HB = 178 * MiB;
constexpr size_t WS_BIG = 242 * MiB;
constexpr size_t WS_Q = WS_BIG, WS_K = WS_BIG + 64 * MiB, WS_V = WS_BIG + 80 * MiB, WS_O = WS_BIG + 96 * MiB;
constexpr size_t WS_XR = WS_BIG, WS_GG = WS_BIG + 96 * MiB;
constexpr size_t WS_AGG = WS_BIG + 192 * MiB;
constexpr size_t WS_CIN = WS_BIG + 208 * MiB;
constexpr size_t WS_END = WS_BIG + 256 * MiB;

namespace pg8 {
#define PG8_LAS __attribute__((address_space(3)))
typedef unsigned short bf16_t;
typedef short bf16x8 __attribute__((ext_vector_type(8)));
typedef float f32x4 __attribute__((ext_vector_type(4)));
typedef unsigned u32x4 __attribute__((ext_vector_type(4)));
constexpr int BM = 256, BK = 64, HALF = 128, HTB = HALF * BK * 2  , STAGE_BYTES = 8 * HTB, NXCD = 8, WGM = 8;

__host__ __device__ __forceinline__ int lds_byte(int r, int c) { const int st = (r >> 4) * 2 + (c >> 5), rr = r & 15, cc = c & 31, ob = rr * 64 + cc * 2; return st * 1024 + (ob ^ (((ob >> 9) & 1) << 5)); }
__host__ __device__ __forceinline__ void stage_rc(int b, int& R, int& C) { const int st = b / 1024, sb = b % 1024, swz = sb ^ (((sb >> 9) & 1) << 5); R = (st >> 1) * 16 + swz / 64; C = (st & 1) * 32 + (swz % 64) / 2; }
__host__ __device__ __forceinline__ int perm32(int rho) { const int n = rho >> 4, i = rho & 15; return 8 * (i >> 2) + 4 * n + (i & 3); }

struct Unit { int pm, pn; };
struct Gemm { const bf16_t* A; const bf16_t* Bt; int M, N, K; };

struct StaticOrder {
    int nM, nN, nwg, G, c;
    __host__ __device__ void init(int M, int N, int G_, int c_) { nM = M / BM; nN = N / BM; nwg = nM * nN; G = G_; c = c_; }
    __host__ __device__ bool next(int i, Unit& u) const {
        const long L = (long)i * G + c; if (L >= nwg) return false;
        int wgid = (int)L; { const int q = nwg / NXCD, r = nwg % NXCD, xcd = wgid % NXCD, off = wgid / NXCD; wgid = (xcd < r ? xcd * (q + 1) : r * (q + 1) + (xcd - r) * q) + off; }
        const int nig = WGM * nN, gid = wgid / nig, fm = gid * WGM, gsz = (nM - fm) < WGM ? (nM - fm) : WGM;
        u.pm = fm + ((wgid % nig) % gsz); u.pn = (wgid % nig) / gsz; return true;
    }
    __device__ __forceinline__ void a_ready(const Unit&) const {}
    __device__ __forceinline__ void done(const Unit&) const {}
};

__device__ __forceinline__ unsigned cvt_pk_bf16(float lo, float hi) { unsigned r; asm volatile("v_cvt_pk_bf16_f32 %0, %1, %2" : "=v"(r) : "v"(lo), "v"(hi)); return r; }
__device__ __forceinline__ u32x4 pack8(const f32x4 v0, const f32x4 v1) { u32x4 w; w.x = cvt_pk_bf16(v0[0], v0[1]); w.y = cvt_pk_bf16(v0[2], v0[3]); w.z = cvt_pk_bf16(v1[0], v1[1]); w.w = cvt_pk_bf16(v1[2], v1[3]); return w; }
struct EpiQKV {
    static constexpr bool PERM = true, AFTER_DRAIN = false;
    bf16_t* Q; bf16_t* K; bf16_t* V; const float* cs; float qscale;
    __device__ __forceinline__ void operator()(const f32x4 (&acc)[2][2][4][2], const Unit& u, int wr, int wc, int fr, int fq) const {
        const int row0 = u.pm * BM + wr * 64 + fr;
        bf16_t* base; int ld, colt; float sc = 1.f; bool rope = true;
        if (u.pn < 4) { base = Q; ld = 1024; colt = u.pn * BM; sc = qscale; }
        else if (u.pn == 4) { base = K; ld = 256; colt = 0; }
        else { base = V; ld = 256; colt = 0; rope = false; }
        const int col0 = colt + wc * 32 + 8 * fq;
        const bool dorope = rope && (wc == 0);
        if (dorope) {
            const float* tb = cs + 8 * (fq & 1); const float sg = (fq < 2) ? -1.0f : 1.0f;
            f32x4 cc0, cc1, cs0, cs1;
            { const float* t = tb + (size_t)(row0 & 8191) * 32; cc0 = *(const f32x4*)t; cc1 = *(const f32x4*)(t + 4); cs0 = *(const f32x4*)(t + 16); cs1 = *(const f32x4*)(t + 20); }
#pragma unroll
            for (int q = 0; q < 8; ++q) {
                const int ai = q >> 2, m = q & 3; const int row = row0 + ai * HALF + m * 16;
                f32x4 n0 = cc0, n1 = cc1, n2 = cs0, n3 = cs1;
                if (q < 7) { const int rown = row0 + ((q + 1) >> 2) * HALF + ((q + 1) & 3) * 16; const float* t = tb + (size_t)(rown & 8191) * 32;
                    n0 = *(const f32x4*)t; n1 = *(const f32x4*)(t + 4); n2 = *(const f32x4*)(t + 16); n3 = *(const f32x4*)(t + 20); }
                __builtin_amdgcn_sched_barrier(0);
                const f32x4 s0 = cs0 * sg, s1 = cs1 * sg;
#pragma unroll
                for (int bj = 0; bj < 2; ++bj) {
                    f32x4 v0 = acc[ai][bj][m][0], v1 = acc[ai][bj][m][1]; f32x4 p0, p1;
#pragma unroll
                    for (int j = 0; j < 4; ++j) { p0[j] = __shfl_xor(v0[j], 32); p1[j] = __shfl_xor(v1[j], 32); }
                    v0 = (v0 * cc0 + p0 * s0) * sc; v1 = (v1 * cc1 + p1 * s1) * sc;
                    *(u32x4*)(base + (size_t)row * ld + col0 + bj * HALF) = pack8(v0, v1);
                }
                cc0 = n0; cc1 = n1; cs0 = n2; cs1 = n3;
            }
        } else {
#pragma unroll
            for (int ai = 0; ai < 2; ++ai)
#pragma unroll
                for (int m = 0; m < 4; ++m) { const int row = row0 + ai * HALF + m * 16;
#pragma unroll
                    for (int bj = 0; bj < 2; ++bj) *(u32x4*)(base + (size_t)row * ld + col0 + bj * HALF) = pack8(acc[ai][bj][m][0] * sc, acc[ai][bj][m][1] * sc); }
        }
    }
};
template <bool XF32> struct EpiRes {
    static constexpr bool PERM = true, AFTER_DRAIN = false;
    unsigned char* ws; const float* xin; const float* lng_all; const float* lnb_all; int k;
    __device__ __forceinline__ void operator()(const f32x4 (&acc)[2][2][4][2], const Unit& u, int wr, int wc, int fr, int fq) const {
        const int row0 = u.pm * BM + wr * 64 + fr, col0 = u.pn * BM + wc * 32 + 8 * fq;
        const int b = (u.pm * BM) >> 13;
        const void* xres = XF32 ? (const void*)xin : (const void*)(ws + WS_XB); bf16_t* out = (bf16_t*)(ws + WS_XB); constexpr float alpha = DN_ALPHA;
        const float* gate = (const float*)(ws + WS_MOD) + k * 12288 + 2048; const float* stat = (const float*)(ws + WS_STAT);
        const float* lng = lng_all + (k - 1) * 1024; const float* lnb = lnb_all + (k - 1) * 1024;
#pragma unroll
        for (int bj = 0; bj < 2; ++bj) {
            const f32x4 g0 = *(const f32x4*)(gate + b * 3072 + col0 + bj * HALF) + 1.0f, g1 = *(const f32x4*)(gate + b * 3072 + col0 + bj * HALF + 4) + 1.0f;
            f32x4 G0, G1, B0, B1;
            if (!XF32) { G0 = *(const f32x4*)(lng + col0 + bj * HALF); G1 = *(const f32x4*)(lng + col0 + bj * HALF + 4); B0 = *(const f32x4*)(lnb + col0 + bj * HALF); B1 = *(const f32x4*)(lnb + col0 + bj * HALF + 4); }
            typedef float f32x2e __attribute__((ext_vector_type(2)));
#pragma unroll
            for (int ai = 0; ai < 2; ++ai) {
                u32x4 xw[4]; f32x2e srs[4];
                if (!XF32) {
#pragma unroll
                    for (int m = 0; m < 4; ++m) { const int r_ = row0 + ai * HALF + m * 16; xw[m] = *(const u32x4*)((const bf16_t*)xres + (size_t)r_ * 1024 + col0 + bj * HALF); srs[m] = *(const f32x2e*)(stat + 2 * r_); }
                    asm volatile("" ::: "memory");
                }
#pragma unroll
                for (int m = 0; m < 4; ++m) { const size_t off = (size_t)(row0 + ai * HALF + m * 16) * 1024 + col0 + bj * HALF;
                    f32x4 x0, x1;
                    if (XF32) { x0 = *(const f32x4*)((const float*)xres + off); x1 = *(const f32x4*)((const float*)xres + off + 4); }
                    else { const u32x4 w = xw[m]; const f32x2e sr = srs[m];
                        x0 = (f32x4){__uint_as_float(w.x << 16), __uint_as_float(w.x & 0xffff0000u), __uint_as_float(w.y << 16), __uint_as_float(w.y & 0xffff0000u)};
                        x1 = (f32x4){__uint_as_float(w.z << 16), __uint_as_float(w.z & 0xffff0000u), __uint_as_float(w.w << 16), __uint_as_float(w.w & 0xffff0000u)};
                        x0 = (x0 - sr.x) * sr.y * G0 + B0; x1 = (x1 - sr.x) * sr.y * G1 + B1; }
                    *(u32x4*)(out + off) = pack8(x0 * alpha + g0 * acc[ai][bj][m][0], x1 * alpha + g1 * acc[ai][bj][m][1]);
                    if (XF32 && (m & 1)) asm volatile("" ::: "memory"); }
                asm volatile("" ::: "memory");
            }
        }
    }
};
__device__ __forceinline__ float gelu_tanh(float x) { const float t = x * x * 0.044715f + 1.0f; const float e = __builtin_amdgcn_exp2f(-2.302208198f * (x * t)); return x * __builtin_amdgcn_rcpf(1.0f + e); }
template <int MODE> struct EpiAct {
    static constexpr bool PERM = true, AFTER_DRAIN = false;
    bf16_t* O; bf16_t* O2; int ldc;
    __device__ __forceinline__ void operator()(const f32x4 (&acc)[2][2][4][2], const Unit& u, int wr, int wc, int fr, int fq) const {
        const int row0 = u.pm * BM + wr * 64 + fr; int colt = u.pn * BM; bf16_t* base = O; bool act = (MODE == 0);
        if (MODE == 1 && u.pn >= 6) { base = O2; colt -= 1536; act = true; }
        const int col0 = colt + wc * 32 + 8 * fq;
#pragma unroll
        for (int ai = 0; ai < 2; ++ai)
#pragma unroll
            for (int m = 0; m < 4; ++m) { bf16_t* rowp = base + (size_t)(row0 + ai * HALF + m * 16) * ldc + col0;
#pragma unroll
                for (int bj = 0; bj < 2; ++bj) { f32x4 v0 = acc[ai][bj][m][0], v1 = acc[ai][bj][m][1];
                    if (act) {
#pragma unroll
                        for (int j = 0; j < 4; ++j) {
                            if (MODE == 0) { const float a = fmaxf(v0[j], 0.f), b = fmaxf(v1[j], 0.f); v0[j] = a * a; v1[j] = b * b; }
                            else { v0[j] = gelu_tanh(v0[j]); v1[j] = gelu_tanh(v1[j]); } } }
                    *(u32x4*)(rowp + bj * HALF) = pack8(v0, v1); } }
    }
};
template <class Epi, class Sched, bool ALIGN_EPI = false, bool SP2 = false>
__device__ __forceinline__ void gemm_phase(PG8_LAS unsigned char* lds, const Gemm g, const Sched& S, const Epi& E) {
    int tid_ = threadIdx.x; asm volatile("" : "+v"(tid_));
    const int tid = tid_, wid = __builtin_amdgcn_readfirstlane(tid >> 6), lane = tid & 63, wr = wid >> 2, wc = wid & 3, fr = lane & 15, fq = lane >> 4;
    const int K = g.K, nt = K / BK;
    unsigned voffA[2], voffB[2];
#pragma unroll
    for (int i = 0; i < 2; ++i) { int R, C; stage_rc(tid * 16 + i * 8192, R, C); const int Rb = Epi::PERM ? ((R & ~31) + perm32(R & 31)) : R;
        voffA[i] = (unsigned)(R * K + C) * 2u; voffB[i] = (unsigned)(Rb * K + C) * 2u; }
    const size_t kstep = (size_t)(BK * 2);
    const size_t hstep = (size_t)HALF * K * 2;
    const size_t tstep = 2 * hstep;
    const unsigned ldsw = (unsigned)wid * 1024u;
    const int aoff = lds_byte(wr * 64 + fr, fq * 8), boff = lds_byte(wc * 32 + fr, fq * 8);
#define PG8_SA(b, h) (((b) * 2 + (h)) * HTB)
#define PG8_SB(b, h) ((4 + (b) * 2 + (h)) * HTB)
#define PG8_STAGE(bufoff, gbase, voff) do { _Pragma("unroll") for (int _i = 0; _i < 2; ++_i) \
        __builtin_amdgcn_global_load_lds((const unsigned*)((const char*)(gbase) + (voff)[_i]), (PG8_LAS unsigned*)(lds + (bufoff) + ldsw + _i * 8192), 16, 0, 0); } while (0)
#define PG8_LDA(dst, b, h) do { _Pragma("unroll") for (int m = 0; m < 4; ++m) _Pragma("unroll") for (int k = 0; k < 2; ++k) dst[m][k] = *(const PG8_LAS bf16x8*)(lds + PG8_SA(b, h) + aoff + m * 2048 + k * 1024); } while (0)
#define PG8_LDB(dst, b, h) do { _Pragma("unroll") for (int n = 0; n < 2; ++n) _Pragma("unroll") for (int k = 0; k < 2; ++k) dst[n][k] = *(const PG8_LAS bf16x8*)(lds + PG8_SB(b, h) + boff + n * 2048 + k * 1024); } while (0)
#define PG8_MMA(ai, bj, At, Bt) do { __builtin_amdgcn_s_setprio(1); _Pragma("unroll") for (int m = 0; m < 4; ++m) _Pragma("unroll") for (int n = 0; n < 2; ++n) _Pragma("unroll") for (int k = 0; k < 2; ++k) \
        acc[ai][bj][m][n] = __builtin_amdgcn_mfma_f32_16x16x32_bf16(Bt[n][k], At[m][k], acc[ai][bj][m][n], 0, 0, 0); __builtin_amdgcn_s_setprio(0); } while (0)
#define PG8_WAIT_V(n) asm volatile("s_waitcnt vmcnt(" #n ")" ::: "memory")
#define PG8_WAIT_L(n) asm volatile("s_waitcnt lgkmcnt(" #n ")" ::: "memory")
#define PG8_BAR __builtin_amdgcn_s_barrier()
#define PG8_SCHED __builtin_amdgcn_sched_barrier(0)
    Unit cur, nxt; int ui = 0;
    if (!S.next(0, cur)) return;
    f32x4 acc[2][2][4][2];
#pragma unroll
    for (int a = 0; a < 2; ++a)
#pragma unroll
        for (int b = 0; b < 2; ++b)
#pragma unroll
            for (int m = 0; m < 4; ++m)
#pragma unroll
                for (int n = 0; n < 2; ++n) acc[a][b][m][n] = (f32x4){0.f, 0.f, 0.f, 0.f};
    bf16x8 At[4][2], B0[2][2], B1[2][2];
    const char* cA = (const char*)g.A + (size_t)cur.pm * tstep; const char* cB = (const char*)g.Bt + (size_t)cur.pn * tstep;
    S.a_ready(cur);
    if constexpr (SP2) {
        PG8_STAGE(PG8_SB(0, 0), cB, voffB); PG8_STAGE(PG8_SB(0, 1), cB + hstep, voffB); PG8_STAGE(PG8_SA(0, 0), cA, voffA); PG8_STAGE(PG8_SA(0, 1), cA + hstep, voffA);
        if (wr == 1) PG8_BAR;
        PG8_WAIT_V(2); PG8_BAR;
        PG8_STAGE(PG8_SB(1, 0), cB + kstep, voffB); PG8_STAGE(PG8_SA(1, 0), cA + kstep, voffA); PG8_STAGE(PG8_SB(1, 1), cB + hstep + kstep, voffB);
        PG8_WAIT_V(6); PG8_BAR;
    } else {
        PG8_STAGE(PG8_SB(0, 0), cB, voffB); PG8_STAGE(PG8_SA(0, 0), cA, voffA); PG8_STAGE(PG8_SB(0, 1), cB + hstep, voffB); PG8_STAGE(PG8_SA(0, 1), cA + hstep, voffA);
        if (wr == 1) PG8_BAR;
        PG8_WAIT_V(4); PG8_BAR;
        PG8_STAGE(PG8_SB(1, 0), cB + kstep, voffB); PG8_STAGE(PG8_SA(1, 0), cA + kstep, voffA); PG8_STAGE(PG8_SB(1, 1), cB + hstep + kstep, voffB);
        PG8_WAIT_V(6); PG8_BAR;
    }
    for (;;) {
        const bool has_next = S.next(ui + 1, nxt);
        const char* nA = has_next ? (const char*)g.A + (size_t)nxt.pm * tstep : cA; const char* nB = has_next ? (const char*)g.Bt + (size_t)nxt.pn * tstep : cB;
        asm volatile(".p2align 8");
        for (int t = 0; t < nt; t += 2) {
            const bool last = (t == nt - 2);
            const char* a1 = cA + (size_t)(t + 1) * kstep;
            const char* a2 = last ? nA : cA + (size_t)(t + 2) * kstep; const char* b2 = last ? nB : cB + (size_t)(t + 2) * kstep;
            const char* a3 = a2 + kstep; const char* b3 = b2 + kstep;
            if (last && has_next) S.a_ready(nxt);
            if constexpr (SP2) {
            PG8_LDB(B0, 0, 0); PG8_LDB(B1, 0, 1); PG8_SCHED; PG8_LDA(At, 0, 0); PG8_STAGE(PG8_SA(1, 1), a1 + hstep, voffA);
            PG8_WAIT_V(8); PG8_WAIT_L(0); PG8_BAR; PG8_MMA(0, 0, At, B0); PG8_MMA(0, 1, At, B1); PG8_BAR; PG8_SCHED;
            PG8_LDA(At, 0, 1); PG8_STAGE(PG8_SB(0, 0), b2, voffB); PG8_STAGE(PG8_SB(0, 1), b2 + hstep, voffB); PG8_STAGE(PG8_SA(0, 0), a2, voffA);
            PG8_WAIT_V(8); PG8_WAIT_L(0); PG8_BAR; PG8_MMA(1, 0, At, B0); PG8_MMA(1, 1, At, B1); PG8_BAR; PG8_SCHED;
            PG8_LDB(B0, 1, 0); PG8_LDB(B1, 1, 1); PG8_SCHED; PG8_LDA(At, 1, 0); PG8_STAGE(PG8_SA(0, 1), a2 + hstep, voffA);
            PG8_WAIT_V(8); PG8_WAIT_L(0); PG8_BAR; PG8_MMA(0, 0, At, B0); PG8_MMA(0, 1, At, B1); PG8_BAR; PG8_SCHED;
            PG8_LDA(At, 1, 1); PG8_STAGE(PG8_SB(1, 0), b3, voffB); PG8_STAGE(PG8_SB(1, 1), b3 + hstep, voffB); PG8_STAGE(PG8_SA(1, 0), a3, voffA);
            PG8_WAIT_V(8); PG8_WAIT_L(0); PG8_BAR; PG8_MMA(1, 0, At, B0); PG8_MMA(1, 1, At, B1); PG8_BAR; PG8_SCHED;
            } else {
            PG8_LDB(B0, 0, 0); PG8_SCHED; PG8_LDA(At, 0, 0); PG8_STAGE(PG8_SA(1, 1), a1 + hstep, voffA);
            PG8_WAIT_L(8); PG8_BAR; PG8_WAIT_L(0); PG8_MMA(0, 0, At, B0); PG8_BAR; PG8_SCHED;
            PG8_LDB(B1, 0, 1); PG8_STAGE(PG8_SB(0, 0), b2, voffB);
            PG8_BAR; PG8_WAIT_L(0); PG8_MMA(0, 1, At, B1); PG8_BAR;
            PG8_LDA(At, 0, 1); PG8_STAGE(PG8_SA(0, 0), a2, voffA);
            PG8_BAR; PG8_WAIT_L(0); PG8_MMA(1, 0, At, B0); PG8_BAR; PG8_SCHED;
            PG8_STAGE(PG8_SB(0, 1), b2 + hstep, voffB);
            PG8_WAIT_V(6); PG8_BAR; PG8_MMA(1, 1, At, B1); PG8_BAR;
            PG8_LDB(B0, 1, 0); PG8_SCHED; PG8_LDA(At, 1, 0); PG8_STAGE(PG8_SA(0, 1), a2 + hstep, voffA);
            PG8_WAIT_L(8); PG8_BAR; PG8_WAIT_L(0); PG8_MMA(0, 0, At, B0); PG8_BAR; PG8_SCHED;
            PG8_LDB(B1, 1, 1); PG8_STAGE(PG8_SB(1, 0), b3, voffB);
            PG8_BAR; PG8_WAIT_L(0); PG8_MMA(0, 1, At, B1); PG8_BAR;
            PG8_LDA(At, 1, 1); PG8_STAGE(PG8_SA(1, 0), a3, voffA);
            PG8_BAR; PG8_WAIT_L(0); PG8_MMA(1, 0, At, B0); PG8_BAR; PG8_SCHED;
            PG8_STAGE(PG8_SB(1, 1), b3 + hstep, voffB);
            PG8_WAIT_V(6); PG8_BAR; PG8_MMA(1, 1, At, B1); PG8_BAR;
            }
        }
        if constexpr (ALIGN_EPI) { if (wr == 0) PG8_BAR; }
        if constexpr (!Epi::AFTER_DRAIN) { E(acc, cur, wr, wc, fr, fq); S.done(cur); }
        if (!has_next) break;
#pragma unroll
        for (int a = 0; a < 2; ++a)
#pragma unroll
            for (int b = 0; b < 2; ++b)
#pragma unroll
                for (int m = 0; m < 4; ++m)
#pragma unroll
                    for (int n = 0; n < 2; ++n) acc[a][b][m][n] = (f32x4){0.f, 0.f, 0.f, 0.f};
        cur = nxt; cA = nA; cB = nB; ++ui;
        if constexpr (ALIGN_EPI) { if (wr == 1) PG8_BAR; }
    }
    PG8_WAIT_V(0);
    if constexpr (!ALIGN_EPI) { if (wr == 0) PG8_BAR; }
    PG8_BAR;
    if constexpr (Epi::AFTER_DRAIN) { E.fused(acc, cur, wr, wc, fr, fq, lds, wid, lane); S.done(cur); }
#undef PG8_SA
#undef PG8_SB
#undef PG8_STAGE
#undef PG8_LDA
#undef PG8_LDB
#undef PG8_MMA
#undef PG8_WAIT_V
#undef PG8_WAIT_L
#undef PG8_BAR
#undef PG8_SCHED
}
}

#define LAS __attribute__((address_space(3)))
typedef unsigned short bf16;
typedef unsigned v4u __attribute__((ext_vector_type(4)));
typedef unsigned v2u __attribute__((ext_vector_type(2)));
typedef float f32x4 __attribute__((ext_vector_type(4)));
typedef float f32x2 __attribute__((ext_vector_type(2)));
typedef float f32x16 __attribute__((ext_vector_type(16)));
typedef short bf16x8 __attribute__((ext_vector_type(8)));
typedef short s16x4 __attribute__((ext_vector_type(4)));
typedef __bf16 bf16x2_t __attribute__((ext_vector_type(2)));
__device__ __forceinline__ unsigned pk2(float lo, float hi) { f32x2 v = {lo, hi}; bf16x2_t b = __builtin_convertvector(v, bf16x2_t); return __builtin_bit_cast(unsigned, b); }
__device__ __forceinline__ float bf2f(unsigned short h) { return __uint_as_float((unsigned)h << 16); }
__device__ __forceinline__ float wave_sum(float v) {
#pragma unroll
    for (int o = 1; o < 64; o <<= 1) v += __shfl_xor(v, o);
    return v;
}
__device__ __forceinline__ float sigmoidf_(float x) { return __builtin_amdgcn_rcpf(1.0f + __builtin_amdgcn_exp2f(-1.4426950408889634f * x)); }

struct Args { const float* in[20]; float* out; unsigned char* ws; };


#define GAS __attribute__((address_space(1)))
#define XB_TMO      128
#define XB_XCNT(j)  (256  + 64 * (j))
#define XB_XSUB(j)  (1280 + 64 * (j))
#define XB_XGEN(j)  (2304 + 64 * (j))
#define XB_TOP      3328
#define XB_TOPGEN   3392
#define XCD_BAR_WORDS 3456
#define XB_SPIN_CAP (1u << 18)

__device__ __forceinline__ unsigned xb_ld(unsigned* p)              { return __hip_atomic_load(p, __ATOMIC_RELAXED, __HIP_MEMORY_SCOPE_AGENT); }
__device__ __forceinline__ unsigned xb_add(unsigned* p, unsigned v) { return __hip_atomic_fetch_add(p, v, __ATOMIC_RELAXED, __HIP_MEMORY_SCOPE_AGENT); }
__device__ __forceinline__ unsigned xb_xcc_id() { return (unsigned)__builtin_amdgcn_s_getreg((3 << 11) | 20) & 0xFu; }
#define XB_SPIN(cond, bar) do { unsigned _sp = 0; while (cond) { __builtin_amdgcn_s_sleep(1); \
    if ((++_sp & 255u) == 0u) { if (xb_ld(&(bar)[XB_TMO])) break; if (_sp > XB_SPIN_CAP) { atomicAdd(&(bar)[XB_TMO], 1u); break; } } } } while (0)

struct XcdBarrier {
    unsigned* bar; unsigned x;
    volatile LAS unsigned* st;
};

__device__ __forceinline__ XcdBarrier xcd_barrier_post(unsigned* bar, volatile LAS unsigned* st) {
    XcdBarrier b; b.bar = bar; b.x = xb_xcc_id(); b.st = st;
    if (threadIdx.x == 0) (void)xb_add(&bar[XB_XCNT(b.x)], 1u);
    return b;
}
__device__ __forceinline__ void xcd_barrier_complete(unsigned* bar, unsigned x, unsigned& nloc, unsigned& nx) {
    const unsigned G = gridDim.x * gridDim.y * gridDim.z;
    unsigned sum, cnt, mine, sp = 0u;
    for (;;) {
        sum = 0u; cnt = 0u; mine = 0u;
#pragma unroll
        for (unsigned j = 0; j < 16; ++j) { const unsigned c = xb_ld(&bar[XB_XCNT(j)]); sum += c; cnt += (c > 0u) ? 1u : 0u; mine = (j == x) ? c : mine; }
        if (sum == G) break;
        __builtin_amdgcn_s_sleep(1);
        if ((++sp & 255u) == 0u) { if (xb_ld(&bar[XB_TMO])) break; if (sp > XB_SPIN_CAP) { atomicAdd(&bar[XB_TMO], 1u); break; } }
    }
    nloc = mine > 0u ? mine : 1u; nx = cnt > 0u ? cnt : 1u;
}

__device__ __forceinline__ void xcd_barrier(const XcdBarrier& b) {
    asm volatile("s_waitcnt vmcnt(0)" ::: "memory");
    __syncthreads();
    if (threadIdx.x == 0) {
        unsigned* bar = b.bar;
        __builtin_amdgcn_s_waitcnt(0);
        unsigned nloc = b.st[0], nx = b.st[1];
        if (nloc == 0u) { xcd_barrier_complete(bar, b.x, nloc, nx); b.st[0] = nloc; b.st[1] = nx; }
        const unsigned old = xb_add(&bar[XB_XSUB(b.x)], 1u);
        const unsigned gen = old / nloc;
        if (old + 1u == (gen + 1u) * nloc) {
            __builtin_amdgcn_fence(__ATOMIC_RELEASE, "agent");
            asm volatile("s_waitcnt vmcnt(0)" ::: "memory");
            const unsigned og = xb_add(&bar[XB_TOP], 1u);
            const unsigned tg = og / nx;
            if (og + 1u == (tg + 1u) * nx) xb_add(&bar[XB_TOPGEN], 1u);
            else XB_SPIN(xb_ld(&bar[XB_TOPGEN]) == tg, bar);
            __builtin_amdgcn_fence(__ATOMIC_ACQUIRE, "agent");
            xb_add(&bar[XB_XGEN(b.x)], 1u);
            asm volatile("s_waitcnt vmcnt(0)" ::: "memory");
        } else {
            XB_SPIN(xb_ld(&bar[XB_XGEN(b.x)]) == gen, bar);
            __builtin_amdgcn_fence(__ATOMIC_ACQUIRE, "agent");
            asm volatile("s_waitcnt vmcnt(0)" ::: "memory");
        }
    }
    __syncthreads();
}

__device__ __forceinline__ void p0_transpose_item(const float* W, int K, int N, bf16* WT, LAS float* scr, int item, int lane) {
    const int nblk = N / 32, kb = item / nblk, nb = item % nblk, k0 = 64 * kb, n0 = 32 * nb;
    float wv_[32];
#pragma unroll
    for (int i = 0; i < 32; ++i) wv_[i] = W[(size_t)(k0 + 2 * i + (lane >> 5)) * N + n0 + (lane & 31)];
#pragma unroll
    for (int i = 0; i < 32; ++i) scr[(2 * i + (lane >> 5)) * 33 + (lane & 31)] = wv_[i];
    asm volatile("s_waitcnt lgkmcnt(0)" ::: "memory");
    const int c = lane & 7;
#pragma unroll
    for (int j = 0; j < 4; ++j) { const int n = (lane >> 3) + 8 * j; const LAS float* s = scr + (8 * c) * 33 + n;
        v4u o; o.x = pk2(s[0 * 33], s[1 * 33]); o.y = pk2(s[2 * 33], s[3 * 33]); o.z = pk2(s[4 * 33], s[5 * 33]); o.w = pk2(s[6 * 33], s[7 * 33]);
        *(v4u*)(WT + (size_t)(n0 + n) * K + k0 + 8 * c) = o; }
    asm volatile("s_waitcnt lgkmcnt(0)" ::: "memory");
}

__device__ __forceinline__ void p0_prologue(const Args& a, LAS unsigned char* lds, int tid, int lane, int wave, int G, int bid) {
    unsigned char* ws = a.ws;
    {
        LAS float* sc = (LAS float*)lds;
        LAS float* red = (LAS float*)(lds + 16384);
        const float* c = a.in[1];
        for (int i = tid; i < 4096; i += NTHR) { const float v = c[i]; sc[i] = v / (1.0f + __expf(-v)); }
        __syncthreads();
        for (int item = bid; item < 192; item += G) {
            const int s = item / 48, n0 = (item % 48) * 64;
            const float* w = a.in[2] + (size_t)s * 1024 * 3072 + n0 + lane;
            float acc0 = 0.f, acc1 = 0.f, acc2 = 0.f, acc3 = 0.f;
            const int kbeg = wave * 128;
#pragma unroll 16
            for (int k = 0; k < 128; ++k) { const float wv = w[(size_t)(kbeg + k) * 3072];
                acc0 += wv * sc[kbeg + k]; acc1 += wv * sc[1024 + kbeg + k]; acc2 += wv * sc[2048 + kbeg + k]; acc3 += wv * sc[3072 + kbeg + k]; }
            red[(wave * 4 + 0) * 64 + lane] = acc0; red[(wave * 4 + 1) * 64 + lane] = acc1; red[(wave * 4 + 2) * 64 + lane] = acc2; red[(wave * 4 + 3) * 64 + lane] = acc3;
            __syncthreads();
            if (tid < 256) { const int b = tid >> 6, l = tid & 63; float t = a.in[3][s * 3072 + n0 + l];
#pragma unroll
                for (int wv = 0; wv < 8; ++wv) t += red[(wv * 4 + b) * 64 + l];
                ((float*)(ws + WS_MOD))[(s * 4 + b) * 3072 + n0 + l] = t; }
            __syncthreads();
        }
    }
    __syncthreads();
    {
        const float invf[16] = {1.000000000e+00f, 4.403665960e-01f, 1.939227432e-01f, 8.539710194e-02f, 3.760603070e-02f, 1.656043902e-02f, 7.292664610e-03f, 3.211445874e-03f,
                                1.414213562e-03f, 6.227723788e-04f, 2.742481884e-04f, 1.207697351e-04f, 5.318296098e-05f, 2.341999971e-05f, 1.031338616e-05f, 4.541670478e-06f};
        float* cs = (float*)(ws + WS_CS);
        for (int idx = bid * NTHR + tid; idx < 8192 * 16; idx += G * NTHR) {
            const int pos = idx >> 4, i = idx & 15;
            float f = invf[0];
#pragma unroll
            for (int q = 1; q < 16; ++q) f = (i == q) ? invf[q] : f;
            const float ang = (float)pos * f;
            double t = (double)ang * 0.15915494309189535; t -= __builtin_rint(t);
            const float r = (float)t;
            cs[pos * 32 + i] = __builtin_amdgcn_cosf(r); cs[pos * 32 + 16 + i] = __builtin_amdgcn_sinf(r);
        }
    }
    { float* sp8 = (float*)(ws + WS_SP8); for (int idx = bid * NTHR + tid; idx < 2 * DRNN; idx += G * NTHR) sp8[idx] = 8.0f * log1pf(__expf(-a.in[16][idx])); }
    {
        bf16* wg = (bf16*)(ws + WS_WG);
        for (int idx = bid * NTHR + tid; idx < 2 * 16 * 2 * 96 * 96; idx += G * NTHR) {
            const int i = idx % 96, j = (idx / 96) % 96, gate = (idx / 9216) & 1, n = (idx / 18432) & 15, dir = idx / 294912;
            const float* src = gate ? a.in[14] : a.in[12];
            const float v = src[((size_t)(dir * 16 + n) * 96 + i) * 96 + j];
            wg[idx] = (bf16)(pk2(v, 0.f) & 0xffffu);
        }
    }
    {
        LAS float* scr = (LAS float*)(lds + wave * 16384);
        const int gw = bid * NWAVES + wave, NGW = G * NWAVES;
        constexpr int I_QKV = 16 * 48, I_O = 16 * 32, I_RIN = 16 * 96, I_ROUT = 24 * 32, I_1 = 16 * 128, I_2 = 64 * 32;
        constexpr int NITEMS = I_QKV + I_O + I_RIN + I_ROUT + 2 * I_1 + 2 * I_2;
        for (int it = gw; it < NITEMS; it += NGW) {
            int r = it;
            if (r < I_QKV) { p0_transpose_item(a.in[6], 1024, 1536, (bf16*)(ws + WS_WQKV), scr, r, lane); continue; } r -= I_QKV;
            if (r < I_O) { p0_transpose_item(a.in[7], 1024, 1024, (bf16*)(ws + WS_WO), scr, r, lane); continue; } r -= I_O;
            if (r < I_RIN) { p0_transpose_item(a.in[9], 1024, 3072, (bf16*)(ws + WS_WRIN), scr, r, lane); continue; } r -= I_RIN;
            if (r < I_ROUT) { p0_transpose_item(a.in[17], 1536, 1024, (bf16*)(ws + WS_WROUT), scr, r, lane); continue; } r -= I_ROUT;
            if (r < I_1) { p0_transpose_item(a.in[18], 1024, 4096, (bf16*)(ws + WS_W1), scr, r, lane); continue; } r -= I_1;
            if (r < I_1) { p0_transpose_item(a.in[18] + (size_t)1024 * 4096, 1024, 4096, (bf16*)(ws + WS_W1) + (size_t)4096 * 1024, scr, r, lane); continue; } r -= I_1;
            if (r < I_2) { p0_transpose_item(a.in[19], 4096, 1024, (bf16*)(ws + WS_W2), scr, r, lane); continue; } r -= I_2;
            p0_transpose_item(a.in[19] + (size_t)4096 * 1024, 4096, 1024, (bf16*)(ws + WS_W2) + (size_t)1024 * 4096, scr, r, lane);
        }
    }
}

template <bool DO_LN, bool IN_F32, bool OUT_F32> __device__ __forceinline__ void ln_mod_phase(const void* xin, void* xout, bf16* hout, const float* lng, const float* lnb, const float* mod, float* stat, int lane, int wave, int G, int bid) {
    const int gw = bid * NWAVES + wave, NGW = G * NWAVES;
    for (int row = gw; row < M; row += NGW) {
        f32x4 v[4];
#pragma unroll
        for (int j = 0; j < 2; ++j) { const size_t e = (size_t)row * DM + 512 * j + 8 * lane;
            if (IN_F32) { v[2 * j] = *(const f32x4*)((const float*)xin + e); v[2 * j + 1] = *(const f32x4*)((const float*)xin + e + 4); }
            else { const v4u w = *(const v4u*)((const bf16*)xin + e);
                v[2 * j] = (f32x4){__uint_as_float(w.x << 16), __uint_as_float(w.x & 0xffff0000u), __uint_as_float(w.y << 16), __uint_as_float(w.y & 0xffff0000u)};
                v[2 * j + 1] = (f32x4){__uint_as_float(w.z << 16), __uint_as_float(w.z & 0xffff0000u), __uint_as_float(w.w << 16), __uint_as_float(w.w & 0xffff0000u)}; } }
        if (DO_LN) {
            float s = 0.f;
#pragma unroll
            for (int j = 0; j < 4; ++j) s += (v[j].x + v[j].y) + (v[j].z + v[j].w);
            const float mean = wave_sum(s) * (1.f / DM); float s2 = 0.f;
#pragma unroll
            for (int j = 0; j < 4; ++j) { v[j] = v[j] - mean; s2 += (v[j].x * v[j].x + v[j].y * v[j].y) + (v[j].z * v[j].z + v[j].w * v[j].w); }
            const float rstd = __builtin_amdgcn_rsqf(wave_sum(s2) * (1.f / DM) + LN_EPS);
            if (stat && lane == 0) { stat[2 * row] = mean; stat[2 * row + 1] = rstd; }
#pragma unroll
            for (int j = 0; j < 4; ++j) { const int c = 512 * (j >> 1) + 8 * lane + 4 * (j & 1); const f32x4 g = *(const f32x4*)(lng + c), bb = *(const f32x4*)(lnb + c); v[j] = v[j] * rstd * g + bb; }
        }
        if (xout) {
#pragma unroll
            for (int j = 0; j < 2; ++j) { const size_t e = (size_t)row * DM + 512 * j + 8 * lane;
                if (OUT_F32) { *(f32x4*)((float*)xout + e) = v[2 * j]; *(f32x4*)((float*)xout + e + 4) = v[2 * j + 1]; }
                else { v4u w; w.x = pk2(v[2 * j].x, v[2 * j].y); w.y = pk2(v[2 * j].z, v[2 * j].w); w.z = pk2(v[2 * j + 1].x, v[2 * j + 1].y); w.w = pk2(v[2 * j + 1].z, v[2 * j + 1].w); *(v4u*)((bf16*)xout + e) = w; } } }
        if (hout) { const int b = row >> 13; const float* sh = mod + b * 3072; const float* scl = mod + b * 3072 + 1024;
#pragma unroll
            for (int j = 0; j < 2; ++j) { const int c = 512 * j + 8 * lane;
                const f32x4 h0 = v[2 * j] * (*(const f32x4*)(scl + c) + 1.0f) + *(const f32x4*)(sh + c), h1 = v[2 * j + 1] * (*(const f32x4*)(scl + c + 4) + 1.0f) + *(const f32x4*)(sh + c + 4);
                v4u w; w.x = pk2(h0.x, h0.y); w.y = pk2(h0.z, h0.w); w.z = pk2(h1.x, h1.y); w.w = pk2(h1.z, h1.w); *(v4u*)(hout + (size_t)row * DM + c) = w; } }
    }
}

__device__ __forceinline__ unsigned off_b(unsigned row, unsigned ch) { return 256u * row + 16u * (ch ^ (((row & 3) << 2) | ((row >> 2) & 3))); }
__device__ __forceinline__ s16x4 vtr(const LAS unsigned char* p) { typedef short v4i16_t __attribute__((ext_vector_type(4))); return __builtin_bit_cast(s16x4, __builtin_amdgcn_ds_read_tr16_b64_v4i16((LAS v4i16_t*)p)); }
__device__ __forceinline__ void attn_phase(LAS unsigned char* lds, const bf16* Q, const bf16* K, const bf16* V, bf16* O, const float* sinks, int tid, int lane, int wave, int G, int bid) {
    const int r32 = lane & 31, h = lane >> 5;
    const int blk = (lane >> 4) & 1, q4 = (lane & 15) >> 2, p4 = lane & 3;
    unsigned kofs[8], vofs[4][2];
    { const unsigned swzk = ((r32 & 3) << 2) | ((r32 >> 2) & 3);
#pragma unroll
      for (int s_ = 0; s_ < 8; ++s_) kofs[s_] = 256u * r32 + 16u * ((2u * s_ + h) ^ swzk);
#pragma unroll
      for (int c = 0; c < 4; ++c)
#pragma unroll
          for (int t_ = 0; t_ < 2; ++t_) { const unsigned xr = ((unsigned)q4 << 2) | ((h + 2u * t_) & 3u); vofs[c][t_] = 256u * (4u * h + q4) + 16u * ((4u * c + 2u * blk + (p4 >> 1)) ^ xr) + 8u * (p4 & 1); } }
    const int vbid = ((G & 7) == 0) ? (bid & 7) * (G >> 3) + (bid >> 3) : bid;
    for (int unit = vbid; unit < 1024; unit += G) {
        const int u = unit & 127, kvh = (unit >> 7) & 1, b = unit >> 8;
        const int head = kvh * 4 + (wave >> 1); const int qpos = 64 * u + 32 * (wave & 1) + r32;
        const size_t tokbase = (size_t)b * SEQ;
        bf16x8 qf[8];
        { const bf16* qp = Q + (tokbase + qpos) * 1024 + head * 128 + 8 * h;
#pragma unroll
          for (int s = 0; s < 8; ++s) qf[s] = *(const bf16x8*)(qp + 16 * s); }
        float mrun = sinks[head] * LOG2E; float lrun = (h == 0) ? 1.f : 0.f;
        f32x16 o[4];
#pragma unroll
        for (int c = 0; c < 4; ++c)
#pragma unroll
            for (int i = 0; i < 16; ++i) o[c][i] = 0.f;
        const int c_lo = (u < 2) ? 2 - u : 0, c_hi = (u > 125) ? 129 - u : 4;
        const int lrow0 = tid >> 4, lch = tid & 15;
        v4u kreg[2], vreg[2];
        __syncthreads();
        { const int kc = u - 2 + c_lo;
#pragma unroll
          for (int i = 0; i < 2; ++i) { const size_t g = (tokbase + 64 * kc + lrow0 + 32 * i) * 256 + kvh * 128 + lch * 8; kreg[i] = *(const v4u*)(K + g); vreg[i] = *(const v4u*)(V + g); }
#pragma unroll
          for (int i = 0; i < 2; ++i) { const unsigned ob = off_b(lrow0 + 32 * i, lch); *(LAS v4u*)(lds + ob) = kreg[i]; *(LAS v4u*)(lds + 32768 + ob) = vreg[i]; } }
        __syncthreads();
        for (int ci = c_lo; ci <= c_hi; ++ci) {
            const int buf = (ci - c_lo) & 1; const int kc = u - 2 + ci;
            const bool more = ci < c_hi;
            if (more) {
#pragma unroll
                for (int i = 0; i < 2; ++i) { const size_t g = (tokbase + 64 * (kc + 1) + lrow0 + 32 * i) * 256 + kvh * 128 + lch * 8; kreg[i] = *(const v4u*)(K + g); vreg[i] = *(const v4u*)(V + g); } }
            const LAS unsigned char* Kb = lds + buf * 16384; const LAS unsigned char* Vb = lds + 32768 + buf * 16384;
            f32x16 sa[2];
#pragma unroll
            for (int kt = 0; kt < 2; ++kt) {
#pragma unroll
                for (int i = 0; i < 16; ++i) sa[kt][i] = 0.f;
#pragma unroll
                for (int s = 0; s < 8; ++s) { const bf16x8 kf = *(const LAS bf16x8*)(Kb + kofs[s] + 8192 * kt); sa[kt] = __builtin_amdgcn_mfma_f32_32x32x16_bf16(kf, qf[s], sa[kt], 0, 0, 0); }
            }
            float mx = -INFINITY;
            if (ci == 0 || ci == 4) {
#pragma unroll
                for (int kt = 0; kt < 2; ++kt)
#pragma unroll
                    for (int i = 0; i < 16; ++i) { const int kp = 64 * kc + 32 * kt + (i & 3) + 8 * (i >> 2) + 4 * h; const int d = qpos - kp; if (d > 128 || d < -128) sa[kt][i] = -INFINITY; }
            }
#pragma unroll
            for (int kt = 0; kt < 2; ++kt)
#pragma unroll
                for (int i = 0; i < 16; ++i) mx = fmaxf(mx, sa[kt][i]);
            mx = fmaxf(mx, __shfl_xor(mx, 32));
            const bool need = __any(mx > mrun + 8.0f);
            const float mnew = need ? fmaxf(mrun, mx) : mrun; const float alpha = __builtin_amdgcn_exp2f(mrun - mnew); mrun = mnew;
            float ls = 0.f;
#pragma unroll
            for (int kt = 0; kt < 2; ++kt) {
                sa[kt] = sa[kt] - mnew;
#pragma unroll
                for (int i = 0; i < 16; ++i) sa[kt][i] = __builtin_amdgcn_exp2f(sa[kt][i]);
                f32x4 q4s = (f32x4){sa[kt][0], sa[kt][1], sa[kt][2], sa[kt][3]} + (f32x4){sa[kt][4], sa[kt][5], sa[kt][6], sa[kt][7]} + (f32x4){sa[kt][8], sa[kt][9], sa[kt][10], sa[kt][11]} + (f32x4){sa[kt][12], sa[kt][13], sa[kt][14], sa[kt][15]};
                ls += (q4s.x + q4s.y) + (q4s.z + q4s.w);
            }
            lrun = lrun * alpha + ls;
            if (need) {
#pragma unroll
                for (int c = 0; c < 4; ++c) o[c] = o[c] * alpha;
            }
#pragma unroll
            for (int kt = 0; kt < 2; ++kt)
#pragma unroll
                for (int s2 = 0; s2 < 2; ++s2) {
                    v4u pw; pw.x = pk2(sa[kt][8 * s2 + 0], sa[kt][8 * s2 + 1]); pw.y = pk2(sa[kt][8 * s2 + 2], sa[kt][8 * s2 + 3]); pw.z = pk2(sa[kt][8 * s2 + 4], sa[kt][8 * s2 + 5]); pw.w = pk2(sa[kt][8 * s2 + 6], sa[kt][8 * s2 + 7]);
                    const bf16x8 pf = __builtin_bit_cast(bf16x8, pw);
#pragma unroll
                    for (int c = 0; c < 4; ++c) {
                        const s16x4 lo = vtr(Vb + vofs[c][0] + (8192 * kt + 4096 * s2));
                        const s16x4 hi = vtr(Vb + vofs[c][1] + (8192 * kt + 4096 * s2 + 2048));
                        const bf16x8 vf = __builtin_shufflevector(lo, hi, 0, 1, 2, 3, 4, 5, 6, 7);
                        o[c] = __builtin_amdgcn_mfma_f32_32x32x16_bf16(vf, pf, o[c], 0, 0, 0);
                    }
                }
            if (more) {
#pragma unroll
                for (int i = 0; i < 2; ++i) { const unsigned ob = off_b(lrow0 + 32 * i, lch); *(LAS v4u*)(lds + (buf ^ 1) * 16384 + ob) = kreg[i]; *(LAS v4u*)(lds + 32768 + (buf ^ 1) * 16384 + ob) = vreg[i]; } }
            __syncthreads();
        }
        lrun += __shfl_xor(lrun, 32);
        const float rl = 1.0f / lrun;
        bf16* op = O + (tokbase + qpos) * 1024 + head * 128 + 4 * h;
#pragma unroll
        for (int c = 0; c < 4; ++c)
#pragma unroll
            for (int g = 0; g < 4; ++g) { v2u w; w.x = pk2(o[c][4 * g] * rl, o[c][4 * g + 1] * rl); w.y = pk2(o[c][4 * g + 2] * rl, o[c][4 * g + 3] * rl); *(v2u*)(op + 32 * c + 8 * g) = w; }
    }
}

constexpr int RL_XCB = 0, RL_XCT = 13312, RL_XRS = 27136, RL_T = 40000, RL_YO = 46144, RL_YOSZ = 26624, RL_PAR = 99392;
template <bool FINAL> __device__ __forceinline__ void rnn_phase(LAS unsigned char* lds, const bf16* XR, bf16* GG, const float* conv_w, const float* conv_b, const bf16* Wg,
        const float* b_a, const float* b_x, const float* sp8t, f32x2* agg, const float* cin, int tid, int lane, int wave, int G, int bid) {
    LAS unsigned short* XCB = (LAS unsigned short*)(lds + RL_XCB); LAS unsigned short* XCT = (LAS unsigned short*)(lds + RL_XCT); LAS unsigned short* XRS = (LAS unsigned short*)(lds + RL_XRS);
    LAS f32x2* T = (LAS f32x2*)(lds + RL_T); LAS float* YO = (LAS float*)(lds + RL_YO); LAS float* PAR = (LAS float*)(lds + RL_PAR);
    const int n = bid & 15, slot = bid >> 4, nslots = (G + 15 - n) >> 4;
    const int xr_r0 = tid / 12, xr_c0 = tid % 12, xr_r1 = (tid + 512) / 12, xr_c1 = (tid + 512) % 12; const bool xr_v1 = (tid + 512) < 67 * 12;
    const int cc = tid % 96, ctq = tid / 96; const int ccg = 96 * n + cc;
    float cw0 = 0.f, cw1 = 0.f, cw2 = 0.f, cw3 = 0.f, cbb = 0.f;
    if (tid < 384) { cw0 = conv_w[ccg]; cw1 = conv_w[DRNN + ccg]; cw2 = conv_w[2 * DRNN + ccg]; cw3 = conv_w[3 * DRNN + ccg]; cbb = conv_b[ccg]; }
    const int rtp = wave & 1, dir = wave >> 2, cth = (wave >> 1) & 1, l15 = lane & 15, l4 = lane >> 4; const bool fwd = (dir == 0);
    const bf16* wlane = Wg + ((size_t)((dir * 16 + n) * 2) * 96 + l15) * 96 + 8 * l4;
    __syncthreads();
    for (int i = tid; i < 576; i += NTHR) { const int d_ = i / 288, w_ = (i / 96) % 3, c_ = i % 96; const float* src = (w_ == 0) ? b_a : (w_ == 1) ? b_x : sp8t; PAR[i] = src[d_ * DRNN + 96 * n + c_]; }
    v4u xq0 = {0u, 0u, 0u, 0u}, xq1 = {0u, 0u, 0u, 0u};
#define RNN_LOAD_XR(pair) do { const int b_ = (pair) >> 7, ch_ = (pair) & 127; const size_t tb_ = (size_t)b_ * SEQ; const int tk0 = 64 * ch_ - 2 + xr_r0, tk1 = 64 * ch_ - 2 + xr_r1; \
        xq0 = (v4u){0u, 0u, 0u, 0u}; xq1 = xq0; \
        if (tk0 >= 0 && tk0 < SEQ) xq0 = *(const v4u*)(XR + (tb_ + tk0) * DRNN + 96 * n + 8 * xr_c0); \
        if (xr_v1 && tk1 >= 0 && tk1 < SEQ) xq1 = *(const v4u*)(XR + (tb_ + tk1) * DRNN + 96 * n + 8 * xr_c1); } while (0)
    bf16x8 wa[3][3], wx[3][3];
#pragma unroll
    for (int i = 0; i < 3; ++i)
#pragma unroll
        for (int ks = 0; ks < 3; ++ks) { wa[i][ks] = *(const bf16x8*)(wlane + (size_t)(16 * (3 * cth + i)) * 96 + 32 * ks); wx[i][ks] = *(const bf16x8*)(wlane + (size_t)(96 + 16 * (3 * cth + i)) * 96 + 32 * ks); }
    int pair = slot;
    if (pair < 512) RNN_LOAD_XR(pair);
    for (; pair < 512; pair += nslots) {
        const int b = pair >> 7, chunk = pair & 127; const size_t tokbase = (size_t)b * SEQ; const int t0 = 64 * chunk;
        *(LAS v4u*)(XRS + xr_r0 * 96 + xr_c0 * 8) = xq0; if (xr_v1) *(LAS v4u*)(XRS + xr_r1 * 96 + xr_c1 * 8) = xq1;
        __syncthreads();
        if (pair + nslots < 512) RNN_LOAD_XR(pair + nslots);
        v4u gq0 = {0u, 0u, 0u, 0u}, gq1 = gq0; float cinr[3] = {0.f, 0.f, 0.f};
        if (FINAL) {
            gq0 = *(const v4u*)(GG + (tokbase + t0 + tid / 12) * DRNN + 96 * n + 8 * (tid % 12));
            if (tid < 256) gq1 = *(const v4u*)(GG + (tokbase + t0 + (tid + 512) / 12) * DRNN + 96 * n + 8 * ((tid + 512) % 12));
#pragma unroll
            for (int i = 0; i < 3; ++i) cinr[i] = cin[((size_t)(b * 128 + chunk) * 2 + dir) * DRNN + 96 * n + 16 * (3 * cth + i) + l15];
        }
        if (tid < 384) {
            float x0 = bf2f(XRS[(16 * ctq + 0) * 96 + cc]), x1 = bf2f(XRS[(16 * ctq + 1) * 96 + cc]), x2 = bf2f(XRS[(16 * ctq + 2) * 96 + cc]);
#pragma unroll
            for (int k = 0; k < 16; ++k) { const int t = 16 * ctq + k; const float x3 = bf2f(XRS[(t + 3) * 96 + cc]);
                const float v = cbb + x0 * cw0 + x1 * cw1 + x2 * cw2 + x3 * cw3;
                const unsigned short vb = (unsigned short)(pk2(v, 0.f) & 0xffffu);
                XCB[t * 104 + cc] = vb; XCT[cc * 72 + t] = vb;
                x0 = x1; x1 = x2; x2 = x3; } }
        __syncthreads();
        float ar[6][4], ur[6][4], Ae[6], He[6];
#pragma unroll
        for (int tt = 0; tt < 2; ++tt) {
            const int rt = 2 * rtp + tt;
            bf16x8 xa[3];
#pragma unroll
            for (int ks = 0; ks < 3; ++ks) xa[ks] = *(const LAS bf16x8*)(XCB + (16 * rt + l15) * 104 + 32 * ks + 8 * l4);
#pragma unroll
            for (int i = 0; i < 3; ++i) {
                const int it = tt * 3 + i;
                f32x4 ga = {0.f, 0.f, 0.f, 0.f}, gx = {0.f, 0.f, 0.f, 0.f};
#pragma unroll
                for (int ks = 0; ks < 3; ++ks) {
                    ga = __builtin_amdgcn_mfma_f32_16x16x32_bf16(xa[ks], wa[i][ks], ga, 0, 0, 0);
                    gx = __builtin_amdgcn_mfma_f32_16x16x32_bf16(xa[ks], wx[i][ks], gx, 0, 0, 0);
                }
                const int c = 16 * (3 * cth + i) + l15;
                const float ba = PAR[dir * 288 + c], bx = PAR[dir * 288 + 96 + c], lm = PAR[dir * 288 + 192 + c];
                const v2u xcw = *(const LAS v2u*)(XCT + c * 72 + 16 * rt + 4 * l4);
                const float xc[4] = {__uint_as_float(xcw.x << 16), __uint_as_float(xcw.x & 0xffff0000u), __uint_as_float(xcw.y << 16), __uint_as_float(xcw.y & 0xffff0000u)};
#pragma unroll
                for (int p2 = 0; p2 < 2; ++p2) {
                    const f32x2 za = (f32x2){ga[2 * p2], ga[2 * p2 + 1]} + ba, zx = (f32x2){gx[2 * p2], gx[2 * p2 + 1]} + bx;
                    const f32x2 ta = za * (-1.4426950408889634f), tx = zx * (-1.4426950408889634f);
                    const f32x2 da = (f32x2){__builtin_amdgcn_exp2f(ta.x), __builtin_amdgcn_exp2f(ta.y)} + 1.0f, dx = (f32x2){__builtin_amdgcn_exp2f(tx.x), __builtin_amdgcn_exp2f(tx.y)} + 1.0f;
                    const f32x2 ra = {__builtin_amdgcn_rcpf(da.x), __builtin_amdgcn_rcpf(da.y)}, ii = {__builtin_amdgcn_rcpf(dx.x), __builtin_amdgcn_rcpf(dx.y)};
                    const f32x2 la = ra * (-lm);
                    const f32x2 tl = la * 1.4426950408889634f;
                    const f32x2 av2 = {__builtin_amdgcn_exp2f(tl.x), __builtin_amdgcn_exp2f(tl.y)};
                    const f32x2 m2 = (1.0f - av2) * (1.0f + av2);
                    const f32x2 w2 = ii * (f32x2){xc[2 * p2], xc[2 * p2 + 1]};
                    const f32x2 uu = (f32x2){__builtin_amdgcn_sqrtf(m2.x), __builtin_amdgcn_sqrtf(m2.y)} * w2;
                    ar[it][2 * p2] = av2.x; ar[it][2 * p2 + 1] = av2.y;
                    ur[it][2 * p2] = uu.x; ur[it][2 * p2 + 1] = uu.y;
                }
                float A = 1.f, H = 0.f;
#pragma unroll
                for (int k = 0; k < 4; ++k) { const int r = fwd ? k : 3 - k; H = ar[it][r] * H + ur[it][r]; A *= ar[it][r]; }
                const int p = fwd ? l4 : 3 - l4;
#pragma unroll
                for (int d = 1; d <= 2; d <<= 1) {
                    const int src = fwd ? lane - 16 * d : lane + 16 * d;
                    const float Ap = __shfl(A, src & 63), Hp = __shfl(H, src & 63);
                    if (p >= d) { H = A * Hp + H; A = Ap * A; }
                }
                { const int src = fwd ? lane - 16 : lane + 16;
                  const float Ap = __shfl(A, src & 63), Hp = __shfl(H, src & 63);
                  Ae[it] = (p >= 1) ? Ap : 1.f; He[it] = (p >= 1) ? Hp : 0.f; }
                if (p == 3) T[(dir * 4 + rt) * 96 + c] = (f32x2){A, H};
            }
        }
        __syncthreads();
        if (!FINAL) {
            if (rtp == 0 && l4 == 0) {
#pragma unroll
                for (int i = 0; i < 3; ++i) { const int c = 16 * (3 * cth + i) + l15; float A = 1.f, H = 0.f;
#pragma unroll
                    for (int k = 0; k < 4; ++k) { const f32x2 tv = T[(dir * 4 + (fwd ? k : 3 - k)) * 96 + c]; H = tv.x * H + tv.y; A *= tv.x; }
                    agg[((size_t)(b * 128 + chunk) * 2 + dir) * DRNN + 96 * n + c] = (f32x2){A, H}; }
            }
        } else {
            LAS float* YOd = YO + dir * (RL_YOSZ / 4);
#pragma unroll
            for (int tt = 0; tt < 2; ++tt) {
                const int rt = 2 * rtp + tt;
#pragma unroll
                for (int i = 0; i < 3; ++i) { const int it = tt * 3 + i; const int c = 16 * (3 * cth + i) + l15;
                    float Hc = cinr[i];
#pragma unroll
                    for (int k = 0; k < 3; ++k) { const int tq = fwd ? k : 3 - k; const bool before = fwd ? (tq < rt) : (tq > rt); const f32x2 tv = T[(dir * 4 + tq) * 96 + c]; if (before) Hc = tv.x * Hc + tv.y; }
                    float h = Ae[it] * Hc + He[it];
#pragma unroll
                    for (int k = 0; k < 4; ++k) { const int r = fwd ? k : 3 - k; h = ar[it][r] * h + ur[it][r]; YOd[(16 * rt + 4 * l4 + r) * 104 + c] = h; }
                }
            }
            __syncthreads();
#pragma unroll
            for (int it2 = 0; it2 < 2; ++it2) { const int idx = tid + 512 * it2; if (it2 == 1 && tid >= 256) break; const int t = idx / 12, ch = idx % 12;
                const v4u gv = it2 ? gq1 : gq0;
                const f32x4 f0 = *(const LAS f32x4*)(YO + t * 104 + 8 * ch), f1 = *(const LAS f32x4*)(YO + t * 104 + 8 * ch + 4);
                const f32x4 r0 = *(const LAS f32x4*)(YO + (RL_YOSZ / 4) + t * 104 + 8 * ch), r1 = *(const LAS f32x4*)(YO + (RL_YOSZ / 4) + t * 104 + 8 * ch + 4);
                const f32x4 y0 = f0 + r0, y1 = f1 + r1;
                v4u ov;
                ov.x = pk2(y0[0] * __uint_as_float(gv.x << 16), y0[1] * __uint_as_float(gv.x & 0xffff0000u));
                ov.y = pk2(y0[2] * __uint_as_float(gv.y << 16), y0[3] * __uint_as_float(gv.y & 0xffff0000u));
                ov.z = pk2(y1[0] * __uint_as_float(gv.z << 16), y1[1] * __uint_as_float(gv.z & 0xffff0000u));
                ov.w = pk2(y1[2] * __uint_as_float(gv.w << 16), y1[3] * __uint_as_float(gv.w & 0xffff0000u));
                *(v4u*)(GG + (tokbase + t0 + t) * DRNN + 96 * n + 8 * ch) = ov; }
        }
    }
#undef RNN_LOAD_XR
}
__device__ __forceinline__ void rnn_carry_phase(const f32x2* agg, float* cin, int tid, int G, int bid) {
    for (int g = bid * NTHR + tid; g < BATCH * 2 * DRNN; g += G * NTHR) {
        const int ch = g % DRNN, dir = (g / DRNN) & 1, b = g / (2 * DRNN);
        float carry = 0.f;
#pragma unroll 8
        for (int k = 0; k < 128; ++k) { const int chunk = dir ? 127 - k : k; const size_t idx = ((size_t)(b * 128 + chunk) * 2 + dir) * DRNN + ch;
            const f32x2 av = agg[idx]; cin[idx] = carry; carry = av.x * carry + av.y; }
    }
}

__global__ void __launch_bounds__(NTHR, 2) fwd_megakernel(Args args) {
    extern __shared__ __attribute__((aligned(16))) unsigned char lds_raw[];
    LAS unsigned char* lds = (LAS unsigned char*)lds_raw;
    cg::grid_group grid = cg::this_grid();
    const int tid = threadIdx.x, lane = tid & 63, wave = __builtin_amdgcn_readfirstlane(tid >> 6);
    const int G = gridDim.x, bid = blockIdx.x;
    unsigned char* ws = args.ws;
    float* MOD = (float*)(ws + WS_MOD); bf16* XB = (bf16*)(ws + WS_XB); bf16* HB = (bf16*)(ws + WS_HB);
    bf16* Qb = (bf16*)(ws + WS_Q); bf16* Kb = (bf16*)(ws + WS_K); bf16* Vb = (bf16*)(ws + WS_V); bf16* Ob = (bf16*)(ws + WS_O);
    bf16* Hbig = (bf16*)(ws + WS_BIG); bf16* XR = (bf16*)(ws + WS_XR); bf16* GG = (bf16*)(ws + WS_GG);
    const float* ln_g = args.in[4]; const float* ln_b = args.in[5];
    using namespace pg8;

    volatile LAS unsigned* MISC = (volatile LAS unsigned*)(lds + LDS_BYTES - 64);
    if (tid < 2) MISC[tid] = 0u;
    if (bid == 0) { for (int i = tid; i < XCD_BAR_WORDS; i += NTHR) ((unsigned*)(ws + WS_BAR))[i] = 0u; }
    __syncthreads();
    p0_prologue(args, lds, tid, lane, wave, G, bid);
    grid.sync();
    (void)xcd_barrier_post((unsigned*)(ws + WS_BAR), MISC);
#define GRID_BAR() do { XcdBarrier b_; b_.bar = (unsigned*)(args.ws + WS_BAR); b_.x = xb_xcc_id(); b_.st = (volatile LAS unsigned*)(lds + LDS_BYTES - 64); xcd_barrier(b_); } while (0)
    ln_mod_phase<false, true, false>(args.in[0], nullptr, HB, nullptr, nullptr, MOD + 0 * 12288, nullptr, lane, wave, G, bid);
    GRID_BAR();
    { Gemm g{HB, (const bf16_t*)(ws + WS_WQKV), M, NQKV, DM}; StaticOrder S; S.init(M, NQKV, G, bid);
      EpiQKV E{Qb, Kb, Vb, (const float*)(ws + WS_CS), 0.08838834764831845f * LOG2E};
      gemm_phase<EpiQKV, StaticOrder, true, true>(lds, g, S, E); }
    GRID_BAR();
    attn_phase(lds, Qb, Kb, Vb, Ob, args.in[8], tid, lane, wave, G, bid);
    GRID_BAR();
    { Gemm g{Ob, (const bf16_t*)(ws + WS_WO), M, DM, DM}; StaticOrder S; S.init(M, DM, G, bid);
      EpiRes<true> E{ws, args.in[0], ln_g, ln_b, 0};
      gemm_phase<EpiRes<true>, StaticOrder, true, true>(lds, g, S, E); }
    GRID_BAR();
    ln_mod_phase<true, false, false>(XB, nullptr, HB, ln_g + 0 * 1024, ln_b + 0 * 1024, MOD + 1 * 12288, (float*)(ws + WS_STAT), lane, wave, G, bid);
    GRID_BAR();
    { Gemm g{HB, (const bf16_t*)(ws + WS_W1), M, DFF, DM}; StaticOrder S; S.init(M, DFF, G, bid);
      EpiAct<0> E{Hbig, nullptr, DFF};
      gemm_phase<EpiAct<0>, StaticOrder, true, true>(lds, g, S, E); }
    GRID_BAR();
    { Gemm g{Hbig, (const bf16_t*)(ws + WS_W2), M, DM, DFF}; StaticOrder S; S.init(M, DM, G, bid);
      EpiRes<false> E{ws, nullptr, ln_g, ln_b, 1};
      gemm_phase<EpiRes<false>, StaticOrder, true, true>(lds, g, S, E); }
    GRID_BAR();
    ln_mod_phase<true, false, false>(XB, nullptr, HB, ln_g + 1 * 1024, ln_b + 1 * 1024, MOD + 2 * 12288, (float*)(ws + WS_STAT), lane, wave, G, bid);
    GRID_BAR();
    { Gemm g{HB, (const bf16_t*)(ws + WS_WRIN), M, 2 * DRNN, DM}; StaticOrder S; S.init(M, 2 * DRNN, G, bid);
      EpiAct<1> E{XR, GG, DRNN};
      gemm_phase<EpiAct<1>, StaticOrder, true, true>(lds, g, S, E); }
    GRID_BAR();
    rnn_phase<false>(lds, XR, GG, args.in[10], args.in[11], (const bf16*)(ws + WS_WG), args.in[13], args.in[15], (const float*)(ws + WS_SP8), (f32x2*)(ws + WS_AGG), (const float*)(ws + WS_CIN), tid, lane, wave, G, bid);
    GRID_BAR();
    rnn_carry_phase((const f32x2*)(ws + WS_AGG), (float*)(ws + WS_CIN), tid, G, bid);
    GRID_BAR();
    rnn_phase<true>(lds, XR, GG, args.in[10], args.in[11], (const bf16*)(ws + WS_WG), args.in[13], args.in[15], (const float*)(ws + WS_SP8), (f32x2*)(ws + WS_AGG), (const float*)(ws + WS_CIN), tid, lane, wave, G, bid);
    GRID_BAR();
    { Gemm g{GG, (const bf16_t*)(ws + WS_WROUT), M, DM, DRNN}; StaticOrder S; S.init(M, DM, G, bid);
      EpiRes<false> E{ws, nullptr, ln_g, ln_b, 2};
      gemm_phase<EpiRes<false>, StaticOrder, true, true>(lds, g, S, E); }
    GRID_BAR();
    ln_mod_phase<true, false, false>(XB, nullptr, HB, ln_g + 2 * 1024, ln_b + 2 * 1024, MOD + 3 * 12288, (float*)(ws + WS_STAT), lane, wave, G, bid);
    GRID_BAR();
    { Gemm g{HB, (const bf16_t*)(ws + WS_W1) + (size_t)DFF * DM, M, DFF, DM}; StaticOrder S; S.init(M, DFF, G, bid);
      EpiAct<0> E{Hbig, nullptr, DFF};
      gemm_phase<EpiAct<0>, StaticOrder, true, true>(lds, g, S, E); }
    GRID_BAR();
    { Gemm g{Hbig, (const bf16_t*)(ws + WS_W2) + (size_t)DM * DFF, M, DM, DFF}; StaticOrder S; S.init(M, DM, G, bid);
      EpiRes<false> E{ws, nullptr, ln_g, ln_b, 3};
      gemm_phase<EpiRes<false>, StaticOrder, true, true>(lds, g, S, E); }
    GRID_BAR();
    ln_mod_phase<true, false, true>(XB, args.out, nullptr, ln_g + 3 * 1024, ln_b + 3 * 1024, nullptr, nullptr, lane, wave, G, bid);
}

extern "C" void kernel_launch(void* const* d_in, const int* in_sizes, int n_in, void* d_out, int out_size, void* d_ws, size_t ws_size, hipStream_t stream) {
    static int grid = 0;
    if (grid == 0) {
        if (n_in != 20 || out_size != M * DM || ws_size < WS_END) { fprintf(stderr, "kernel_launch: unexpected problem (n_in %d, out %d, ws %zu)\n", n_in, out_size, ws_size); grid = -1; return; }
        int dev = 0, cus = 0, per_cu = 0;
        (void)hipGetDevice(&dev); (void)hipDeviceGetAttribute(&cus, hipDeviceAttributeMultiprocessorCount, dev);
        if (hipFuncSetAttribute((const void*)fwd_megakernel, hipFuncAttributeMaxDynamicSharedMemorySize, LDS_BYTES) != hipSuccess) { fprintf(stderr, "kernel_launch: hipFuncSetAttribute failed\n"); grid = -1; return; }
        if (hipOccupancyMaxActiveBlocksPerMultiprocessor(&per_cu, (const void*)fwd_megakernel, NTHR, LDS_BYTES) != hipSuccess || per_cu < 1) { fprintf(stderr, "kernel_launch: occupancy query gave %d\n", per_cu); per_cu = 1; }
        (void)hipGetLastError();
        grid = cus * 1;
    }
    if (grid < 0) return;
    Args a{};
    for (int i = 0; i < 20; ++i) a.in[i] = (const float*)d_in[i];
    a.out = (float*)d_out; a.ws = (unsigned char*)d_ws;
    void* kargs[] = {&a};
    hipError_t e = hipLaunchCooperativeKernel((const void*)fwd_megakernel, dim3(grid), dim3(NTHR), kargs, LDS_BYTES, stream);
    if (e != hipSuccess) fprintf(stderr, "cooperative launch failed: %s (grid %d)\n", hipGetErrorString(e), grid);
}
```
